# Optimizing an MI355X kernel written in HIP

```python
import jax, jax.numpy as jnp
from jax import lax
import numpy as np

D_MODEL = 1024
BATCH = 4
SEQ = 4096
DEPTH = 4

BRANCH_W = D_MODEL // 2
N_BRANCHES = 3
POOL_WINDOWS = (2, 4, 8, 16)
POOL_GROUPS = 4
POOL_GROUP_W = BRANCH_W // POOL_GROUPS
RET_HEADS = 4
RET_HEAD_DIM = BRANCH_W // RET_HEADS
RET_CHUNK = 128
ROPE_BASE = 10000.0
RWKV_HEAD_DIM = 64
RWKV_HEADS = BRANCH_W // RWKV_HEAD_DIM
RWKV_W_LORA = 64
RWKV_A_LORA = 64
RWKV_SHIFT_W = 3 * BRANCH_W + RWKV_W_LORA + RWKV_A_LORA
IN_SPLIT_SIZES = (BRANCH_W, BRANCH_W, BRANCH_W, BRANCH_W, BRANCH_W, BRANCH_W,
                  RWKV_SHIFT_W, BRANCH_W, N_BRANCHES * D_MODEL)
D_IN = sum(IN_SPLIT_SIZES)
NORM_EPS = 1e-6
RET_NORM_EPS = 1e-5
RWKV_NORM_EPS = 64e-5

kernel_name = "hybrid_pool_retention_rwkv7_gated_parallel"


def rms_norm(x, g):
    x32 = x.astype(jnp.float32)
    y = x32 * lax.rsqrt(jnp.mean(x32 * x32, axis=-1, keepdims=True) + NORM_EPS)
    return (y * g).astype(x.dtype)


def head_norm(x, eps):
    x32 = x.astype(jnp.float32)
    mu = jnp.mean(x32, axis=-1, keepdims=True)
    xc = x32 - mu
    var = jnp.mean(xc * xc, axis=-1, keepdims=True)
    return xc * lax.rsqrt(var + eps)


def causal_pool_mixer(u, pool_w, pool_scale):
    B, T, _ = u.shape
    u32 = u.astype(jnp.float32)
    cs_pad = jnp.pad(jnp.cumsum(u32, axis=1), ((0, 0), (1, 0), (0, 0)))
    t_idx = jnp.arange(T)
    outs = []
    for gi, w in enumerate(POOL_WINDOWS):
        sl = slice(gi * POOL_GROUP_W, (gi + 1) * POOL_GROUP_W)
        c = cs_pad[..., sl]
        lower = jnp.pad(c[:, :T + 1 - w], ((0, 0), (w - 1, 0), (0, 0)))
        win_sum = c[:, 1:] - lower
        count = jnp.minimum(t_idx + 1, w).astype(jnp.float32)[None, :, None]
        outs.append(win_sum / count - u32[..., sl])
    d = jnp.stack(outs, axis=2).astype(u.dtype)
    y = jnp.einsum('btgc,gcd->btgd', d, pool_w).reshape(B, T, BRANCH_W)
    return y * pool_scale


def rotary(x, positions):
    half = x.shape[-1] // 2
    freqs = ROPE_BASE ** (-jnp.arange(half, dtype=jnp.float32) / half)
    ang = positions.astype(jnp.float32)[..., None] * freqs
    cos = jnp.cos(ang)[:, :, None, :]
    sin = jnp.sin(ang)[:, :, None, :]
    x32 = x.astype(jnp.float32)
    x1, x2 = x32[..., :half], x32[..., half:]
    return jnp.concatenate([x1 * cos - x2 * sin, x1 * sin + x2 * cos], axis=-1)


def retention(q, k, v, positions, ret_norm_g):
    dtype = q.dtype
    B, T, _ = q.shape
    H, dh, C = RET_HEADS, RET_HEAD_DIM, RET_CHUNK
    N = T // C
    qh = rotary(q.reshape(B, T, H, dh), positions)
    kh = rotary(k.reshape(B, T, H, dh), positions) * (dh ** -0.5)
    vh = v.reshape(B, T, H, dh).astype(jnp.float32)

    def to_chunks(a):
        return a.reshape(B, N, C, H, dh).transpose(0, 3, 1, 2, 4)

    qc, kc, vc = to_chunks(qh), to_chunks(kh), to_chunks(vh)
    log_gamma = jnp.log1p(-(2.0 ** (-5.0 - jnp.arange(H, dtype=jnp.float32))))
    i = jnp.arange(C, dtype=jnp.float32)
    diff = i[:, None] - i[None, :]
    decay_mask = jnp.where(diff >= 0,
                           jnp.exp(log_gamma[:, None, None] * jnp.maximum(diff, 0.0)),
                           0.0)
    scores = jnp.einsum('bhnid,bhnjd->bhnij', qc, kc) * decay_mask[None, :, None]
    o_intra = jnp.einsum('bhnij,bhnje->bhnie', scores, vc)
    k_tail = kc * jnp.exp(log_gamma[:, None] * (C - 1 - i))[None, :, None, :, None]
    kv = jnp.einsum('bhnjd,bhnje->bhnde', k_tail, vc)
    chunk_decay = jnp.exp(log_gamma * C)[None, :, None, None]

    def step(R, kv_n):
        return chunk_decay * R + kv_n, R

    _, R_prev = lax.scan(step, jnp.zeros((B, H, dh, dh), jnp.float32), jnp.moveaxis(kv, 2, 0))
    R_prev = jnp.moveaxis(R_prev, 0, 2)
    q_dec = qc * jnp.exp(log_gamma[:, None] * (i + 1.0))[None, :, None, :, None]
    o = o_intra + jnp.einsum('bhnid,bhnde->bhnie', q_dec, R_prev)
    o = o.transpose(0, 2, 3, 1, 4).reshape(B, T, H, dh)
    o = head_norm(o, RET_NORM_EPS).reshape(B, T, BRANCH_W) * ret_norm_g
    return o.astype(dtype)


def rwkv7_time_mix(p, shift_mu, w0, w2, a0, a2, k_k, k_a, r_k, ln_w, ln_b):
    dtype = p.dtype
    B, T, _ = p.shape
    H, N = RWKV_HEADS, RWKV_HEAD_DIM
    p_prev = jnp.pad(p[:, :-1], ((0, 0), (1, 0), (0, 0)))
    p = p + (p_prev - p) * shift_mu
    split_pts = (BRANCH_W, BRANCH_W + RWKV_W_LORA, 2 * BRANCH_W + RWKV_W_LORA,
                 3 * BRANCH_W + RWKV_W_LORA)
    r, wl, k, v, al = jnp.split(p, split_pts, axis=-1)
    w = -jax.nn.softplus(-(w0 + jnp.tanh(wl) @ w2)) - 0.5
    decay = jnp.exp(-jnp.exp(w.astype(jnp.float32)))
    a = jax.nn.sigmoid(a0 + al @ a2)

    def heads(z):
        return z.reshape(B, T, H, N).astype(jnp.float32)

    kk = heads(k * k_k)
    kk = kk / jnp.maximum(jnp.sqrt(jnp.sum(kk * kk, axis=-1, keepdims=True)), 1e-12)
    k = k * (1.0 + (a - 1.0) * k_a)
    r_h, k_h, v_h, a_h, w_h = heads(r), heads(k), heads(v), heads(a), heads(decay)
    xs = tuple(jnp.moveaxis(z, 1, 0) for z in (r_h, w_h, k_h, v_h, -kk, kk * a_h))

    def step(S, inp):
        r_t, w_t, k_t, v_t, a_t, b_t = inp
        sa = jnp.einsum('bhvk,bhk->bhv', S, a_t)
        S = (S * w_t[:, :, None, :] + sa[..., None] * b_t[:, :, None, :]
             + v_t[..., None] * k_t[:, :, None, :])
        return S, jnp.einsum('bhvk,bhk->bhv', S, r_t)

    _, y = lax.scan(step, jnp.zeros((B, H, N, N), jnp.float32), xs)
    y = jnp.moveaxis(y, 0, 1)
    y = head_norm(y, RWKV_NORM_EPS).reshape(B, T, BRANCH_W) * ln_w + ln_b
    bonus = jnp.sum(r_h * k_h * r_k, axis=-1, keepdims=True) * v_h
    y = y + bonus.reshape(B, T, BRANCH_W)
    return y.astype(dtype)


def hybrid_layer(x, c_act, positions, norm_g, w_ada, b_ada, w_in, pool_w, pool_scale,
                 ret_norm_g, shift_mu, w0, w2, a0, a2, k_k, k_a, r_k, ln_w, ln_b,
                 w_branch, w_out):
    B, T, D = x.shape
    mod = c_act @ w_ada + b_ada
    shift, scale, gate = jnp.split(mod[:, None, :], 3, axis=-1)
    h = rms_norm(x, norm_g) * (1.0 + scale) + shift
    proj = h @ w_in
    points = np.cumsum(IN_SPLIT_SIZES)[:-1].tolist()
    pool_u, pool_g, q, k, v, ret_g, rw, rw_g, gate_logits = jnp.split(proj, points, axis=-1)
    o_pool = causal_pool_mixer(pool_u, pool_w, pool_scale) * jax.nn.silu(pool_g)
    o_ret = retention(q, k, v, positions, ret_norm_g) * jax.nn.silu(ret_g)
    o_rwkv = rwkv7_time_mix(rw, shift_mu, w0, w2, a0, a2, k_k, k_a, r_k,
                            ln_w, ln_b) * jax.nn.silu(rw_g)
    branches = jnp.stack([o_pool, o_ret, o_rwkv], axis=2)
    y = jnp.einsum('btnw,nwd->btnd', branches, w_branch)
    gates = jax.nn.sigmoid(gate_logits.reshape(B, T, N_BRANCHES, D))
    merged = jnp.sum(gates * y, axis=2)
    return x + gate * (merged @ w_out)


def setup_inputs(seed: int = 0) -> dict:
    key = jax.random.key(seed)
    ks = jax.random.split(key, 24)
    L, D, W = DEPTH, D_MODEL, BRANCH_W
    nrm = jax.random.normal
    f32 = jnp.float32
    return {
        "x": nrm(ks[0], (BATCH, SEQ, D), f32),
        "c": nrm(ks[1], (BATCH, D), f32),
        "positions": jnp.broadcast_to(jnp.arange(SEQ, dtype=jnp.int32), (BATCH, SEQ)),
        "norm_g": 1.0 + 0.05 * nrm(ks[2], (L, D), f32),
        "w_ada": 0.5 * D ** -0.5 * nrm(ks[3], (L, D, 3 * D), f32),
        "b_ada": 0.01 * nrm(ks[4], (L, 3 * D), f32),
        "w_in": D ** -0.5 * nrm(ks[5], (L, D, D_IN), f32),
        "pool_w": POOL_GROUP_W ** -0.5 * nrm(ks[6], (L, POOL_GROUPS, POOL_GROUP_W, POOL_GROUP_W), f32),
        "pool_scale": 1.0 + 0.1 * nrm(ks[7], (L, W), f32),
        "ret_norm_g": 1.0 + 0.05 * nrm(ks[8], (L, W), f32),
        "rwkv_shift_mu": jax.random.uniform(ks[9], (L, RWKV_SHIFT_W), f32),
        "rwkv_w0": jax.random.uniform(ks[10], (L, W), f32, -6.0, 1.0),
        "rwkv_w2": 0.5 * RWKV_W_LORA ** -0.5 * nrm(ks[11], (L, RWKV_W_LORA, W), f32),
        "rwkv_a0": 0.1 * nrm(ks[12], (L, W), f32),
        "rwkv_a2": 0.5 * RWKV_A_LORA ** -0.5 * nrm(ks[13], (L, RWKV_A_LORA, W), f32),
        "rwkv_k_k": 0.85 + 0.05 * nrm(ks[14], (L, W), f32),
        "rwkv_k_a": 1.0 + 0.05 * nrm(ks[15], (L, W), f32),
        "rwkv_r_k": 0.1 * nrm(ks[16], (L, RWKV_HEADS, RWKV_HEAD_DIM), f32),
        "rwkv_ln_w": 1.0 + 0.05 * nrm(ks[17], (L, W), f32),
        "rwkv_ln_b": 0.01 * nrm(ks[18], (L, W), f32),
        "w_branch": W ** -0.5 * nrm(ks[19], (L, N_BRANCHES, W, D), f32),
        "w_out": D ** -0.5 * nrm(ks[20], (L, D, D), f32),
        "final_g": 1.0 + 0.05 * nrm(ks[21], (D,), f32),
    }


def reference(x, c, positions, norm_g, w_ada, b_ada, w_in, pool_w, pool_scale, ret_norm_g,
              rwkv_shift_mu, rwkv_w0, rwkv_w2, rwkv_a0, rwkv_a2, rwkv_k_k, rwkv_k_a,
              rwkv_r_k, rwkv_ln_w, rwkv_ln_b, w_branch, w_out, final_g):
    c_act = jax.nn.silu(c)
    for l in range(DEPTH):
        x = hybrid_layer(x, c_act, positions, norm_g[l], w_ada[l], b_ada[l], w_in[l],
                         pool_w[l], pool_scale[l], ret_norm_g[l], rwkv_shift_mu[l],
                         rwkv_w0[l], rwkv_w2[l], rwkv_a0[l], rwkv_a2[l], rwkv_k_k[l],
                         rwkv_k_a[l], rwkv_r_k[l], rwkv_ln_w[l], rwkv_ln_b[l],
                         w_branch[l], w_out[l])
    return rms_norm(x, final_g)
```

```cpp
#include <hip/hip_runtime.h>
#include <hip/hip_cooperative_groups.h>
#include <cstdio>
namespace cg = cooperative_groups;

__device__ __forceinline__ int tid_() { int t = (int)__builtin_amdgcn_workitem_id_x(); asm volatile("" : "+v"(t)); return t; }
namespace pg8 {
#define PG8_LAS __attribute__((address_space(3)))
typedef unsigned short bf16_t;
typedef short bf16x8 __attribute__((ext_vector_type(8)));
typedef float f32x4 __attribute__((ext_vector_type(4)));
typedef unsigned u32x4 __attribute__((ext_vector_type(4)));
constexpr int BM = 256, BK = 64, HALF = 128, HTB = HALF * BK * 2  , STAGE_BYTES = 8 * HTB, NXCD = 8, WGM = 8;

__host__ __device__ __forceinline__ int lds_byte(int r, int c) { const int st = (r >> 4) * 2 + (c >> 5), rr = r & 15, cc = c & 31, ob = rr * 64 + cc * 2; return st * 1024 + (ob ^ (((ob >> 9) & 1) << 5)); }
__host__ __device__ __forceinline__ void stage_rc(int b, int& R, int& C) { const int st = b / 1024, sb = b % 1024, swz = sb ^ (((sb >> 9) & 1) << 5); R = (st >> 1) * 16 + swz / 64; C = (st & 1) * 32 + (swz % 64) / 2; }
__host__ __device__ __forceinline__ int perm32(int rho) { const int n = rho >> 4, i = rho & 15; return 8 * (i >> 2) + 4 * n + (i & 3); }

struct Unit { int pm, pn; };
struct Gemm { const bf16_t* A; const bf16_t* Bt; int M, N, K; };

struct StaticOrder {
    int nM, nN, nwg, G, c;
    __host__ __device__ void init(int M, int N, int G_, int c_) { nM = M / BM; nN = N / BM; nwg = nM * nN; G = G_; c = c_; }
    __host__ __device__ bool next(int i, Unit& u) const {
        const long L = (long)i * G + c; if (L >= nwg) return false;
        int wgid = (int)L; { const int q = nwg / NXCD, r = nwg % NXCD, xcd = wgid % NXCD, off = wgid / NXCD; wgid = (xcd < r ? xcd * (q + 1) : r * (q + 1) + (xcd - r) * q) + off; }
        const int nig = WGM * nN, gid = wgid / nig, fm = gid * WGM, gsz = (nM - fm) < WGM ? (nM - fm) : WGM;
        u.pm = fm + ((wgid % nig) % gsz); u.pn = (wgid % nig) / gsz; return true;
    }
    __device__ __forceinline__ void a_ready(const Unit&) const {}
    __device__ __forceinline__ void done(const Unit&) const {}
};
__device__ __forceinline__ unsigned cvt_pk_bf16(float lo, float hi) { unsigned r; asm volatile("v_cvt_pk_bf16_f32 %0, %1, %2" : "=v"(r) : "v"(lo), "v"(hi)); return r; }
typedef float f32x2 __attribute__((ext_vector_type(2)));

template <class Epi, class Sched, bool STAMP = false>
__device__ __forceinline__ void gemm_phase(PG8_LAS unsigned char* lds, const Gemm g, const Sched& S, const Epi& E, unsigned long long* stamps) {
    const int tid = tid_(), wid = __builtin_amdgcn_readfirstlane(tid >> 6), lane = tid & 63, wr = wid >> 2, wc = wid & 3, fr = lane & 15, fq = lane >> 4;
    const int K = g.K, nt = K / BK;
    int ts_lo = 0, ts_hi = 0, nts = 0; const unsigned long long rt_entry = STAMP ? (unsigned long long)wall_clock64() : 0ull;
#define PG8_STAMP() do { if (STAMP && wid == 0 && nts < 64) { const unsigned long long _c = (unsigned long long)clock64(); \
        ts_lo = (lane == nts) ? (int)(unsigned)_c : ts_lo; ts_hi = (lane == nts) ? (int)(unsigned)(_c >> 32) : ts_hi; ++nts; } } while (0)
    PG8_STAMP();
    unsigned voffA[2], voffB[2];
#pragma unroll
    for (int i = 0; i < 2; ++i) { int R, C; stage_rc(tid * 16 + i * 8192, R, C); const int Rb = Epi::PERM ? ((R & ~31) + perm32(R & 31)) : R;
        voffA[i] = (unsigned)(R * K + C) * 2u; voffB[i] = (unsigned)(Rb * K + C) * 2u; }
    const size_t kstep = (size_t)(BK * 2);
    const size_t hstep = (size_t)HALF * K * 2;
    const size_t tstep = 2 * hstep;
    const unsigned ldsw = (unsigned)wid * 1024u;
    const int aoff = lds_byte(wr * 64 + fr, fq * 8), boff = lds_byte(wc * 32 + fr, fq * 8);
#define PG8_SA(b, h) (((b) * 2 + (h)) * HTB)
#define PG8_SB(b, h) ((4 + (b) * 2 + (h)) * HTB)
#define PG8_STAGE(bufoff, gbase, voff) do { _Pragma("unroll") for (int _i = 0; _i < 2; ++_i) \
        __builtin_amdgcn_global_load_lds((const unsigned*)((const char*)(gbase) + (voff)[_i]), (PG8_LAS unsigned*)(lds + (bufoff) + ldsw + _i * 8192), 16, 0, 0); } while (0)
#define PG8_LDA(dst, b, h) do { _Pragma("unroll") for (int m = 0; m < 4; ++m) _Pragma("unroll") for (int k = 0; k < 2; ++k) dst[m][k] = *(const PG8_LAS bf16x8*)(lds + PG8_SA(b, h) + aoff + m * 2048 + k * 1024); } while (0)
#define PG8_LDB(dst, b, h) do { _Pragma("unroll") for (int n = 0; n < 2; ++n) _Pragma("unroll") for (int k = 0; k < 2; ++k) dst[n][k] = *(const PG8_LAS bf16x8*)(lds + PG8_SB(b, h) + boff + n * 2048 + k * 1024); } while (0)
#define PG8_MMA(ai, bj, At, Bt) do { __builtin_amdgcn_s_setprio(1); _Pragma("unroll") for (int m = 0; m < 4; ++m) _Pragma("unroll") for (int n = 0; n < 2; ++n) _Pragma("unroll") for (int k = 0; k < 2; ++k) \
        acc[ai][bj][m][n] = __builtin_amdgcn_mfma_f32_16x16x32_bf16(Bt[n][k], At[m][k], acc[ai][bj][m][n], 0, 0, 0); __builtin_amdgcn_s_setprio(0); } while (0)
#define PG8_WAIT_V(n) asm volatile("s_waitcnt vmcnt(" #n ")" ::: "memory")
#define PG8_WAIT_L(n) asm volatile("s_waitcnt lgkmcnt(" #n ")" ::: "memory")
#define PG8_BAR __builtin_amdgcn_s_barrier()
#define PG8_SCHED __builtin_amdgcn_sched_barrier(0)
    Unit cur, nxt; int ui = 0;
    if (!S.next(0, cur)) return;
    f32x4 acc[2][2][4][2];
#pragma unroll
    for (int a = 0; a < 2; ++a)
#pragma unroll
        for (int b = 0; b < 2; ++b)
#pragma unroll
            for (int m = 0; m < 4; ++m)
#pragma unroll
                for (int n = 0; n < 2; ++n) acc[a][b][m][n] = (f32x4){0.f, 0.f, 0.f, 0.f};
    bf16x8 At[4][2], B0[2][2], B1[2][2];
    const char* cA = (const char*)g.A + (size_t)cur.pm * tstep; const char* cB = (const char*)g.Bt + (size_t)cur.pn * tstep;
    S.a_ready(cur);
    PG8_STAGE(PG8_SB(0, 0), cB, voffB); PG8_STAGE(PG8_SA(0, 0), cA, voffA); PG8_STAGE(PG8_SB(0, 1), cB + hstep, voffB); PG8_STAGE(PG8_SA(0, 1), cA + hstep, voffA);
    if (wr == 1) PG8_BAR;
    PG8_WAIT_V(4); PG8_BAR;
    PG8_STAGE(PG8_SB(1, 0), cB + kstep, voffB); PG8_STAGE(PG8_SA(1, 0), cA + kstep, voffA); PG8_STAGE(PG8_SB(1, 1), cB + hstep + kstep, voffB);
    PG8_WAIT_V(6); PG8_BAR;
    PG8_STAMP();
    for (;;) {
        const bool has_next = S.next(ui + 1, nxt);
        const char* nA = has_next ? (const char*)g.A + (size_t)nxt.pm * tstep : cA; const char* nB = has_next ? (const char*)g.Bt + (size_t)nxt.pn * tstep : cB;
        for (int t = 0; t < nt; t += 2) {
            const bool last = (t == nt - 2);
            const char* a1 = cA + (size_t)(t + 1) * kstep;
            const char* a2 = last ? nA : cA + (size_t)(t + 2) * kstep; const char* b2 = last ? nB : cB + (size_t)(t + 2) * kstep;
            const char* a3 = a2 + kstep; const char* b3 = b2 + kstep;
            if (last && has_next) S.a_ready(nxt);
            PG8_LDB(B0, 0, 0); PG8_SCHED; PG8_LDA(At, 0, 0); PG8_STAGE(PG8_SA(1, 1), a1 + hstep, voffA);
            PG8_WAIT_L(8); PG8_BAR; PG8_WAIT_L(0); PG8_MMA(0, 0, At, B0); PG8_BAR; PG8_SCHED;
            PG8_LDB(B1, 0, 1); PG8_STAGE(PG8_SB(0, 0), b2, voffB);
            PG8_BAR; PG8_WAIT_L(0); PG8_MMA(0, 1, At, B1); PG8_BAR;
            PG8_LDA(At, 0, 1); PG8_STAGE(PG8_SA(0, 0), a2, voffA);
            PG8_BAR; PG8_WAIT_L(0); PG8_MMA(1, 0, At, B0); PG8_BAR; PG8_SCHED;
            PG8_STAGE(PG8_SB(0, 1), b2 + hstep, voffB);
            PG8_WAIT_V(6); PG8_BAR; PG8_MMA(1, 1, At, B1); PG8_BAR;
            PG8_LDB(B0, 1, 0); PG8_SCHED; PG8_LDA(At, 1, 0); PG8_STAGE(PG8_SA(0, 1), a2 + hstep, voffA);
            PG8_WAIT_L(8); PG8_BAR; PG8_WAIT_L(0); PG8_MMA(0, 0, At, B0); PG8_BAR; PG8_SCHED;
            PG8_LDB(B1, 1, 1); PG8_STAGE(PG8_SB(1, 0), b3, voffB);
            PG8_BAR; PG8_WAIT_L(0); PG8_MMA(0, 1, At, B1); PG8_BAR;
            PG8_LDA(At, 1, 1); PG8_STAGE(PG8_SA(1, 0), a3, voffA);
            PG8_BAR; PG8_WAIT_L(0); PG8_MMA(1, 0, At, B0); PG8_BAR; PG8_SCHED;
            PG8_STAGE(PG8_SB(1, 1), b3 + hstep, voffB);
            PG8_WAIT_V(6); PG8_BAR; PG8_MMA(1, 1, At, B1); PG8_BAR;
        }
        PG8_STAMP();
        if constexpr (!Epi::AFTER_DRAIN) { E(acc, cur, wr, wc, fr, fq); S.done(cur); }
        PG8_STAMP();
        if (!has_next) break;
#pragma unroll
        for (int a = 0; a < 2; ++a)
#pragma unroll
            for (int b = 0; b < 2; ++b)
#pragma unroll
                for (int m = 0; m < 4; ++m)
#pragma unroll
                    for (int n = 0; n < 2; ++n) acc[a][b][m][n] = (f32x4){0.f, 0.f, 0.f, 0.f};
        cur = nxt; cA = nA; cB = nB; ++ui;
    }
    PG8_WAIT_V(0);
    if (wr == 0) PG8_BAR;
    PG8_BAR;
    if constexpr (Epi::AFTER_DRAIN) { E.fused(acc, cur, wr, wc, fr, fq, lds, wid, lane); S.done(cur); }
    PG8_STAMP();
    if (STAMP && wid == 0) { stamps[lane] = lane < nts ? (((unsigned long long)(unsigned)ts_hi << 32) | (unsigned)ts_lo) : 0ull;
        if (lane == 62) stamps[62] = rt_entry; if (lane == 63) stamps[63] = (unsigned long long)wall_clock64(); }
#undef PG8_STAMP
#undef PG8_SA
#undef PG8_SB
#undef PG8_STAGE
#undef PG8_LDA
#undef PG8_LDB
#undef PG8_MMA
#undef PG8_WAIT_V
#undef PG8_WAIT_L
#undef PG8_BAR
#undef PG8_SCHED
}
}

#define LAS __attribute__((address_space(3)))
typedef unsigned short bf16_t;
typedef short bf16x8 __attribute__((ext_vector_type(8)));
typedef float f32x4 __attribute__((ext_vector_type(4)));
typedef float f32x2 __attribute__((ext_vector_type(2)));
typedef unsigned u32x4 __attribute__((ext_vector_type(4)));
typedef unsigned u32x2 __attribute__((ext_vector_type(2)));

constexpr int D = 1024, NB = 4, T = 4096, NL = 4, BT = NB * T, BW = 512;
constexpr int DIN = 8320, DINP = 8448;
constexpr int C_PU = 0, C_PG = 512, C_Q = 1024, C_K = 1536, C_V = 2048, C_RG = 2560, C_RW = 3072, C_RWG = 4736, C_GATE = 5248;
constexpr int RW_R = 0, RW_WL = 512, RW_K = 576, RW_V = 1088, RW_AL = 1600, RW_W = 1664;
constexpr int SREC = 896;
constexpr int LDS_BYTES = 131072;

constexpr size_t SZ_WIN = (size_t)DINP * D * 2, SZ_WBR = (size_t)3 * D * BW * 2, SZ_WOUT = (size_t)D * D * 2, SZ_LORA = (size_t)BW * 64 * 2;
constexpr size_t OFF_WIN = 0, OFF_WBR = OFF_WIN + SZ_WIN, OFF_WOUT = OFF_WBR + SZ_WBR, OFF_W2T = OFF_WOUT + SZ_WOUT, OFF_A2T = OFF_W2T + SZ_LORA;
constexpr size_t OFF_MOD = OFF_A2T + SZ_LORA, SZ_MOD = (size_t)NL * NB * 3 * D * 4;
constexpr size_t OFF_COS = OFF_MOD + SZ_MOD, SZ_TAB = (size_t)BT * 64 * 4, OFF_SIN = OFF_COS + SZ_TAB;
constexpr size_t OFF_BONUS = OFF_SIN + SZ_TAB, SZ_BONUS = (size_t)BT * 8 * 4;
constexpr size_t OFF_PROJ = OFF_BONUS + SZ_BONUS, SZ_PROJ = (size_t)BT * DINP * 2;
constexpr size_t OFF_BR = OFF_PROJ + SZ_PROJ, SZ_BR = (size_t)3 * BT * BW * 2;
constexpr size_t OFF_X = OFF_BR + SZ_BR;
constexpr size_t OFF_H = OFF_X;
constexpr size_t OFF_STREAM = OFF_X, SZ_STREAM = (size_t)BT * 8 * SREC;
constexpr size_t OFF_KVT = OFF_STREAM + SZ_STREAM, SZ_KVT = (size_t)16 * 32 * 128 * 128 * 4;
constexpr size_t OFF_RPREV = OFF_KVT + SZ_KVT, SZ_RPREV = SZ_KVT / 2;
constexpr size_t OFF_MERGED = OFF_X, SZ_MERGED = (size_t)BT * D * 4;
constexpr size_t OFF_MERGEDB = OFF_MERGED + SZ_MERGED;
constexpr size_t WS_NEED = OFF_RPREV + SZ_RPREV;

struct Params {
    const float* x; const float* c; const int* pos;
    const float *norm_g, *w_ada, *b_ada, *w_in, *pool_w, *pool_scale, *ret_norm_g, *shift_mu, *w0, *w2, *a0, *a2, *k_k, *k_a, *r_k, *ln_w, *ln_b, *w_branch, *w_out, *final_g;
    float* out; unsigned char* ws;
};

__device__ __forceinline__ float bf2f(unsigned v) { return __uint_as_float(v << 16); }
__device__ __forceinline__ float bflo(unsigned v) { return __uint_as_float(v << 16); }
__device__ __forceinline__ float bfhi(unsigned v) { return __uint_as_float(v & 0xffff0000u); }
__device__ __forceinline__ unsigned pk2(float lo, float hi) { return pg8::cvt_pk_bf16(lo, hi); }
__device__ __forceinline__ bf16_t f2bf(float f) { return (bf16_t)(pk2(f, 0.f) & 0xffffu); }
__device__ __forceinline__ float sigmoidf_(float x) { return 1.0f / (1.0f + __expf(-x)); }
__device__ __forceinline__ float siluf_(float x) { return x / (1.0f + __expf(-x)); }

template <int CTRL> __device__ __forceinline__ float dpp_mov(float v) { return __int_as_float(__builtin_amdgcn_update_dpp(0, __float_as_int(v), CTRL, 0xF, 0xF, false)); }
__device__ __forceinline__ float red16(float v) {
    v += dpp_mov<0xB1>(v);
    v += dpp_mov<0x4E>(v);
    v += dpp_mov<0x141>(v);
    v += dpp_mov<0x140>(v);
    return v;
}
__device__ __forceinline__ float red64(float v) {
    v = red16(v);
    v += __shfl_xor(v, 16); v += __shfl_xor(v, 32);
    return v;
}

constexpr int LDS_LD = 136;
__device__ __forceinline__ void strip_mma(const LAS bf16_t* A, int row0, const LAS bf16_t* Bm, f32x4 (&acc)[8], int fr, int fq) {
#pragma unroll
    for (int kk = 0; kk < 4; ++kk) {
        const bf16x8 a = *(const LAS bf16x8*)(A + (row0 + fr) * LDS_LD + kk * 32 + fq * 8);
#pragma unroll
        for (int n = 0; n < 8; ++n) {
            const bf16x8 b = *(const LAS bf16x8*)(Bm + (n * 16 + fr) * LDS_LD + kk * 32 + fq * 8);
            acc[n] = __builtin_amdgcn_mfma_f32_16x16x32_bf16(a, b, acc[n], 0, 0, 0);
        }
    }
}

struct EpiProj {
    static constexpr bool PERM = true, AFTER_DRAIN = false;
    bf16_t* O;
    __device__ __forceinline__ void operator()(const f32x4 (&acc)[2][2][4][2], const pg8::Unit& u, int wr, int wc, int fr, int fq) const {
        const int row0 = u.pm * 256 + wr * 64 + fr, col0 = u.pn * 256 + wc * 32 + 8 * fq;
#pragma unroll
        for (int ai = 0; ai < 2; ++ai)
#pragma unroll
            for (int m = 0; m < 4; ++m) { bf16_t* rowp = O + (size_t)(row0 + ai * 128 + m * 16) * DINP + col0;
#pragma unroll
                for (int bj = 0; bj < 2; ++bj) { const f32x4 v0 = acc[ai][bj][m][0], v1 = acc[ai][bj][m][1];
                    u32x4 w; w.x = pk2(v0[0], v0[1]); w.y = pk2(v0[2], v0[3]); w.z = pk2(v1[0], v1[1]); w.w = pk2(v1[2], v1[3]);
                    *(u32x4*)(rowp + bj * 128) = w; } }
    }
};
template <int NBR> struct EpiMerge {
    static constexpr bool PERM = true, AFTER_DRAIN = false;
    const bf16_t* proj; float* merged; bf16_t* mergedb;
    __device__ __forceinline__ void operator()(const f32x4 (&acc)[2][2][4][2], const pg8::Unit& u, int wr, int wc, int fr, int fq) const {
        const int row0 = u.pm * 256 + wr * 64 + fr, col0 = u.pn * 256 + wc * 32 + 8 * fq;
#pragma unroll
        for (int ai = 0; ai < 2; ++ai)
#pragma unroll
            for (int m = 0; m < 4; ++m) {
                const size_t row = (size_t)(row0 + ai * 128 + m * 16);
#pragma unroll
                for (int bj = 0; bj < 2; ++bj) {
                    const int col = col0 + bj * 128;
                    const u32x4 lg = *(const u32x4*)(proj + row * DINP + C_GATE + NBR * D + col);
                    const f32x4 v0 = acc[ai][bj][m][0], v1 = acc[ai][bj][m][1];
                    f32x4 o0, o1;
                    o0[0] = sigmoidf_(bflo(lg.x)) * v0[0]; o0[1] = sigmoidf_(bfhi(lg.x)) * v0[1]; o0[2] = sigmoidf_(bflo(lg.y)) * v0[2]; o0[3] = sigmoidf_(bfhi(lg.y)) * v0[3];
                    o1[0] = sigmoidf_(bflo(lg.z)) * v1[0]; o1[1] = sigmoidf_(bfhi(lg.z)) * v1[1]; o1[2] = sigmoidf_(bflo(lg.w)) * v1[2]; o1[3] = sigmoidf_(bfhi(lg.w)) * v1[3];
                    float* mp = merged + row * D + col;
                    if (NBR > 0) { o0 += *(const f32x4*)mp; o1 += *(const f32x4*)(mp + 4); }
                    if (NBR < 2) { *(f32x4*)mp = o0; *(f32x4*)(mp + 4) = o1; }
                    else { u32x4 w; w.x = pk2(o0[0], o0[1]); w.y = pk2(o0[2], o0[3]); w.z = pk2(o1[0], o1[1]); w.w = pk2(o1[2], o1[3]); *(u32x4*)(mergedb + row * D + col) = w; }
                }
            }
    }
};
struct EpiOut {
    static constexpr bool PERM = false, AFTER_DRAIN = false;
    const float* xin; float* xout; const float* gate;
    __device__ __forceinline__ void operator()(const f32x4 (&acc)[2][2][4][2], const pg8::Unit& u, int wr, int wc, int fr, int fq) const {
        const int row0 = u.pm * 256 + wr * 64 + fr, col0 = u.pn * 256 + wc * 32 + 4 * fq;
        const float* gp = gate + (size_t)(u.pm >> 4) * 3 * D + col0;
        f32x4 gv[2][2];
#pragma unroll
        for (int bj = 0; bj < 2; ++bj)
#pragma unroll
            for (int n = 0; n < 2; ++n) gv[bj][n] = *(const f32x4*)(gp + bj * 128 + n * 16);
#pragma unroll
        for (int ai = 0; ai < 2; ++ai)
#pragma unroll
            for (int m = 0; m < 4; ++m) {
                const size_t ro = (size_t)(row0 + ai * 128 + m * 16) * D + col0;
#pragma unroll
                for (int bj = 0; bj < 2; ++bj)
#pragma unroll
                    for (int n = 0; n < 2; ++n) {
                        const f32x4 xi = *(const f32x4*)(xin + ro + bj * 128 + n * 16);
                        *(f32x4*)(xout + ro + bj * 128 + n * 16) = xi + gv[bj][n] * acc[ai][bj][m][n];
                    }
            }
    }
};

__device__ __forceinline__ void phase0(const Params& p, unsigned char* shm) {
    const int tid = tid_(), wid = tid >> 6, lane = tid & 63;
    const int gtid = blockIdx.x * 512 + tid, nth = gridDim.x * 512;
    { u32x4* z = (u32x4*)(p.ws + OFF_WIN + (size_t)DIN * D * 2); const int nz = (DINP - DIN) * D * 2 / 16;
      for (int i = gtid; i < nz; i += nth) z[i] = (u32x4){0u, 0u, 0u, 0u}; }
    { float* COS = (float*)(p.ws + OFF_COS); float* SIN = (float*)(p.ws + OFF_SIN);
      for (int idx = gtid; idx < BT * 64; idx += nth) {
          const int i = idx & 63, tok = idx >> 6;
          double f = 1.0; for (int j = 0; j < i; ++j) f *= 0.8659643233600653;
          const float freq = (float)f;
          const float ang = (float)p.pos[tok] * freq;
          const double ad = (double)ang;
          const double nq = rint(ad * 0.6366197723675814);
          double r = fma(-nq, 1.5707963267948966, ad); r = fma(-nq, 6.123233995736766e-17, r);
          const float rf = (float)r; const float sr = sinf(rf), cr = cosf(rf);
          const int q = ((int)nq) & 3;
          float s, c;
          if (q == 0) { s = sr; c = cr; } else if (q == 1) { s = cr; c = -sr; } else if (q == 2) { s = -sr; c = -cr; } else { s = -cr; c = sr; }
          COS[idx] = c; SIN[idx] = s;
      } }
    float* cs = (float*)shm;
    float* red = cs + 4096;
    for (int i = tid; i < 4096; i += 512) { const int b = i >> 10, k = i & 1023; cs[k * 4 + b] = siluf_(p.c[b * 1024 + k]); }
    __syncthreads();
    float* mod = (float*)(p.ws + OFF_MOD);
    for (int item = blockIdx.x; item < NL * 48; item += gridDim.x) {
        const int l = item / 48, cgp = item % 48, col = cgp * 64 + lane;
        const float* wp = p.w_ada + (size_t)l * D * 3 * D + col;
        const int k0 = wid * 128;
        float a0 = 0.f, a1 = 0.f, a2 = 0.f, a3 = 0.f;
#pragma unroll 8
        for (int k = k0; k < k0 + 128; ++k) { const float w = wp[(size_t)k * 3 * D]; const f32x4 c4 = *(const f32x4*)(cs + k * 4); a0 += w * c4[0]; a1 += w * c4[1]; a2 += w * c4[2]; a3 += w * c4[3]; }
        red[(wid * 4 + 0) * 64 + lane] = a0; red[(wid * 4 + 1) * 64 + lane] = a1; red[(wid * 4 + 2) * 64 + lane] = a2; red[(wid * 4 + 3) * 64 + lane] = a3;
        __syncthreads();
        if (tid < 256) { const int b = tid >> 6; float s = 0.f;
#pragma unroll
            for (int w = 0; w < 8; ++w) s += red[(w * 4 + b) * 64 + lane];
            mod[(size_t)(l * NB + b) * 3 * D + col] = s + p.b_ada[l * 3 * D + col]; }
        __syncthreads();
    }
}

__device__ __forceinline__ void tconv64(const float* src, int ld_src, bf16_t* dst, int ld_dst, int r0, int c0, float* tile) {
    const int tid = tid_();
    { const int r = tid >> 3, cc = (tid & 7) * 8; const float* sp = src + (size_t)(r0 + r) * ld_src + c0 + cc;
      const f32x4 v0 = *(const f32x4*)sp, v1 = *(const f32x4*)(sp + 4); float* tp = tile + r * 65 + cc;
      tp[0] = v0[0]; tp[1] = v0[1]; tp[2] = v0[2]; tp[3] = v0[3]; tp[4] = v1[0]; tp[5] = v1[1]; tp[6] = v1[2]; tp[7] = v1[3]; }
    __syncthreads();
    { const int c = tid >> 3, rc = (tid & 7) * 8; const float* tp = tile + rc * 65 + c;
      u32x4 w; w.x = pk2(tp[0], tp[65]); w.y = pk2(tp[130], tp[195]); w.z = pk2(tp[260], tp[325]); w.w = pk2(tp[390], tp[455]);
      *(u32x4*)(dst + (size_t)(c0 + c) * ld_dst + r0 + rc) = w; }
    __syncthreads();
}
__device__ __forceinline__ void poolfold64(const float* w_in_l, const float* pool_w_l, bf16_t* dst, int k0, int n0, float* lds) {
    const int tid = tid_(), g = n0 >> 7, nb = n0 & 127;
    float* Ain = lds;
    float* Pw = lds + 64 * 129;
    for (int i = tid; i < 64 * 32; i += 512) { const int r = i >> 5, c4 = (i & 31) * 4; const f32x4 v = *(const f32x4*)(w_in_l + (size_t)(k0 + r) * DIN + g * 128 + c4);
        float* tp = Ain + r * 129 + c4; tp[0] = v[0]; tp[1] = v[1]; tp[2] = v[2]; tp[3] = v[3]; }
    for (int i = tid; i < 128 * 16; i += 512) { const int c = i >> 4, n4 = (i & 15) * 4; const f32x4 v = *(const f32x4*)(pool_w_l + (size_t)(g * 128 + c) * 128 + nb + n4);
        float* tp = Pw + c * 65 + n4; tp[0] = v[0]; tp[1] = v[1]; tp[2] = v[2]; tp[3] = v[3]; }
    __syncthreads();
    { const int nn = tid >> 3, rc = (tid & 7) * 8; float acc[8];
#pragma unroll
      for (int i = 0; i < 8; ++i) acc[i] = 0.f;
      for (int c = 0; c < 128; ++c) { const float pw = Pw[c * 65 + nn];
#pragma unroll
          for (int i = 0; i < 8; ++i) acc[i] += Ain[(rc + i) * 129 + c] * pw; }
      u32x4 w; w.x = pk2(acc[0], acc[1]); w.y = pk2(acc[2], acc[3]); w.z = pk2(acc[4], acc[5]); w.w = pk2(acc[6], acc[7]);
      *(u32x4*)(dst + (size_t)(n0 + nn) * D + k0 + rc) = w; }
    __syncthreads();
}
__device__ __forceinline__ void phase_weights(const Params& p, int l, unsigned char* shm) {
    float* tile = (float*)shm;
    bf16_t* Wt_in = (bf16_t*)(p.ws + OFF_WIN); bf16_t* Wt_br = (bf16_t*)(p.ws + OFF_WBR); bf16_t* Wt_out = (bf16_t*)(p.ws + OFF_WOUT);
    bf16_t* W2T = (bf16_t*)(p.ws + OFF_W2T); bf16_t* A2T = (bf16_t*)(p.ws + OFF_A2T);
    const float* w_in_l = p.w_in + (size_t)l * D * DIN;
    constexpr int J_IN = 16 * 130, J_BR = 3 * 8 * 16, J_OUT = 16 * 16, J_LORA = 16;
    constexpr int NJ = J_IN + J_BR + J_OUT + J_LORA;
    for (int job = blockIdx.x; job < NJ; job += gridDim.x) {
        int j = job;
        if (j < J_IN) { const int kt = j & 15, nt = j >> 4;
            if (nt < 8) poolfold64(w_in_l, p.pool_w + (size_t)l * 4 * 128 * 128, Wt_in, kt * 64, nt * 64, tile);
            else tconv64(w_in_l, DIN, Wt_in, D, kt * 64, nt * 64, tile);
            continue; }
        j -= J_IN;
        if (j < J_BR) { const int nb = j / 128, r = j % 128, wt = r & 7, dt = r >> 3;
            tconv64(p.w_branch + ((size_t)l * 3 + nb) * BW * D, D, Wt_br + (size_t)nb * D * BW, BW, wt * 64, dt * 64, tile); continue; }
        j -= J_BR;
        if (j < J_OUT) { const int kt = j & 15, dt = j >> 4; tconv64(p.w_out + (size_t)l * D * D, D, Wt_out, D, kt * 64, dt * 64, tile); continue; }
        j -= J_OUT;
        if (j < 8) tconv64(p.w2 + (size_t)l * 64 * BW, BW, W2T, 64, 0, j * 64, tile);
        else tconv64(p.a2 + (size_t)l * 64 * BW, BW, A2T, 64, 0, (j - 8) * 64, tile);
    }
}
__device__ __forceinline__ void phase_norm(const Params& p, int l, const float* xin) {
    const int tid = tid_(), wid = tid >> 6, lane = tid & 63;
    bf16_t* h = (bf16_t*)(p.ws + OFF_H);
    const float* mod = (const float*)(p.ws + OFF_MOD) + (size_t)l * NB * 3 * D;
    const float* g = p.norm_g + l * D;
    for (int row = blockIdx.x * 8 + wid; row < BT; row += gridDim.x * 8) {
        const int b = row >> 12;
        const float* xp = xin + (size_t)row * D;
        f32x4 v[4]; float ss = 0.f;
#pragma unroll
        for (int j = 0; j < 2; ++j) { v[2 * j] = *(const f32x4*)(xp + j * 512 + lane * 8); v[2 * j + 1] = *(const f32x4*)(xp + j * 512 + lane * 8 + 4); }
#pragma unroll
        for (int j = 0; j < 4; ++j) ss += v[j][0] * v[j][0] + v[j][1] * v[j][1] + v[j][2] * v[j][2] + v[j][3] * v[j][3];
        ss = red64(ss);
        const float rstd = rsqrtf(ss * (1.0f / D) + 1e-6f);
        const float* sh = mod + (size_t)b * 3 * D; const float* sc = sh + D;
#pragma unroll
        for (int j = 0; j < 2; ++j) {
            const int c0 = j * 512 + lane * 8; float o[8];
#pragma unroll
            for (int i = 0; i < 8; ++i) { const float xv = v[2 * j + (i >> 2)][i & 3]; o[i] = xv * rstd * g[c0 + i] * (1.0f + sc[c0 + i]) + sh[c0 + i]; }
            u32x4 w; w.x = pk2(o[0], o[1]); w.y = pk2(o[2], o[3]); w.z = pk2(o[4], o[5]); w.w = pk2(o[6], o[7]);
            *(u32x4*)(h + (size_t)row * D + c0) = w;
        }
    }
}
__device__ __forceinline__ void phase_final_norm(const Params& p) {
    const int tid = tid_(), wid = tid >> 6, lane = tid & 63;
    for (int row = blockIdx.x * 8 + wid; row < BT; row += gridDim.x * 8) {
        float* xp = p.out + (size_t)row * D;
        f32x4 v[4]; float ss = 0.f;
#pragma unroll
        for (int j = 0; j < 4; ++j) v[j] = *(const f32x4*)(xp + j * 256 + lane * 4);
#pragma unroll
        for (int j = 0; j < 4; ++j) ss += v[j][0] * v[j][0] + v[j][1] * v[j][1] + v[j][2] * v[j][2] + v[j][3] * v[j][3];
        ss = red64(ss);
        const float rstd = rsqrtf(ss * (1.0f / D) + 1e-6f);
#pragma unroll
        for (int j = 0; j < 4; ++j) { const f32x4 gg = *(const f32x4*)(p.final_g + j * 256 + lane * 4); *(f32x4*)(xp + j * 256 + lane * 4) = v[j] * rstd * gg; }
    }
}

__device__ __forceinline__ void pool_item(const Params& p, int l, int item) {
    const int tid = tid_(), cv = tid & 63, tl = tid >> 6, c0 = cv * 8, g = c0 >> 7, win = 2 << g;
    const bf16_t* proj = (const bf16_t*)(p.ws + OFF_PROJ);
    bf16_t* br0 = (bf16_t*)(p.ws + OFF_BR);
    const float* ps = p.pool_scale + l * BW + c0;
    float sc[8];
#pragma unroll
    for (int i = 0; i < 8; ++i) sc[i] = ps[i];
    for (int tt = 0; tt < 8; ++tt) {
        const int tok = item * 64 + tl * 8 + tt, tpos = tok & (T - 1);
        const int cnt = min(tpos + 1, win);
        float s[8];
#pragma unroll
        for (int i = 0; i < 8; ++i) s[i] = 0.f;
        u32x4 cur = (u32x4){0u, 0u, 0u, 0u};
        for (int j = 0; j < cnt; ++j) {
            const u32x4 u = *(const u32x4*)(proj + (size_t)(tok - j) * DINP + C_PU + c0);
            if (j == 0) cur = u;
            s[0] += bflo(u.x); s[1] += bfhi(u.x); s[2] += bflo(u.y); s[3] += bfhi(u.y); s[4] += bflo(u.z); s[5] += bfhi(u.z); s[6] += bflo(u.w); s[7] += bfhi(u.w);
        }
        const float inv = 1.0f / (float)cnt;
        const u32x4 gt = *(const u32x4*)(proj + (size_t)tok * DINP + C_PG + c0);
        float uu[8] = {bflo(cur.x), bfhi(cur.x), bflo(cur.y), bfhi(cur.y), bflo(cur.z), bfhi(cur.z), bflo(cur.w), bfhi(cur.w)};
        float gg[8] = {bflo(gt.x), bfhi(gt.x), bflo(gt.y), bfhi(gt.y), bflo(gt.z), bfhi(gt.z), bflo(gt.w), bfhi(gt.w)};
        float o[8];
#pragma unroll
        for (int i = 0; i < 8; ++i) o[i] = (s[i] * inv - uu[i]) * sc[i] * siluf_(gg[i]);
        u32x4 w; w.x = pk2(o[0], o[1]); w.y = pk2(o[2], o[3]); w.z = pk2(o[4], o[5]); w.w = pk2(o[6], o[7]);
        *(u32x4*)(br0 + (size_t)tok * BW + c0) = w;
    }
}

__device__ __forceinline__ float ret_lg(int h) { return h == 0 ? -0.04580368961312479f : h == 1 ? -0.02272007650008353f : h == 2 ? -0.011315313227834146f : -0.005646563141142063f; }

template <bool TRANS> __device__ __forceinline__ void load_rot(const Params& p, LAS bf16_t* dst, int tok0, int col, float scale, float lgt) {
    const bf16_t* proj = (const bf16_t*)(p.ws + OFF_PROJ);
    const float* COS = (const float*)(p.ws + OFF_COS); const float* SIN = (const float*)(p.ws + OFF_SIN);
    for (int u = tid_(); u < 1024; u += 512) {
        const int j = u >> 3, d0 = (u & 7) * 8;
        const bf16_t* sp = proj + (size_t)(tok0 + j) * DINP + col + d0;
        const u32x4 a = *(const u32x4*)sp, b = *(const u32x4*)(sp + 64);
        const float* cp = COS + (size_t)(tok0 + j) * 64 + d0; const float* sn = SIN + (size_t)(tok0 + j) * 64 + d0;
        const f32x4 c0 = *(const f32x4*)cp, c1 = *(const f32x4*)(cp + 4), s0 = *(const f32x4*)sn, s1 = *(const f32x4*)(sn + 4);
        const float x1[8] = {bflo(a.x), bfhi(a.x), bflo(a.y), bfhi(a.y), bflo(a.z), bfhi(a.z), bflo(a.w), bfhi(a.w)};
        const float x2[8] = {bflo(b.x), bfhi(b.x), bflo(b.y), bfhi(b.y), bflo(b.z), bfhi(b.z), bflo(b.w), bfhi(b.w)};
        const float cc[8] = {c0[0], c0[1], c0[2], c0[3], c1[0], c1[1], c1[2], c1[3]};
        const float ss[8] = {s0[0], s0[1], s0[2], s0[3], s1[0], s1[1], s1[2], s1[3]};
        const float sc = (lgt != 0.f) ? scale * exp2f(lgt * (float)(127 - j)) : scale;
        float o1[8], o2[8];
#pragma unroll
        for (int i = 0; i < 8; ++i) { o1[i] = (x1[i] * cc[i] - x2[i] * ss[i]) * sc; o2[i] = (x1[i] * ss[i] + x2[i] * cc[i]) * sc; }
        if (TRANS) {
#pragma unroll
            for (int i = 0; i < 8; ++i) { dst[(d0 + i) * LDS_LD + j] = f2bf(o1[i]); dst[(d0 + 64 + i) * LDS_LD + j] = f2bf(o2[i]); }
        } else {
            u32x4 w1, w2; w1.x = pk2(o1[0], o1[1]); w1.y = pk2(o1[2], o1[3]); w1.z = pk2(o1[4], o1[5]); w1.w = pk2(o1[6], o1[7]);
            w2.x = pk2(o2[0], o2[1]); w2.y = pk2(o2[2], o2[3]); w2.z = pk2(o2[4], o2[5]); w2.w = pk2(o2[6], o2[7]);
            *(LAS u32x4*)(dst + j * LDS_LD + d0) = w1; *(LAS u32x4*)(dst + j * LDS_LD + d0 + 64) = w2;
        }
    }
}
__device__ __forceinline__ void load_vT(const Params& p, LAS bf16_t* dst, int tok0, int col) {
    const bf16_t* proj = (const bf16_t*)(p.ws + OFF_PROJ);
    for (int u = tid_(); u < 2048; u += 512) {
        const int j = u >> 4, e0 = (u & 15) * 8;
        const u32x4 a = *(const u32x4*)(proj + (size_t)(tok0 + j) * DINP + col + e0);
        dst[(e0 + 0) * LDS_LD + j] = (bf16_t)(a.x & 0xffffu); dst[(e0 + 1) * LDS_LD + j] = (bf16_t)(a.x >> 16);
        dst[(e0 + 2) * LDS_LD + j] = (bf16_t)(a.y & 0xffffu); dst[(e0 + 3) * LDS_LD + j] = (bf16_t)(a.y >> 16);
        dst[(e0 + 4) * LDS_LD + j] = (bf16_t)(a.z & 0xffffu); dst[(e0 + 5) * LDS_LD + j] = (bf16_t)(a.z >> 16);
        dst[(e0 + 6) * LDS_LD + j] = (bf16_t)(a.w & 0xffffu); dst[(e0 + 7) * LDS_LD + j] = (bf16_t)(a.w >> 16);
    }
}

__device__ __forceinline__ void ret_r1_item(const Params& p, int item, LAS bf16_t* lds) {
    const int tid = tid_(), wid = tid >> 6, lane = tid & 63, fr = lane & 15, fq = lane >> 4;
    const int n = item & 31, bh = item >> 5, h = bh & 3, b = bh >> 2, tok0 = b * T + n * 128;
    LAS bf16_t* KT = lds; LAS bf16_t* VT = lds + 128 * LDS_LD;
    load_rot<true>(p, KT, tok0, C_K + h * 128, 0.08838834764831845f, ret_lg(h));
    load_vT(p, VT, tok0, C_V + h * 128);
    __syncthreads();
    f32x4 acc[8];
#pragma unroll
    for (int i = 0; i < 8; ++i) acc[i] = (f32x4){0.f, 0.f, 0.f, 0.f};
    strip_mma(VT, wid * 16, KT, acc, fr, fq);
    float* kvT = (float*)(p.ws + OFF_KVT) + ((size_t)item << 14);
#pragma unroll
    for (int nn = 0; nn < 8; ++nn)
#pragma unroll
        for (int jj = 0; jj < 4; ++jj) kvT[(wid * 16 + fq * 4 + jj) * 128 + nn * 16 + fr] = acc[nn][jj];
    __syncthreads();
}

__device__ __forceinline__ void rwkv_prep_item(const Params& p, int l, int item, LAS bf16_t* lds) {
    const int tid = tid_(), wid = tid >> 6, lane = tid & 63, fr = lane & 15, fq = lane >> 4;
    const bf16_t* proj = (const bf16_t*)(p.ws + OFF_PROJ);
    const int tok0 = item * 16;
    LAS bf16_t* Aw = lds;
    LAS bf16_t* Aa = lds + 16 * 72;
    const float* mu = p.shift_mu + l * RW_W;
    {
        const int tt = tid >> 5, cc = (tid & 31) * 4, tok = tok0 + tt;
        const int ch = cc < 64 ? RW_WL + cc : RW_AL + (cc - 64);
        const u32x2 cu = *(const u32x2*)(proj + (size_t)tok * DINP + C_RW + ch);
        u32x2 pu = (u32x2){0u, 0u};
        if ((tok & (T - 1)) != 0) pu = *(const u32x2*)(proj + (size_t)(tok - 1) * DINP + C_RW + ch);
        const float xc[4] = {bflo(cu.x), bfhi(cu.x), bflo(cu.y), bfhi(cu.y)}, xp[4] = {bflo(pu.x), bfhi(pu.x), bflo(pu.y), bfhi(pu.y)};
        float o[4];
#pragma unroll
        for (int i = 0; i < 4; ++i) { o[i] = xc[i] + (xp[i] - xc[i]) * mu[ch + i]; if (cc < 64) o[i] = tanhf(o[i]); }
        LAS bf16_t* dp = (cc < 64 ? Aw + tt * 72 + cc : Aa + tt * 72 + (cc - 64));
        u32x2 w; w.x = pk2(o[0], o[1]); w.y = pk2(o[2], o[3]); *(LAS u32x2*)dp = w;
    }
    __syncthreads();
    const bf16_t* W2T = (const bf16_t*)(p.ws + OFF_W2T); const bf16_t* A2T = (const bf16_t*)(p.ws + OFF_A2T);
    f32x4 lw[4], la[4];
#pragma unroll
    for (int n = 0; n < 4; ++n) { lw[n] = (f32x4){0.f, 0.f, 0.f, 0.f}; la[n] = (f32x4){0.f, 0.f, 0.f, 0.f}; }
#pragma unroll
    for (int kk = 0; kk < 2; ++kk) {
        const bf16x8 aw = *(const LAS bf16x8*)(Aw + fr * 72 + kk * 32 + fq * 8);
        const bf16x8 aa = *(const LAS bf16x8*)(Aa + fr * 72 + kk * 32 + fq * 8);
#pragma unroll
        for (int n = 0; n < 4; ++n) {
            const int chn = wid * 64 + n * 16 + fr;
            const bf16x8 bw = *(const bf16x8*)(W2T + (size_t)chn * 64 + kk * 32 + fq * 8);
            const bf16x8 ba = *(const bf16x8*)(A2T + (size_t)chn * 64 + kk * 32 + fq * 8);
            lw[n] = __builtin_amdgcn_mfma_f32_16x16x32_bf16(aw, bw, lw[n], 0, 0, 0);
            la[n] = __builtin_amdgcn_mfma_f32_16x16x32_bf16(aa, ba, la[n], 0, 0, 0);
        }
    }
    const float* w0 = p.w0 + l * BW; const float* a0 = p.a0 + l * BW; const float* k_k = p.k_k + l * BW; const float* k_a = p.k_a + l * BW; const float* r_k = p.r_k + l * BW;
    unsigned char* stream = p.ws + OFF_STREAM; float* bonus = (float*)(p.ws + OFF_BONUS);
#pragma unroll
    for (int jj = 0; jj < 4; ++jj) {
        const int tok = tok0 + fq * 4 + jj, tpos = tok & (T - 1), b = tok >> 12;
        const bool hasp = tpos != 0;
        const bf16_t* pc = proj + (size_t)tok * DINP + C_RW; const bf16_t* pp = pc - DINP;
        float rr[4], kk2[4], vv[4], dec[4], aa[4], kkn[4]; float ssq = 0.f, bsum = 0.f;
#pragma unroll
        for (int n = 0; n < 4; ++n) {
            const int ch = wid * 64 + n * 16 + fr;
            const float rc = bf2f(pc[RW_R + ch]), kc = bf2f(pc[RW_K + ch]), vc = bf2f(pc[RW_V + ch]);
            const float rp = hasp ? bf2f(pp[RW_R + ch]) : 0.f, kp = hasp ? bf2f(pp[RW_K + ch]) : 0.f, vp = hasp ? bf2f(pp[RW_V + ch]) : 0.f;
            const float r = rc + (rp - rc) * mu[RW_R + ch], k = kc + (kp - kc) * mu[RW_K + ch], v = vc + (vp - vc) * mu[RW_V + ch];
            const float z = -(w0[ch] + lw[n][jj]);
            const float sp = fmaxf(z, 0.f) + log1pf(__expf(-fabsf(z)));
            const float wl = -sp - 0.5f;
            dec[n] = __expf(-__expf(wl));
            const float a = sigmoidf_(a0[ch] + la[n][jj]);
            const float kkv = k * k_k[ch];
            ssq += kkv * kkv; kkn[n] = kkv;
            const float k2 = k * (1.0f + (a - 1.0f) * k_a[ch]);
            bsum += r * k2 * r_k[ch];
            rr[n] = r; kk2[n] = k2; vv[n] = v; aa[n] = a;
        }
        ssq = red16(ssq); bsum = red16(bsum);
        const float inv = 1.0f / fmaxf(sqrtf(ssq), 1e-12f);
        unsigned char* rec = stream + ((size_t)(b * 8 + wid) * T + tpos) * SREC;
#pragma unroll
        for (int n = 0; n < 4; ++n) {
            const int c = n * 16 + fr; const float kn = kkn[n] * inv;
            ((float*)rec)[c] = dec[n];
            ((bf16_t*)(rec + 256))[c] = f2bf(rr[n]);
            ((bf16_t*)(rec + 384))[c] = f2bf(kk2[n]);
            ((bf16_t*)(rec + 512))[c] = f2bf(-kn);
            ((bf16_t*)(rec + 640))[c] = f2bf(kn * aa[n]);
            ((bf16_t*)(rec + 768))[c] = f2bf(vv[n]);
        }
        if (fr == 0) bonus[(size_t)tok * 8 + wid] = bsum;
    }
    __syncthreads();
}

__device__ __forceinline__ void ret_r2(const Params& p) {
    const float* kvT = (const float*)(p.ws + OFF_KVT); bf16_t* rp = (bf16_t*)(p.ws + OFF_RPREV);
    const int gtid = blockIdx.x * 512 + tid_(), nth = gridDim.x * 512;
    for (int i2 = gtid; i2 < 16 * 8192; i2 += nth) {
        const int bh = i2 >> 13, ed = (i2 & 8191) * 2, h = bh & 3;
        const float cd = exp2f(128.0f * ret_lg(h));
        float r0 = 0.f, r1 = 0.f;
        for (int n = 0; n < 32; ++n) {
            const size_t o = ((size_t)(bh * 32 + n) << 14) + ed;
            *(unsigned*)(rp + o) = pk2(r0, r1);
            const f32x2 kv = *(const f32x2*)(kvT + o);
            r0 = cd * r0 + kv[0]; r1 = cd * r1 + kv[1];
        }
    }
}

constexpr int SCH = 32;
constexpr int SREC_F = 384;
__device__ __forceinline__ void rwkv_scan_item(const Params& p, int item, LAS float* lds) {
    const int tid = tid_(), wid = tid >> 6, lane = tid & 63;
    const int bh = (item & 7) + 8 * ((item >> 3) & 3), rg = item >> 5, b = bh >> 3, h = bh & 7;
    const unsigned char* sbase = p.ws + OFF_STREAM + (size_t)bh * T * SREC;
    constexpr int NCH = T / SCH, NV = SCH * SREC / 16;
    const bool loader = wid >= 2;
    const int lt = tid - 128;
    u32x4 reg[5];
    auto ld = [&](int c) {
        const u32x4* src = (const u32x4*)(sbase + (size_t)c * SCH * SREC);
#pragma unroll
        for (int i = 0; i < 5; ++i) { const int v = lt + i * 384; if (v < NV) reg[i] = src[v]; }
    };
    auto st = [&](int buf) {
        LAS float* dst = lds + buf * (SCH * SREC_F);
#pragma unroll
        for (int i = 0; i < 5; ++i) { const int v = lt + i * 384; if (v < NV) {
            const int s = v / 56, wi = v % 56; const u32x4 r = reg[i];
            if (wi < 16) { *(LAS u32x4*)(dst + s * SREC_F + wi * 4) = r; }
            else { const int a = (wi - 16) >> 3, pos = ((wi - 16) & 7) * 8; LAS float* d = dst + s * SREC_F + 64 + a * 64 + pos;
                *(LAS f32x4*)d = (f32x4){bflo(r.x), bfhi(r.x), bflo(r.y), bfhi(r.y)}; *(LAS f32x4*)(d + 4) = (f32x4){bflo(r.z), bfhi(r.z), bflo(r.w), bfhi(r.w)}; }
        } }
    };
    if (loader) { ld(0); st(0); ld(1); }
    __syncthreads();
    const int rr = lane >> 4, q = lane & 15, row = rg * 8 + (wid & 1) * 4 + rr;
    f32x4 S = (f32x4){0.f, 0.f, 0.f, 0.f};
    bf16_t* proj = (bf16_t*)(p.ws + OFF_PROJ);
    float* yout = (float*)(proj + (size_t)(b * T) * DINP + C_RW) + h * 64 + row;
    for (int c = 0; c < NCH; ++c) {
        if (loader) {
            if (c + 1 < NCH) st((c + 1) & 1);
            if (c + 2 < NCH) ld(c + 2);
        } else {
            const LAS float* base = lds + (c & 1) * (SCH * SREC_F) + q * 4;
            const LAS float* vb = lds + (c & 1) * (SCH * SREC_F) + 320 + row;
            float* yo = yout + (size_t)(c * SCH) * (DINP / 2);
#pragma unroll 4
            for (int s = 0; s < SCH; ++s) {
                const f32x4 w4 = *(const LAS f32x4*)(base + s * SREC_F);
                const f32x4 r4 = *(const LAS f32x4*)(base + s * SREC_F + 64);
                const f32x4 k4 = *(const LAS f32x4*)(base + s * SREC_F + 128);
                const f32x4 a4 = *(const LAS f32x4*)(base + s * SREC_F + 192);
                const f32x4 b4 = *(const LAS f32x4*)(base + s * SREC_F + 256);
                const float vv = vb[s * SREC_F];
                float pa = (S[0] * a4[0] + S[1] * a4[1]) + (S[2] * a4[2] + S[3] * a4[3]);
                pa = red16(pa);
                const f32x4 tmp = S * w4 + vv * k4;
                S = tmp + pa * b4;
                float y = (S[0] * r4[0] + S[1] * r4[1]) + (S[2] * r4[2] + S[3] * r4[3]);
                y = red16(y);
                if (q == 0) yo[(size_t)s * (DINP / 2)] = y;
            }
        }
        __syncthreads();
    }
}

__device__ __forceinline__ void ret_r3_item(const Params& p, int l, int item, LAS bf16_t* lds) {
    const int tid = tid_(), wid = tid >> 6, lane = tid & 63, fr = lane & 15, fq = lane >> 4;
    const int n = item & 31, bh = item >> 5, h = bh & 3, b = bh >> 2, tok0 = b * T + n * 128;
    const float lg = ret_lg(h);
    LAS bf16_t* Q = lds; LAS bf16_t* Kk = lds + 128 * LDS_LD; LAS bf16_t* VT = lds + 2 * 128 * LDS_LD;
    load_rot<false>(p, Q, tok0, C_Q + h * 128, 1.0f, 0.f);
    load_rot<false>(p, Kk, tok0, C_K + h * 128, 0.08838834764831845f, 0.f);
    load_vT(p, VT, tok0, C_V + h * 128);
    __syncthreads();
    const int i0 = wid * 16;
    f32x4 acc[8];
#pragma unroll
    for (int i = 0; i < 8; ++i) acc[i] = (f32x4){0.f, 0.f, 0.f, 0.f};
    strip_mma(Q, i0, Kk, acc, fr, fq);
    __syncthreads();
    LAS bf16_t* P = Kk;
#pragma unroll
    for (int nn = 0; nn < 8; ++nn)
#pragma unroll
        for (int jj = 0; jj < 4; ++jj) {
            const int i = i0 + fq * 4 + jj, j = nn * 16 + fr;
            const float m = (i >= j) ? exp2f(lg * (float)(i - j)) : 0.f;
            P[i * LDS_LD + j] = f2bf(acc[nn][jj] * m);
        }
    __syncthreads();
#pragma unroll
    for (int i = 0; i < 8; ++i) acc[i] = (f32x4){0.f, 0.f, 0.f, 0.f};
    {
        const bf16_t* rp = (const bf16_t*)(p.ws + OFF_RPREV) + ((size_t)item << 14);
#pragma unroll
        for (int kk = 0; kk < 4; ++kk) {
            const bf16x8 a = *(const LAS bf16x8*)(Q + (i0 + fr) * LDS_LD + kk * 32 + fq * 8);
#pragma unroll
            for (int nn = 0; nn < 8; ++nn) {
                const bf16x8 bb = *(const bf16x8*)(rp + (nn * 16 + fr) * 128 + kk * 32 + fq * 8);
                acc[nn] = __builtin_amdgcn_mfma_f32_16x16x32_bf16(a, bb, acc[nn], 0, 0, 0);
            }
        }
#pragma unroll
        for (int jj = 0; jj < 4; ++jj) { const float sc = exp2f(lg * (float)(i0 + fq * 4 + jj + 1));
#pragma unroll
            for (int nn = 0; nn < 8; ++nn) acc[nn][jj] *= sc; }
    }
    strip_mma(P, i0, VT, acc, fr, fq);
    const bf16_t* proj = (const bf16_t*)(p.ws + OFF_PROJ);
    bf16_t* br1 = (bf16_t*)(p.ws + OFF_BR) + (size_t)BT * BW;
    const float* gn = p.ret_norm_g + l * BW + h * 128;
#pragma unroll
    for (int jj = 0; jj < 4; ++jj) {
        float s = 0.f;
#pragma unroll
        for (int nn = 0; nn < 8; ++nn) s += acc[nn][jj];
        s = red16(s); const float mean = s * (1.0f / 128.0f);
        float vs = 0.f;
#pragma unroll
        for (int nn = 0; nn < 8; ++nn) { const float d = acc[nn][jj] - mean; vs += d * d; }
        vs = red16(vs); const float rstd = rsqrtf(vs * (1.0f / 128.0f) + 1e-5f);
        const size_t tok = (size_t)(tok0 + i0 + fq * 4 + jj);
#pragma unroll
        for (int nn = 0; nn < 8; ++nn) { const int e = nn * 16 + fr;
            const float gt = bf2f(proj[tok * DINP + C_RG + h * 128 + e]);
            br1[tok * BW + h * 128 + e] = f2bf((acc[nn][jj] - mean) * rstd * gn[e] * siluf_(gt)); }
    }
    __syncthreads();
}

__device__ __forceinline__ void rwkv_post(const Params& p, int l) {
    const bf16_t* proj = (const bf16_t*)(p.ws + OFF_PROJ);
    bf16_t* br2 = (bf16_t*)(p.ws + OFF_BR) + (size_t)2 * BT * BW;
    const float* bonus = (const float*)(p.ws + OFF_BONUS);
    const unsigned char* stream = p.ws + OFF_STREAM;
    const float* ln_w = p.ln_w + l * BW; const float* ln_b = p.ln_b + l * BW;
    const int gtid = blockIdx.x * 512 + tid_(), nth = gridDim.x * 512;
    for (int idx = gtid; idx < BT * 128; idx += nth) {
        const int tok = idx >> 7, h = (idx >> 4) & 7, q = idx & 15, ch = h * 64 + q * 4, b = tok >> 12, tpos = tok & (T - 1);
        const f32x4 y = *(const f32x4*)((const float*)(proj + (size_t)tok * DINP + C_RW) + ch);
        float s = (y[0] + y[1]) + (y[2] + y[3]); s = red16(s); const float mean = s * (1.0f / 64.0f);
        const f32x4 d = y - mean;
        float vs = (d[0] * d[0] + d[1] * d[1]) + (d[2] * d[2] + d[3] * d[3]); vs = red16(vs);
        const float rstd = rsqrtf(vs * (1.0f / 64.0f) + 64e-5f);
        const u32x2 vv = *(const u32x2*)(stream + ((size_t)(b * 8 + h) * T + tpos) * SREC + 768 + q * 8);
        const u32x2 gg = *(const u32x2*)(proj + (size_t)tok * DINP + C_RWG + ch);
        const float bs = bonus[(size_t)tok * 8 + h];
        const float v4[4] = {bflo(vv.x), bfhi(vv.x), bflo(vv.y), bfhi(vv.y)}, g4[4] = {bflo(gg.x), bfhi(gg.x), bflo(gg.y), bfhi(gg.y)};
        float o[4];
#pragma unroll
        for (int i = 0; i < 4; ++i) o[i] = (d[i] * rstd * ln_w[ch + i] + ln_b[ch + i] + bs * v4[i]) * siluf_(g4[i]);
        u32x2 w; w.x = pk2(o[0], o[1]); w.y = pk2(o[2], o[3]);
        *(u32x2*)(br2 + (size_t)tok * BW + ch) = w;
    }
}


__device__ __forceinline__ void gemm_inproj(const Params& p, LAS unsigned char* lds) {
    pg8::Gemm g{(const bf16_t*)(p.ws + OFF_H), (const bf16_t*)(p.ws + OFF_WIN), BT, DINP, D}; pg8::StaticOrder S; S.init(BT, DINP, (int)gridDim.x, (int)blockIdx.x); EpiProj E{(bf16_t*)(p.ws + OFF_PROJ)};
    pg8::gemm_phase<EpiProj, pg8::StaticOrder, false>(lds, g, S, E, nullptr);
}
template <int NBR> __device__ __forceinline__ void gemm_merge1(const Params& p, LAS unsigned char* lds) {
    const bf16_t* br = (const bf16_t*)(p.ws + OFF_BR); const bf16_t* Wt_br = (const bf16_t*)(p.ws + OFF_WBR);
    pg8::StaticOrder S; S.init(BT, D, (int)gridDim.x, (int)blockIdx.x);
    pg8::Gemm g{br + (size_t)NBR * BT * BW, Wt_br + (size_t)NBR * D * BW, BT, D, BW};
    EpiMerge<NBR> E{(const bf16_t*)(p.ws + OFF_PROJ), (float*)(p.ws + OFF_MERGED), (bf16_t*)(p.ws + OFF_MERGEDB)};
    pg8::gemm_phase<EpiMerge<NBR>, pg8::StaticOrder, false>(lds, g, S, E, nullptr);
}
__device__ __forceinline__ void gemm_merge(const Params& p, LAS unsigned char* lds) { gemm_merge1<0>(p, lds); gemm_merge1<1>(p, lds); gemm_merge1<2>(p, lds); }
__device__ __forceinline__ void gemm_out(const Params& p, int l, const float* xin, LAS unsigned char* lds) {
    pg8::Gemm g{(const bf16_t*)(p.ws + OFF_MERGEDB), (const bf16_t*)(p.ws + OFF_WOUT), BT, D, D}; pg8::StaticOrder S; S.init(BT, D, (int)gridDim.x, (int)blockIdx.x);
    EpiOut E{xin, p.out, (const float*)(p.ws + OFF_MOD) + (size_t)l * NB * 3 * D + 2 * D};
    pg8::gemm_phase<EpiOut, pg8::StaticOrder, false>(lds, g, S, E, nullptr);
}
#if defined(__HIP_DEVICE_COMPILE__)
#define FRESH_PARAMS(q) Params q; { const __attribute__((address_space(4))) Params* pp_ = (const __attribute__((address_space(4))) Params*)__builtin_amdgcn_kernarg_segment_ptr(); asm volatile("" : "+s"(pp_)); q = *pp_; }
#else
#define FRESH_PARAMS(q) Params q = p_unused;
#endif
__global__ void __launch_bounds__(512, 2) fwd_megakernel(Params p_unused) {
    extern __shared__ __attribute__((aligned(16))) unsigned char shm[];
    cg::grid_group grid = cg::this_grid();
    LAS unsigned char* lds = (LAS unsigned char*)shm;
    const int G = (int)gridDim.x, bid = (int)blockIdx.x;

    { FRESH_PARAMS(p); phase0(p, shm); }
    grid.sync();

#pragma nounroll
    for (int l = 0; l < NL; ++l) {
        { FRESH_PARAMS(p); phase_weights(p, l, shm); }
        { FRESH_PARAMS(p); phase_norm(p, l, (l == 0) ? p.x : p.out); }
        grid.sync();
        { FRESH_PARAMS(p); gemm_inproj(p, lds); }
        grid.sync();
        { FRESH_PARAMS(p); for (int it = bid; it < BT / 64; it += G) pool_item(p, l, it); }
        { FRESH_PARAMS(p); for (int it = bid; it < 512; it += G) ret_r1_item(p, it, (LAS bf16_t*)lds); }
        { FRESH_PARAMS(p); for (int it = bid; it < BT / 16; it += G) rwkv_prep_item(p, l, it, (LAS bf16_t*)lds); }
        grid.sync();
        { FRESH_PARAMS(p); ret_r2(p); }
        { FRESH_PARAMS(p); for (int it = bid; it < 256; it += G) rwkv_scan_item(p, it, (LAS float*)lds); }
        grid.sync();
        { FRESH_PARAMS(p); for (int it = bid; it < 512; it += G) ret_r3_item(p, l, it, (LAS bf16_t*)lds); }
        { FRESH_PARAMS(p); rwkv_post(p, l); }
        grid.sync();
        { FRESH_PARAMS(p); gemm_merge1<0>(p, lds); }
        { FRESH_PARAMS(p); gemm_merge1<1>(p, lds); }
        { FRESH_PARAMS(p); gemm_merge1<2>(p, lds); }
        grid.sync();
        { FRESH_PARAMS(p); gemm_out(p, l, (l == 0) ? p.x : p.out, lds); }
        grid.sync();
    }
    { FRESH_PARAMS(p); phase_final_norm(p); }
}

extern "C" void kernel_launch(void* const* d_in, const int* in_sizes, int n_in, void* d_out, int out_size, void* d_ws, size_t ws_size, hipStream_t stream) {
    (void)in_sizes; (void)n_in; (void)out_size;
    if (ws_size < WS_NEED) { fprintf(stderr, "workspace too small: %zu < %zu\n", ws_size, (size_t)WS_NEED); return; }
    static int grid_blocks = 0;
    if (!grid_blocks) {
        int dev = 0, cus = 0, per_cu = 0;
        hipGetDevice(&dev);
        hipDeviceGetAttribute(&cus, hipDeviceAttributeMultiprocessorCount, dev);
        hipFuncSetAttribute((const void*)fwd_megakernel, hipFuncAttributeMaxDynamicSharedMemorySize, LDS_BYTES);
        hipOccupancyMaxActiveBlocksPerMultiprocessor(&per_cu, fwd_megakernel, 512, LDS_BYTES);
        if (per_cu < 1) per_cu = 1;
        grid_blocks = cus * per_cu;
        if (grid_blocks > 256) grid_blocks = 256;
    }
    Params p{};
    p.x = (const float*)d_in[0]; p.c = (const float*)d_in[1]; p.pos = (const int*)d_in[2];
    p.norm_g = (const float*)d_in[3]; p.w_ada = (const float*)d_in[4]; p.b_ada = (const float*)d_in[5]; p.w_in = (const float*)d_in[6];
    p.pool_w = (const float*)d_in[7]; p.pool_scale = (const float*)d_in[8]; p.ret_norm_g = (const float*)d_in[9]; p.shift_mu = (const float*)d_in[10];
    p.w0 = (const float*)d_in[11]; p.w2 = (const float*)d_in[12]; p.a0 = (const float*)d_in[13]; p.a2 = (const float*)d_in[14];
    p.k_k = (const float*)d_in[15]; p.k_a = (const float*)d_in[16]; p.r_k = (const float*)d_in[17]; p.ln_w = (const float*)d_in[18]; p.ln_b = (const float*)d_in[19];
    p.w_branch = (const float*)d_in[20]; p.w_out = (const float*)d_in[21]; p.final_g = (const float*)d_in[22];
    p.out = (float*)d_out; p.ws = (unsigned char*)d_ws;
    void* args[] = {&p};
    hipError_t e = hipLaunchCooperativeKernel((const void*)fwd_megakernel, dim3(grid_blocks), dim3(512), args, LDS_BYTES, stream);
    if (e != hipSuccess) fprintf(stderr, "cooperative launch failed: %s (grid %d)\n", hipGetErrorString(e), grid_blocks);
}
```

```cpp
#include <hip/hip_runtime.h>
#include <hip/hip_cooperative_groups.h>
#include <cstdio>
namespace cg = cooperative_groups;

__device__ __forceinline__ int tid_() { int t = (int)__builtin_amdgcn_workitem_id_x(); asm volatile("" : "+v"(t)); return t; }
#define LAS __attribute__((address_space(3)))

#define XB_TMO      128
#define XB_XCNT(j)  (256  + 64 * (j))
#define XB_XSUB(j)  (1280 + 64 * (j))
#define XB_XGEN(j)  (2304 + 64 * (j))
#define XB_TOP      3328
#define XB_TOPGEN   3392
#define XCD_BAR_WORDS 3456
#define XB_SPIN_CAP (1u << 18)

__device__ __forceinline__ unsigned xb_ld(unsigned* p)              { return __hip_atomic_load(p, __ATOMIC_RELAXED, __HIP_MEMORY_SCOPE_AGENT); }
__device__ __forceinline__ unsigned xb_add(unsigned* p, unsigned v) { return __hip_atomic_fetch_add(p, v, __ATOMIC_RELAXED, __HIP_MEMORY_SCOPE_AGENT); }
__device__ __forceinline__ unsigned xb_xcc_id() { return (unsigned)__builtin_amdgcn_s_getreg((3 << 11) | 20) & 0xFu; }
#define XB_SPIN(cond, bar) do { unsigned _sp = 0; while (cond) { __builtin_amdgcn_s_sleep(1); \
    if ((++_sp & 255u) == 0u) { if (xb_ld(&(bar)[XB_TMO])) break; if (_sp > XB_SPIN_CAP) { atomicAdd(&(bar)[XB_TMO], 1u); break; } } } } while (0)

struct XcdBarrier {
    unsigned* bar; unsigned x;
    volatile LAS unsigned* st;
};

__device__ __forceinline__ XcdBarrier xcd_barrier_post(unsigned* bar, volatile LAS unsigned* st) {
    XcdBarrier b; b.bar = bar; b.x = xb_xcc_id(); b.st = st;
    if (tid_() == 0) (void)xb_add(&bar[XB_XCNT(b.x)], 1u);
    return b;
}
__device__ __forceinline__ void xcd_barrier_complete(unsigned* bar, unsigned x, unsigned& nloc, unsigned& nx) {
    const unsigned G = gridDim.x * gridDim.y * gridDim.z;
    unsigned sum, cnt, mine, sp = 0u;
    for (;;) {
        sum = 0u; cnt = 0u; mine = 0u;
#pragma unroll
        for (unsigned j = 0; j < 16; ++j) { const unsigned c = xb_ld(&bar[XB_XCNT(j)]); sum += c; cnt += (c > 0u) ? 1u : 0u; mine = (j == x) ? c : mine; }
        if (sum == G) break;
        __builtin_amdgcn_s_sleep(1);
        if ((++sp & 255u) == 0u) { if (xb_ld(&bar[XB_TMO])) break; if (sp > XB_SPIN_CAP) { atomicAdd(&bar[XB_TMO], 1u); break; } }
    }
    nloc = mine > 0u ? mine : 1u; nx = cnt > 0u ? cnt : 1u;
}

__device__ __forceinline__ void xcd_barrier(const XcdBarrier& b) {
    asm volatile("s_waitcnt vmcnt(0)" ::: "memory");
    __syncthreads();
    if (tid_() == 0) {
        unsigned* bar = b.bar;
        __builtin_amdgcn_s_waitcnt(0);
        unsigned nloc = b.st[0], nx = b.st[1];
        if (nloc == 0u) { xcd_barrier_complete(bar, b.x, nloc, nx); b.st[0] = nloc; b.st[1] = nx; }
        const unsigned old = xb_add(&bar[XB_XSUB(b.x)], 1u);
        const unsigned gen = old / nloc;
        if (old + 1u == (gen + 1u) * nloc) {
            __builtin_amdgcn_fence(__ATOMIC_RELEASE, "agent");
            asm volatile("s_waitcnt vmcnt(0)" ::: "memory");
            const unsigned og = xb_add(&bar[XB_TOP], 1u);
            const unsigned tg = og / nx;
            if (og + 1u == (tg + 1u) * nx) xb_add(&bar[XB_TOPGEN], 1u);
            else XB_SPIN(xb_ld(&bar[XB_TOPGEN]) == tg, bar);
            __builtin_amdgcn_fence(__ATOMIC_ACQUIRE, "agent");
            xb_add(&bar[XB_XGEN(b.x)], 1u);
            asm volatile("s_waitcnt vmcnt(0)" ::: "memory");
        } else {
            XB_SPIN(xb_ld(&bar[XB_XGEN(b.x)]) == gen, bar);
            __builtin_amdgcn_fence(__ATOMIC_ACQUIRE, "agent");
            asm volatile("s_waitcnt vmcnt(0)" ::: "memory");
        }
    }
    __syncthreads();
}
namespace pg8 {
#define PG8_LAS __attribute__((address_space(3)))
typedef unsigned short bf16_t;
typedef short bf16x8 __attribute__((ext_vector_type(8)));
typedef float f32x4 __attribute__((ext_vector_type(4)));
typedef unsigned u32x4 __attribute__((ext_vector_type(4)));
constexpr int BM = 256, BK = 64, HALF = 128, HTB = HALF * BK * 2  , STAGE_BYTES = 8 * HTB, NXCD = 8, WGM = 8;

__host__ __device__ __forceinline__ int lds_byte(int r, int c) { const int st = (r >> 4) * 2 + (c >> 5), rr = r & 15, cc = c & 31, ob = rr * 64 + cc * 2; return st * 1024 + (ob ^ (((ob >> 9) & 1) << 5)); }
__host__ __device__ __forceinline__ void stage_rc(int b, int& R, int& C) { const int st = b / 1024, sb = b % 1024, swz = sb ^ (((sb >> 9) & 1) << 5); R = (st >> 1) * 16 + swz / 64; C = (st & 1) * 32 + (swz % 64) / 2; }
__host__ __device__ __forceinline__ int perm32(int rho) { const int n = rho >> 4, i = rho & 15; return 8 * (i >> 2) + 4 * n + (i & 3); }

struct Unit { int pm, pn; };
struct Gemm { const bf16_t* A; const bf16_t* Bt; int M, N, K; };

struct StaticOrder {
    int nM, nN, nwg, G, c;
    __host__ __device__ void init(int M, int N, int G_, int c_) { nM = M / BM; nN = N / BM; nwg = nM * nN; G = G_; c = c_; }
    __host__ __device__ bool next(int i, Unit& u) const {
        const long L = (long)i * G + c; if (L >= nwg) return false;
        int wgid = (int)L; { const int q = nwg / NXCD, r = nwg % NXCD, xcd = wgid % NXCD, off = wgid / NXCD; wgid = (xcd < r ? xcd * (q + 1) : r * (q + 1) + (xcd - r) * q) + off; }
        const int nig = WGM * nN, gid = wgid / nig, fm = gid * WGM, gsz = (nM - fm) < WGM ? (nM - fm) : WGM;
        u.pm = fm + ((wgid % nig) % gsz); u.pn = (wgid % nig) / gsz; return true;
    }
    __device__ __forceinline__ void a_ready(const Unit&) const {}
    __device__ __forceinline__ void done(const Unit&) const {}
};
__device__ __forceinline__ unsigned cvt_pk_bf16(float lo, float hi) { unsigned r; asm volatile("v_cvt_pk_bf16_f32 %0, %1, %2" : "=v"(r) : "v"(lo), "v"(hi)); return r; }
typedef float f32x2 __attribute__((ext_vector_type(2)));

template <class Epi, class Sched, bool STAMP = false>
__device__ __forceinline__ void gemm_phase(PG8_LAS unsigned char* lds, const Gemm g, const Sched& S, const Epi& E, unsigned long long* stamps) {
    const int tid = tid_(), wid = __builtin_amdgcn_readfirstlane(tid >> 6), lane = tid & 63, wr = wid >> 2, wc = wid & 3, fr = lane & 15, fq = lane >> 4;
    const int K = g.K, nt = K / BK;
    int ts_lo = 0, ts_hi = 0, nts = 0; const unsigned long long rt_entry = STAMP ? (unsigned long long)wall_clock64() : 0ull;
#define PG8_STAMP() do { if (STAMP && wid == 0 && nts < 64) { const unsigned long long _c = (unsigned long long)clock64(); \
        ts_lo = (lane == nts) ? (int)(unsigned)_c : ts_lo; ts_hi = (lane == nts) ? (int)(unsigned)(_c >> 32) : ts_hi; ++nts; } } while (0)
    PG8_STAMP();
    unsigned voffA[2], voffB[2];
#pragma unroll
    for (int i = 0; i < 2; ++i) { int R, C; stage_rc(tid * 16 + i * 8192, R, C); const int Rb = Epi::PERM ? ((R & ~31) + perm32(R & 31)) : R;
        voffA[i] = (unsigned)(R * K + C) * 2u; voffB[i] = (unsigned)(Rb * K + C) * 2u; }
    const size_t kstep = (size_t)(BK * 2);
    const size_t hstep = (size_t)HALF * K * 2;
    const size_t tstep = 2 * hstep;
    const unsigned ldsw = (unsigned)wid * 1024u;
    const int aoff = lds_byte(wr * 64 + fr, fq * 8), boff = lds_byte(wc * 32 + fr, fq * 8);
#define PG8_SA(b, h) (((b) * 2 + (h)) * HTB)
#define PG8_SB(b, h) ((4 + (b) * 2 + (h)) * HTB)
#define PG8_STAGE(bufoff, gbase, voff) do { _Pragma("unroll") for (int _i = 0; _i < 2; ++_i) \
        __builtin_amdgcn_global_load_lds((const unsigned*)((const char*)(gbase) + (voff)[_i]), (PG8_LAS unsigned*)(lds + (bufoff) + ldsw + _i * 8192), 16, 0, 0); } while (0)
#define PG8_LDA(dst, b, h) do { _Pragma("unroll") for (int m = 0; m < 4; ++m) _Pragma("unroll") for (int k = 0; k < 2; ++k) dst[m][k] = *(const PG8_LAS bf16x8*)(lds + PG8_SA(b, h) + aoff + m * 2048 + k * 1024); } while (0)
#define PG8_LDB(dst, b, h) do { _Pragma("unroll") for (int n = 0; n < 2; ++n) _Pragma("unroll") for (int k = 0; k < 2; ++k) dst[n][k] = *(const PG8_LAS bf16x8*)(lds + PG8_SB(b, h) + boff + n * 2048 + k * 1024); } while (0)
#define PG8_MMA(ai, bj, At, Bt) do { __builtin_amdgcn_s_setprio(1); _Pragma("unroll") for (int m = 0; m < 4; ++m) _Pragma("unroll") for (int n = 0; n < 2; ++n) _Pragma("unroll") for (int k = 0; k < 2; ++k) \
        acc[ai][bj][m][n] = __builtin_amdgcn_mfma_f32_16x16x32_bf16(Bt[n][k], At[m][k], acc[ai][bj][m][n], 0, 0, 0); __builtin_amdgcn_s_setprio(0); } while (0)
#define PG8_WAIT_V(n) asm volatile("s_waitcnt vmcnt(" #n ")" ::: "memory")
#define PG8_WAIT_L(n) asm volatile("s_waitcnt lgkmcnt(" #n ")" ::: "memory")
#define PG8_BAR __builtin_amdgcn_s_barrier()
#define PG8_SCHED __builtin_amdgcn_sched_barrier(0)
    Unit cur, nxt; int ui = 0;
    if (!S.next(0, cur)) return;
    f32x4 acc[2][2][4][2];
#pragma unroll
    for (int a = 0; a < 2; ++a)
#pragma unroll
        for (int b = 0; b < 2; ++b)
#pragma unroll
            for (int m = 0; m < 4; ++m)
#pragma unroll
                for (int n = 0; n < 2; ++n) acc[a][b][m][n] = (f32x4){0.f, 0.f, 0.f, 0.f};
    bf16x8 At[4][2], B0[2][2], B1[2][2];
    const char* cA = (const char*)g.A + (size_t)cur.pm * tstep; const char* cB = (const char*)g.Bt + (size_t)cur.pn * tstep;
    S.a_ready(cur);
    PG8_STAGE(PG8_SB(0, 0), cB, voffB); PG8_STAGE(PG8_SA(0, 0), cA, voffA); PG8_STAGE(PG8_SB(0, 1), cB + hstep, voffB); PG8_STAGE(PG8_SA(0, 1), cA + hstep, voffA);
    if (wr == 1) PG8_BAR;
    PG8_WAIT_V(4); PG8_BAR;
    PG8_STAGE(PG8_SB(1, 0), cB + kstep, voffB); PG8_STAGE(PG8_SA(1, 0), cA + kstep, voffA); PG8_STAGE(PG8_SB(1, 1), cB + hstep + kstep, voffB);
    PG8_WAIT_V(6); PG8_BAR;
    PG8_STAMP();
    for (;;) {
        const bool has_next = S.next(ui + 1, nxt);
        const char* nA = has_next ? (const char*)g.A + (size_t)nxt.pm * tstep : cA; const char* nB = has_next ? (const char*)g.Bt + (size_t)nxt.pn * tstep : cB;
        for (int t = 0; t < nt; t += 2) {
            const bool last = (t == nt - 2);
            const char* a1 = cA + (size_t)(t + 1) * kstep;
            const char* a2 = last ? nA : cA + (size_t)(t + 2) * kstep; const char* b2 = last ? nB : cB + (size_t)(t + 2) * kstep;
            const char* a3 = a2 + kstep; const char* b3 = b2 + kstep;
            if (last && has_next) S.a_ready(nxt);
            PG8_LDB(B0, 0, 0); PG8_SCHED; PG8_LDA(At, 0, 0); PG8_STAGE(PG8_SA(1, 1), a1 + hstep, voffA);
            PG8_WAIT_L(8); PG8_BAR; PG8_WAIT_L(0); PG8_MMA(0, 0, At, B0); PG8_BAR; PG8_SCHED;
            PG8_LDB(B1, 0, 1); PG8_STAGE(PG8_SB(0, 0), b2, voffB);
            PG8_BAR; PG8_WAIT_L(0); PG8_MMA(0, 1, At, B1); PG8_BAR;
            PG8_LDA(At, 0, 1); PG8_STAGE(PG8_SA(0, 0), a2, voffA);
            PG8_BAR; PG8_WAIT_L(0); PG8_MMA(1, 0, At, B0); PG8_BAR; PG8_SCHED;
            PG8_STAGE(PG8_SB(0, 1), b2 + hstep, voffB);
            PG8_WAIT_V(6); PG8_BAR; PG8_MMA(1, 1, At, B1); PG8_BAR;
            PG8_LDB(B0, 1, 0); PG8_SCHED; PG8_LDA(At, 1, 0); PG8_STAGE(PG8_SA(0, 1), a2 + hstep, voffA);
            PG8_WAIT_L(8); PG8_BAR; PG8_WAIT_L(0); PG8_MMA(0, 0, At, B0); PG8_BAR; PG8_SCHED;
            PG8_LDB(B1, 1, 1); PG8_STAGE(PG8_SB(1, 0), b3, voffB);
            PG8_BAR; PG8_WAIT_L(0); PG8_MMA(0, 1, At, B1); PG8_BAR;
            PG8_LDA(At, 1, 1); PG8_STAGE(PG8_SA(1, 0), a3, voffA);
            PG8_BAR; PG8_WAIT_L(0); PG8_MMA(1, 0, At, B0); PG8_BAR; PG8_SCHED;
            PG8_STAGE(PG8_SB(1, 1), b3 + hstep, voffB);
            PG8_WAIT_V(6); PG8_BAR; PG8_MMA(1, 1, At, B1); PG8_BAR;
        }
        PG8_STAMP();
        if constexpr (!Epi::AFTER_DRAIN) { E(acc, cur, wr, wc, fr, fq); S.done(cur); }
        PG8_STAMP();
        if (!has_next) break;
#pragma unroll
        for (int a = 0; a < 2; ++a)
#pragma unroll
            for (int b = 0; b < 2; ++b)
#pragma unroll
                for (int m = 0; m < 4; ++m)
#pragma unroll
                    for (int n = 0; n < 2; ++n) acc[a][b][m][n] = (f32x4){0.f, 0.f, 0.f, 0.f};
        cur = nxt; cA = nA; cB = nB; ++ui;
    }
    PG8_WAIT_V(0);
    if (wr == 0) PG8_BAR;
    PG8_BAR;
    if constexpr (Epi::AFTER_DRAIN) { E.fused(acc, cur, wr, wc, fr, fq, lds, wid, lane); S.done(cur); }
    PG8_STAMP();
    if (STAMP && wid == 0) { stamps[lane] = lane < nts ? (((unsigned long long)(unsigned)ts_hi << 32) | (unsigned)ts_lo) : 0ull;
        if (lane == 62) stamps[62] = rt_entry; if (lane == 63) stamps[63] = (unsigned long long)wall_clock64(); }
#undef PG8_STAMP
#undef PG8_SA
#undef PG8_SB
#undef PG8_STAGE
#undef PG8_LDA
#undef PG8_LDB
#undef PG8_MMA
#undef PG8_WAIT_V
#undef PG8_WAIT_L
#undef PG8_BAR
#undef PG8_SCHED
}
}

typedef unsigned short bf16_t;
typedef short bf16x8 __attribute__((ext_vector_type(8)));
typedef float f32x4 __attribute__((ext_vector_type(4)));
typedef float f32x2 __attribute__((ext_vector_type(2)));
typedef unsigned u32x4 __attribute__((ext_vector_type(4)));
typedef unsigned u32x2 __attribute__((ext_vector_type(2)));

constexpr int D = 1024, NB = 4, T = 4096, NL = 4, BT = NB * T, BW = 512;
constexpr int DIN = 8320, DINP = 8448;
constexpr int C_PU = 0, C_PG = 512, C_Q = 1024, C_K = 1536, C_V = 2048, C_RG = 2560, C_RW = 3072, C_RWG = 4736, C_GATE = 5248;
constexpr int RW_R = 0, RW_WL = 512, RW_K = 576, RW_V = 1088, RW_AL = 1600, RW_W = 1664;
constexpr int SREC = 896;
constexpr int LDS_MAIN = 147456, LDS_BYTES = LDS_MAIN + 64;

constexpr size_t SZ_WIN = (size_t)DINP * D * 2, SZ_WBR = (size_t)3 * D * BW * 2, SZ_WOUT = (size_t)D * D * 2, SZ_LORA = (size_t)BW * 64 * 2;
constexpr size_t OFF_WIN = 0, OFF_WBR = OFF_WIN + SZ_WIN, OFF_WOUT = OFF_WBR + SZ_WBR, OFF_W2T = OFF_WOUT + SZ_WOUT, OFF_A2T = OFF_W2T + SZ_LORA;
constexpr size_t IMG_STRIDE = OFF_A2T + SZ_LORA;
constexpr size_t OFF_MOD = 2 * IMG_STRIDE, SZ_MOD = (size_t)NL * NB * 3 * D * 4;
constexpr size_t OFF_COS = OFF_MOD + SZ_MOD, SZ_TAB = (size_t)BT * 64 * 4, OFF_SIN = OFF_COS + SZ_TAB;
constexpr size_t OFF_BONUS = OFF_SIN + SZ_TAB, SZ_BONUS = (size_t)BT * 8 * 4;
constexpr size_t OFF_PROJ = OFF_BONUS + SZ_BONUS, SZ_PROJ = (size_t)BT * DINP * 2;
constexpr size_t OFF_BR = OFF_PROJ + SZ_PROJ, SZ_BR = (size_t)3 * BT * BW * 2;
constexpr size_t OFF_X = OFF_BR + SZ_BR;
constexpr size_t OFF_H = OFF_X;
constexpr size_t OFF_STREAM = OFF_X, SZ_STREAM = (size_t)BT * 8 * SREC;
constexpr size_t OFF_KVT = OFF_BR + SZ_BR / 3, SZ_KVT = (size_t)16 * 32 * 128 * 128 * 4;
constexpr size_t OFF_RPREV = OFF_STREAM + SZ_STREAM, SZ_RPREV = SZ_KVT / 2;
constexpr size_t OFF_MERGED = OFF_X, SZ_MERGED = (size_t)BT * D * 4;
constexpr size_t OFF_MERGEDB = OFF_MERGED + SZ_MERGED;
constexpr size_t OFF_H0F = OFF_RPREV + SZ_RPREV, SZ_H0F = (size_t)NB * D * 4;
constexpr int P0W = 2304;
constexpr size_t OFF_P0F = OFF_H0F + SZ_H0F, SZ_P0F = (size_t)NB * P0W * 4;
constexpr size_t OFF_CACC = OFF_P0F + SZ_P0F, SZ_CACC = 256;
constexpr size_t OFF_SACC = OFF_CACC + 128;
constexpr size_t OFF_BAR = OFF_CACC + SZ_CACC, SZ_BAR = (size_t)XCD_BAR_WORDS * 4;
constexpr size_t WS_NEED = OFF_BAR + SZ_BAR;

struct Params {
    const float* x; const float* c; const int* pos;
    const float *norm_g, *w_ada, *b_ada, *w_in, *pool_w, *pool_scale, *ret_norm_g, *shift_mu, *w0, *w2, *a0, *a2, *k_k, *k_a, *r_k, *ln_w, *ln_b, *w_branch, *w_out, *final_g;
    float* out; unsigned char* ws; size_t img_off;
};

__device__ __forceinline__ float bf2f(unsigned v) { return __uint_as_float(v << 16); }
__device__ __forceinline__ float bflo(unsigned v) { return __uint_as_float(v << 16); }
__device__ __forceinline__ float bfhi(unsigned v) { return __uint_as_float(v & 0xffff0000u); }
__device__ __forceinline__ unsigned pk2(float lo, float hi) { return pg8::cvt_pk_bf16(lo, hi); }
__device__ __forceinline__ bf16_t f2bf(float f) { return (bf16_t)(pk2(f, 0.f) & 0xffffu); }
__device__ __forceinline__ float sigmoidf_(float x) { return __builtin_amdgcn_rcpf(1.0f + __expf(-x)); }
__device__ __forceinline__ float siluf_(float x) { return x / (1.0f + __expf(-x)); }

__device__ __forceinline__ void unpack8(const u32x4 a, float (&o)[8]) { o[0] = bflo(a.x); o[1] = bfhi(a.x); o[2] = bflo(a.y); o[3] = bfhi(a.y); o[4] = bflo(a.z); o[5] = bfhi(a.z); o[6] = bflo(a.w); o[7] = bfhi(a.w); }
__device__ __forceinline__ u32x4 pack8(const float (&o)[8]) { u32x4 w; w.x = pk2(o[0], o[1]); w.y = pk2(o[2], o[3]); w.z = pk2(o[4], o[5]); w.w = pk2(o[6], o[7]); return w; }
__device__ __forceinline__ void ldf8(const float* p, float (&o)[8]) { const f32x4 a = *(const f32x4*)p, b = *(const f32x4*)(p + 4); o[0] = a[0]; o[1] = a[1]; o[2] = a[2]; o[3] = a[3]; o[4] = b[0]; o[5] = b[1]; o[6] = b[2]; o[7] = b[3]; }
template <int CTRL> __device__ __forceinline__ float dpp_mov(float v) { return __int_as_float(__builtin_amdgcn_update_dpp(0, __float_as_int(v), CTRL, 0xF, 0xF, false)); }
__device__ __forceinline__ float red16(float v) {
    v += dpp_mov<0xB1>(v);
    v += dpp_mov<0x4E>(v);
    v += dpp_mov<0x141>(v);
    v += dpp_mov<0x140>(v);
    return v;
}
__device__ __forceinline__ float red64(float v) {
    v = red16(v);
    v += __shfl_xor(v, 16); v += __shfl_xor(v, 32);
    return v;
}

constexpr int LDS_LD = 136;
__device__ __forceinline__ void strip_mma(const LAS bf16_t* A, int row0, const LAS bf16_t* Bm, f32x4 (&acc)[8], int fr, int fq) {
#pragma unroll
    for (int kk = 0; kk < 4; ++kk) {
        const bf16x8 a = *(const LAS bf16x8*)(A + (row0 + fr) * LDS_LD + kk * 32 + fq * 8);
#pragma unroll
        for (int n = 0; n < 8; ++n) {
            const bf16x8 b = *(const LAS bf16x8*)(Bm + (n * 16 + fr) * LDS_LD + kk * 32 + fq * 8);
            acc[n] = __builtin_amdgcn_mfma_f32_16x16x32_bf16(a, b, acc[n], 0, 0, 0);
        }
    }
}

struct EpiProj {
    static constexpr bool PERM = true, AFTER_DRAIN = false;
    bf16_t* O;
    __device__ __forceinline__ void operator()(const f32x4 (&acc)[2][2][4][2], const pg8::Unit& u, int wr, int wc, int fr, int fq) const {
        const int row0 = u.pm * 256 + wr * 64 + fr, col0 = u.pn * 256 + wc * 32 + 8 * fq;
#pragma unroll
        for (int ai = 0; ai < 2; ++ai)
#pragma unroll
            for (int m = 0; m < 4; ++m) { bf16_t* rowp = O + (size_t)(row0 + ai * 128 + m * 16) * DINP + col0;
#pragma unroll
                for (int bj = 0; bj < 2; ++bj) { const f32x4 v0 = acc[ai][bj][m][0], v1 = acc[ai][bj][m][1];
                    u32x4 w; w.x = pk2(v0[0], v0[1]); w.y = pk2(v0[2], v0[3]); w.z = pk2(v1[0], v1[1]); w.w = pk2(v1[2], v1[3]);
                    *(u32x4*)(rowp + bj * 128) = w; } }
    }
};
template <int NBR> struct EpiMerge {
    static constexpr bool PERM = true, AFTER_DRAIN = false;
    const bf16_t* proj; float* merged; bf16_t* mergedb;
    __device__ __forceinline__ void operator()(const f32x4 (&acc)[2][2][4][2], const pg8::Unit& u, int wr, int wc, int fr, int fq) const {
        const int row0 = u.pm * 256 + wr * 64 + fr, col0 = u.pn * 256 + wc * 32 + 8 * fq;
#pragma unroll
        for (int ai = 0; ai < 2; ++ai)
#pragma unroll
            for (int m = 0; m < 4; ++m) {
                const size_t row = (size_t)(row0 + ai * 128 + m * 16);
#pragma unroll
                for (int bj = 0; bj < 2; ++bj) {
                    const int col = col0 + bj * 128;
                    const u32x4 lg = *(const u32x4*)(proj + row * DINP + C_GATE + NBR * D + col);
                    const f32x4 v0 = acc[ai][bj][m][0], v1 = acc[ai][bj][m][1];
                    f32x4 o0, o1;
                    o0[0] = sigmoidf_(bflo(lg.x)) * v0[0]; o0[1] = sigmoidf_(bfhi(lg.x)) * v0[1]; o0[2] = sigmoidf_(bflo(lg.y)) * v0[2]; o0[3] = sigmoidf_(bfhi(lg.y)) * v0[3];
                    o1[0] = sigmoidf_(bflo(lg.z)) * v1[0]; o1[1] = sigmoidf_(bfhi(lg.z)) * v1[1]; o1[2] = sigmoidf_(bflo(lg.w)) * v1[2]; o1[3] = sigmoidf_(bfhi(lg.w)) * v1[3];
                    float* mp = merged + row * D + col;
                    if (NBR > 0) { o0 += *(const f32x4*)mp; o1 += *(const f32x4*)(mp + 4); }
                    if (NBR < 2) { *(f32x4*)mp = o0; *(f32x4*)(mp + 4) = o1; }
                    else { u32x4 w; w.x = pk2(o0[0], o0[1]); w.y = pk2(o0[2], o0[3]); w.z = pk2(o1[0], o1[1]); w.w = pk2(o1[2], o1[3]); *(u32x4*)(mergedb + row * D + col) = w; }
                }
            }
    }
};

struct MergeOrder {
    pg8::StaticOrder base;
    __device__ __forceinline__ bool next(int i, pg8::Unit& u) const { const int r = i / 3, n = i - 3 * r; pg8::Unit t; if (!base.next(r, t)) return false; u.pm = n * 64 + t.pm; u.pn = n * 4 + t.pn; return true; }
    __device__ __forceinline__ void a_ready(const pg8::Unit&) const {}
    __device__ __forceinline__ void done(const pg8::Unit&) const {}
};
struct EpiMergeAll {
    static constexpr bool PERM = true, AFTER_DRAIN = false;
    const bf16_t* proj; float* merged; bf16_t* mergedb;
    __device__ __forceinline__ void operator()(const f32x4 (&acc)[2][2][4][2], const pg8::Unit& u, int wr, int wc, int fr, int fq) const {
        const int n = u.pm >> 6; pg8::Unit t; t.pm = u.pm & 63; t.pn = u.pn & 3;
        if (n == 0) { EpiMerge<0> e{proj, merged, mergedb}; e(acc, t, wr, wc, fr, fq); }
        else if (n == 1) { EpiMerge<1> e{proj, merged, mergedb}; e(acc, t, wr, wc, fr, fq); }
        else { EpiMerge<2> e{proj, merged, mergedb}; e(acc, t, wr, wc, fr, fq); }
    }
};
struct EpiOut {
    static constexpr bool PERM = false, AFTER_DRAIN = false;
    const float* xin; float* xout; const float* gate;
    __device__ __forceinline__ void operator()(const f32x4 (&acc)[2][2][4][2], const pg8::Unit& u, int wr, int wc, int fr, int fq) const {
        const int row0 = u.pm * 256 + wr * 64 + fr, col0 = u.pn * 256 + wc * 32 + 4 * fq;
        const float* gp = gate + (size_t)(u.pm >> 4) * 3 * D + col0;
        f32x4 gv[2][2];
#pragma unroll
        for (int bj = 0; bj < 2; ++bj)
#pragma unroll
            for (int n = 0; n < 2; ++n) gv[bj][n] = *(const f32x4*)(gp + bj * 128 + n * 16);
#pragma unroll
        for (int ai = 0; ai < 2; ++ai)
#pragma unroll
            for (int m = 0; m < 4; ++m) {
                const size_t ro = (size_t)(row0 + ai * 128 + m * 16) * D + col0;
#pragma unroll
                for (int bj = 0; bj < 2; ++bj)
#pragma unroll
                    for (int n = 0; n < 2; ++n) {
                        const f32x4 xi = *(const f32x4*)(xin + ro + bj * 128 + n * 16);
                        *(f32x4*)(xout + ro + bj * 128 + n * 16) = xi + gv[bj][n] * acc[ai][bj][m][n];
                    }
            }
    }
};

__device__ __forceinline__ void phase0(const Params& p, unsigned char* shm) {
    const int tid = tid_(), wid = tid >> 6, lane = tid & 63;
    const int gtid = blockIdx.x * 512 + tid, nth = gridDim.x * 512;
    { const int nz = (DINP - DIN) * D * 2 / 16;
      for (int st_ = 0; st_ < 2; ++st_) { u32x4* z = (u32x4*)(p.ws + st_ * IMG_STRIDE + OFF_WIN + (size_t)DIN * D * 2);
        for (int i = gtid; i < nz; i += nth) z[i] = (u32x4){0u, 0u, 0u, 0u}; } }
    { float* COS = (float*)(p.ws + OFF_COS); float* SIN = (float*)(p.ws + OFF_SIN);
      for (int idx = gtid; idx < BT * 64; idx += nth) {
          const int i = idx & 63, tok = idx >> 6;
          double f = 1.0; for (int j = 0; j < i; ++j) f *= 0.8659643233600653;
          const float freq = (float)f;
          const float ang = (float)p.pos[tok] * freq;
          const double ad = (double)ang;
          const double nq = rint(ad * 0.6366197723675814);
          double r = fma(-nq, 1.5707963267948966, ad); r = fma(-nq, 6.123233995736766e-17, r);
          const float rf = (float)r; const float sr = sinf(rf), cr = cosf(rf);
          const int q = ((int)nq) & 3;
          float s, c;
          if (q == 0) { s = sr; c = cr; } else if (q == 1) { s = cr; c = -sr; } else if (q == 2) { s = -sr; c = -cr; } else { s = -cr; c = sr; }
          COS[idx] = c; SIN[idx] = s;
      } }
    float* cs = (float*)shm;
    float* red = cs + 4096;
    for (int i = tid; i < 4096; i += 512) { const int b = i >> 10, k = i & 1023; cs[k * 4 + b] = siluf_(p.c[b * 1024 + k]); }
    __syncthreads();
    float* mod = (float*)(p.ws + OFF_MOD);
    for (int item = blockIdx.x; item < NL * 48; item += gridDim.x) {
        const int l = item / 48, cgp = item % 48, col = cgp * 64 + lane;
        const float* wp = p.w_ada + (size_t)l * D * 3 * D + col;
        const int k0 = wid * 128;
        float a0 = 0.f, a1 = 0.f, a2 = 0.f, a3 = 0.f;
#pragma unroll 32
        for (int k = k0; k < k0 + 128; ++k) { const float w = wp[(size_t)k * 3 * D]; const f32x4 c4 = *(const f32x4*)(cs + k * 4); a0 += w * c4[0]; a1 += w * c4[1]; a2 += w * c4[2]; a3 += w * c4[3]; }
        red[(wid * 4 + 0) * 64 + lane] = a0; red[(wid * 4 + 1) * 64 + lane] = a1; red[(wid * 4 + 2) * 64 + lane] = a2; red[(wid * 4 + 3) * 64 + lane] = a3;
        __syncthreads();
        if (tid < 256) { const int b = tid >> 6; float s = 0.f;
#pragma unroll
            for (int w = 0; w < 8; ++w) s += red[(w * 4 + b) * 64 + lane];
            mod[(size_t)(l * NB + b) * 3 * D + col] = s + p.b_ada[l * 3 * D + col]; }
        __syncthreads();
    }
}

__device__ __forceinline__ void tconv64(const float* src, int ld_src, bf16_t* dst, int ld_dst, int r0, int c0, float* tile) {
    const int tid = tid_();
    { const int r = tid >> 3, cc = (tid & 7) * 8; const float* sp = src + (size_t)(r0 + r) * ld_src + c0 + cc;
      const f32x4 v0 = *(const f32x4*)sp, v1 = *(const f32x4*)(sp + 4); float* tp = tile + r * 65 + cc;
      tp[0] = v0[0]; tp[1] = v0[1]; tp[2] = v0[2]; tp[3] = v0[3]; tp[4] = v1[0]; tp[5] = v1[1]; tp[6] = v1[2]; tp[7] = v1[3]; }
    __syncthreads();
    { const int c = tid >> 3, rc = (tid & 7) * 8; const float* tp = tile + rc * 65 + c;
      u32x4 w; w.x = pk2(tp[0], tp[65]); w.y = pk2(tp[130], tp[195]); w.z = pk2(tp[260], tp[325]); w.w = pk2(tp[390], tp[455]);
      *(u32x4*)(dst + (size_t)(c0 + c) * ld_dst + r0 + rc) = w; }
    __syncthreads();
}
__device__ __forceinline__ void poolfold64(const float* w_in_l, const float* pool_w_l, bf16_t* dst, int k0, int n0, float* lds) {
    const int tid = tid_(), g = n0 >> 7, nb = n0 & 127;
    float* Ain = lds;
    float* Pw = lds + 64 * 129;
    for (int i = tid; i < 64 * 32; i += 512) { const int r = i >> 5, c4 = (i & 31) * 4; const f32x4 v = *(const f32x4*)(w_in_l + (size_t)(k0 + r) * DIN + g * 128 + c4);
        float* tp = Ain + r * 129 + c4; tp[0] = v[0]; tp[1] = v[1]; tp[2] = v[2]; tp[3] = v[3]; }
    for (int i = tid; i < 128 * 16; i += 512) { const int c = i >> 4, n4 = (i & 15) * 4; const f32x4 v = *(const f32x4*)(pool_w_l + (size_t)(g * 128 + c) * 128 + nb + n4);
        float* tp = Pw + c * 65 + n4; tp[0] = v[0]; tp[1] = v[1]; tp[2] = v[2]; tp[3] = v[3]; }
    __syncthreads();
    { const int nn = tid >> 3, rc = (tid & 7) * 8; float acc[8];
#pragma unroll
      for (int i = 0; i < 8; ++i) acc[i] = 0.f;
      for (int c = 0; c < 128; ++c) { const float pw = Pw[c * 65 + nn];
#pragma unroll
          for (int i = 0; i < 8; ++i) acc[i] += Ain[(rc + i) * 129 + c] * pw; }
      u32x4 w; w.x = pk2(acc[0], acc[1]); w.y = pk2(acc[2], acc[3]); w.z = pk2(acc[4], acc[5]); w.w = pk2(acc[6], acc[7]);
      *(u32x4*)(dst + (size_t)(n0 + nn) * D + k0 + rc) = w; }
    __syncthreads();
}
__device__ __forceinline__ void phase_weights(const Params& p, int l, unsigned char* shm, int job0, int jstride) {
    float* tile = (float*)shm;
    unsigned char* img = p.ws + p.img_off;
    bf16_t* Wt_in = (bf16_t*)(img + OFF_WIN); bf16_t* Wt_br = (bf16_t*)(img + OFF_WBR); bf16_t* Wt_out = (bf16_t*)(img + OFF_WOUT);
    bf16_t* W2T = (bf16_t*)(img + OFF_W2T); bf16_t* A2T = (bf16_t*)(img + OFF_A2T);
    const float* w_in_l = p.w_in + (size_t)l * D * DIN;
    constexpr int J_IN = 16 * 130, J_BR = 3 * 8 * 16, J_OUT = 16 * 16, J_LORA = 16;
    constexpr int NJ = J_IN + J_BR + J_OUT + J_LORA;
    for (int job = job0; job < NJ; job += jstride) {
        int j = job;
        if (j < J_IN) { const int kt = j & 15, nt = j >> 4;
            if (nt < 8) poolfold64(w_in_l, p.pool_w + (size_t)l * 4 * 128 * 128, Wt_in, kt * 64, nt * 64, tile);
            else tconv64(w_in_l, DIN, Wt_in, D, kt * 64, nt * 64, tile);
            continue; }
        j -= J_IN;
        if (j < J_BR) { const int nb = j / 128, r = j % 128, wt = r & 7, dt = r >> 3;
            tconv64(p.w_branch + ((size_t)l * 3 + nb) * BW * D, D, Wt_br + (size_t)nb * D * BW, BW, wt * 64, dt * 64, tile); continue; }
        j -= J_BR;
        if (j < J_OUT) { const int kt = j & 15, dt = j >> 4; tconv64(p.w_out + (size_t)l * D * D, D, Wt_out, D, kt * 64, dt * 64, tile); continue; }
        j -= J_OUT;
        if (j < 8) tconv64(p.w2 + (size_t)l * 64 * BW, BW, W2T, 64, 0, j * 64, tile);
        else tconv64(p.a2 + (size_t)l * 64 * BW, BW, A2T, 64, 0, (j - 8) * 64, tile);
    }
}
__device__ __forceinline__ void phase_norm(const Params& p, int l, const float* xin) {
    const int tid = tid_(), wid = tid >> 6, lane = tid & 63;
    bf16_t* h = (bf16_t*)(p.ws + OFF_H);
    const float* mod = (const float*)(p.ws + OFF_MOD) + (size_t)l * NB * 3 * D;
    const float* g = p.norm_g + l * D;
    { float* z = (float*)(p.ws + OFF_P0F); const int g_ = blockIdx.x * 512 + tid; if (g_ < NB * P0W) z[g_] = 0.f; }
    for (int row = blockIdx.x * 8 + wid; row < BT; row += gridDim.x * 8) {
        const int b = row >> 12;
        const float* xp = xin + (size_t)row * D;
        f32x4 v[4]; float ss = 0.f;
#pragma unroll
        for (int j = 0; j < 2; ++j) { v[2 * j] = *(const f32x4*)(xp + j * 512 + lane * 8); v[2 * j + 1] = *(const f32x4*)(xp + j * 512 + lane * 8 + 4); }
#pragma unroll
        for (int j = 0; j < 4; ++j) ss += v[j][0] * v[j][0] + v[j][1] * v[j][1] + v[j][2] * v[j][2] + v[j][3] * v[j][3];
        ss = red64(ss);
        const float rstd = rsqrtf(ss * (1.0f / D) + 1e-6f);
        const float* sh = mod + (size_t)b * 3 * D; const float* sc = sh + D;
#pragma unroll
        for (int j = 0; j < 2; ++j) {
            const int c0 = j * 512 + lane * 8; float o[8];
#pragma unroll
            for (int i = 0; i < 8; ++i) { const float xv = v[2 * j + (i >> 2)][i & 3]; o[i] = xv * rstd * g[c0 + i] * (1.0f + sc[c0 + i]) + sh[c0 + i]; }
            u32x4 w; w.x = pk2(o[0], o[1]); w.y = pk2(o[2], o[3]); w.z = pk2(o[4], o[5]); w.w = pk2(o[6], o[7]);
            *(u32x4*)(h + (size_t)row * D + c0) = w;
            if ((row & (T - 1)) == 0) { float* hf = (float*)(p.ws + OFF_H0F) + (size_t)b * D + c0;
                *(f32x4*)hf = (f32x4){o[0], o[1], o[2], o[3]}; *(f32x4*)(hf + 4) = (f32x4){o[4], o[5], o[6], o[7]}; }
        }
    }
}
__device__ __forceinline__ void gemv0_item(const Params& p, int l, int item, unsigned char* shm) {
    const int tid = tid_(), wid = tid >> 6, lane = tid & 63, cg_ = item >> 3, kc = item & 7;
    float* red = (float*)shm;
    const float* h0 = (const float*)(p.ws + OFF_H0F);
    const int src = cg_ < 8 ? C_RW + RW_R + 64 * cg_ : cg_ < 16 ? C_RW + RW_K + 64 * (cg_ - 8) : cg_ == 16 ? C_RW + RW_AL : cg_ < 25 ? C_Q + 64 * (cg_ - 17) : C_K + 64 * (cg_ - 25);
    const int dst = cg_ < 8 ? 64 * cg_ : cg_ < 16 ? 512 + 64 * (cg_ - 8) : cg_ == 16 ? 1024 : 1152 + 64 * (cg_ - 17);
    const int k0 = kc * 128 + wid * 16;
    const float* wp = p.w_in + (size_t)l * D * DIN + (size_t)k0 * DIN + src + lane;
    float w[16];
#pragma unroll
    for (int i = 0; i < 16; ++i) w[i] = wp[(size_t)i * DIN];
    float a0 = 0.f, a1 = 0.f, a2 = 0.f, a3 = 0.f;
#pragma unroll
    for (int i = 0; i < 16; ++i) { a0 += w[i] * h0[k0 + i]; a1 += w[i] * h0[D + k0 + i]; a2 += w[i] * h0[2 * D + k0 + i]; a3 += w[i] * h0[3 * D + k0 + i]; }
    red[(wid * 4 + 0) * 64 + lane] = a0; red[(wid * 4 + 1) * 64 + lane] = a1; red[(wid * 4 + 2) * 64 + lane] = a2; red[(wid * 4 + 3) * 64 + lane] = a3;
    __syncthreads();
    if (tid < 256) { const int b = tid >> 6; float sm = 0.f;
#pragma unroll
        for (int w_ = 0; w_ < 8; ++w_) sm += red[(w_ * 4 + b) * 64 + lane];
        atomicAdd((float*)(p.ws + OFF_P0F) + (size_t)b * P0W + dst + lane, sm); }
    __syncthreads();
}

__device__ __forceinline__ void phase_final_norm(const Params& p) {
    const int tid = tid_(), wid = tid >> 6, lane = tid & 63;
    for (int row = blockIdx.x * 8 + wid; row < BT; row += gridDim.x * 8) {
        float* xp = p.out + (size_t)row * D;
        f32x4 v[4]; float ss = 0.f;
#pragma unroll
        for (int j = 0; j < 4; ++j) v[j] = *(const f32x4*)(xp + j * 256 + lane * 4);
#pragma unroll
        for (int j = 0; j < 4; ++j) ss += v[j][0] * v[j][0] + v[j][1] * v[j][1] + v[j][2] * v[j][2] + v[j][3] * v[j][3];
        ss = red64(ss);
        const float rstd = rsqrtf(ss * (1.0f / D) + 1e-6f);
#pragma unroll
        for (int j = 0; j < 4; ++j) { const f32x4 gg = *(const f32x4*)(p.final_g + j * 256 + lane * 4); *(f32x4*)(xp + j * 256 + lane * 4) = v[j] * rstd * gg; }
    }
}

__device__ __forceinline__ void pool_item(const Params& p, int l, int item) {
    const int tid = tid_(), cv = tid & 63, tl = tid >> 6, c0 = cv * 8, g = c0 >> 7, win = 2 << g;
    const bf16_t* proj = (const bf16_t*)(p.ws + OFF_PROJ);
    bf16_t* br0 = (bf16_t*)(p.ws + OFF_BR);
    float sc[8]; ldf8(p.pool_scale + l * BW + c0, sc);
    const int tokA = item * 64 + tl * 8, tposA = tokA & (T - 1);
    u32x4 rows[23];
#pragma unroll
    for (int i = 0; i < 23; ++i) {
        const int d = i - 15;
        const bool ok = (tposA + d >= 0) && (d > -win);
        rows[i] = ok ? *(const u32x4*)(proj + (size_t)(tokA + d) * DINP + C_PU + c0) : (u32x4){0u, 0u, 0u, 0u};
    }
    u32x4 gts[8];
#pragma unroll
    for (int tt = 0; tt < 8; ++tt) gts[tt] = *(const u32x4*)(proj + (size_t)(tokA + tt) * DINP + C_PG + c0);
#pragma unroll
    for (int tt = 0; tt < 8; ++tt) {
        const int tpos = tposA + tt, cnt = min(tpos + 1, win);
        float s[8];
#pragma unroll
        for (int i = 0; i < 8; ++i) s[i] = 0.f;
#pragma unroll
        for (int j = 0; j < 16; ++j) {
            if (j < win) { float u[8]; unpack8(rows[15 + tt - j], u);
#pragma unroll
                for (int i = 0; i < 8; ++i) s[i] += u[i]; }
        }
        const float inv = 1.0f / (float)cnt;
        float uu[8], gg[8], o[8]; unpack8(rows[15 + tt], uu); unpack8(gts[tt], gg);
#pragma unroll
        for (int i = 0; i < 8; ++i) o[i] = (s[i] * inv - uu[i]) * sc[i] * siluf_(gg[i]);
        *(u32x4*)(br0 + (size_t)(tokA + tt) * BW + c0) = pack8(o);
    }
}

__device__ __forceinline__ float ret_lg(int h) { return h == 0 ? -0.04580368961312479f : h == 1 ? -0.02272007650008353f : h == 2 ? -0.011315313227834146f : -0.005646563141142063f; }

struct RotCS { f32x4 c0, c1, s0, s1; };
__device__ __forceinline__ void fetch_cs(const Params& p, RotCS (&cs)[2], int tid, int tok0) {
    const float* COS = (const float*)(p.ws + OFF_COS); const float* SIN = (const float*)(p.ws + OFF_SIN);
#pragma unroll
    for (int it = 0; it < 2; ++it) { const int u = tid + it * 512, j = u >> 3, d0 = (u & 7) * 8;
        const float* cp = COS + (size_t)(tok0 + j) * 64 + d0; const float* sn = SIN + (size_t)(tok0 + j) * 64 + d0;
        cs[it].c0 = *(const f32x4*)cp; cs[it].c1 = *(const f32x4*)(cp + 4); cs[it].s0 = *(const f32x4*)sn; cs[it].s1 = *(const f32x4*)(sn + 4); }
}
__device__ __forceinline__ void fetch_qk(const Params& p, u32x4 (&ra)[2], u32x4 (&rb)[2], int tid, int tok0, int col) {
    const bf16_t* proj = (const bf16_t*)(p.ws + OFF_PROJ);
#pragma unroll
    for (int it = 0; it < 2; ++it) { const int u = tid + it * 512, j = u >> 3, d0 = (u & 7) * 8;
        const bf16_t* sp = proj + (size_t)(tok0 + j) * DINP + col + d0; ra[it] = *(const u32x4*)sp; rb[it] = *(const u32x4*)(sp + 64); }
}
template <bool TRANS> __device__ __forceinline__ void store_rot(LAS bf16_t* dst, const u32x4 (&ra)[2], const u32x4 (&rb)[2], const RotCS (&cs)[2], int tid, float scale, float lgt) {
#pragma unroll
    for (int it = 0; it < 2; ++it) {
        const int u = tid + it * 512, j = u >> 3, d0 = (u & 7) * 8;
        float x1[8], x2[8]; unpack8(ra[it], x1); unpack8(rb[it], x2);
        const float cc[8] = {cs[it].c0[0], cs[it].c0[1], cs[it].c0[2], cs[it].c0[3], cs[it].c1[0], cs[it].c1[1], cs[it].c1[2], cs[it].c1[3]};
        const float ss[8] = {cs[it].s0[0], cs[it].s0[1], cs[it].s0[2], cs[it].s0[3], cs[it].s1[0], cs[it].s1[1], cs[it].s1[2], cs[it].s1[3]};
        const float sc = (lgt != 0.f) ? scale * exp2f(lgt * (float)(127 - j)) : scale;
        float o1[8], o2[8];
#pragma unroll
        for (int i = 0; i < 8; ++i) { o1[i] = (x1[i] * cc[i] - x2[i] * ss[i]) * sc; o2[i] = (x1[i] * ss[i] + x2[i] * cc[i]) * sc; }
        if (TRANS) {
#pragma unroll
            for (int i = 0; i < 8; ++i) { dst[(d0 + i) * LDS_LD + j] = f2bf(o1[i]); dst[(d0 + 64 + i) * LDS_LD + j] = f2bf(o2[i]); }
        } else {
            *(LAS u32x4*)(dst + j * LDS_LD + d0) = pack8(o1); *(LAS u32x4*)(dst + j * LDS_LD + d0 + 64) = pack8(o2);
        }
    }
}
__device__ __forceinline__ void fetch_v(const Params& p, u32x4 (&rv)[4], int tid, int tok0, int col) {
    const bf16_t* proj = (const bf16_t*)(p.ws + OFF_PROJ);
#pragma unroll
    for (int it = 0; it < 4; ++it) { const int u = tid + it * 512, j = u >> 4, e0 = (u & 15) * 8; rv[it] = *(const u32x4*)(proj + (size_t)(tok0 + j) * DINP + col + e0); }
}
__device__ __forceinline__ void store_vT(LAS bf16_t* dst, const u32x4 (&rv)[4], int tid) {
#pragma unroll
    for (int it = 0; it < 4; ++it) {
        const int u = tid + it * 512, j = u >> 4, e0 = (u & 15) * 8; const u32x4 a = rv[it];
        dst[(e0 + 0) * LDS_LD + j] = (bf16_t)(a.x & 0xffffu); dst[(e0 + 1) * LDS_LD + j] = (bf16_t)(a.x >> 16);
        dst[(e0 + 2) * LDS_LD + j] = (bf16_t)(a.y & 0xffffu); dst[(e0 + 3) * LDS_LD + j] = (bf16_t)(a.y >> 16);
        dst[(e0 + 4) * LDS_LD + j] = (bf16_t)(a.z & 0xffffu); dst[(e0 + 5) * LDS_LD + j] = (bf16_t)(a.z >> 16);
        dst[(e0 + 6) * LDS_LD + j] = (bf16_t)(a.w & 0xffffu); dst[(e0 + 7) * LDS_LD + j] = (bf16_t)(a.w >> 16);
    }
}

__device__ __forceinline__ void ret_r1_item(const Params& p, int item, LAS bf16_t* lds) {
    const int tid = tid_(), wid = tid >> 6, lane = tid & 63, fr = lane & 15, fq = lane >> 4;
    const int n = item & 31, bh = item >> 5, h = bh & 3, b = bh >> 2, tok0 = b * T + n * 128;
    LAS bf16_t* KT = lds; LAS bf16_t* VT = lds + 128 * LDS_LD;
    { RotCS cs[2]; u32x4 ka[2], kb[2], rv[4];
      fetch_qk(p, ka, kb, tid, tok0, C_K + h * 128); fetch_cs(p, cs, tid, tok0); fetch_v(p, rv, tid, tok0, C_V + h * 128);
      store_rot<true>(KT, ka, kb, cs, tid, 0.08838834764831845f, ret_lg(h));
      store_vT(VT, rv, tid); }
    __syncthreads();
    f32x4 acc[8];
#pragma unroll
    for (int i = 0; i < 8; ++i) acc[i] = (f32x4){0.f, 0.f, 0.f, 0.f};
    strip_mma(VT, wid * 16, KT, acc, fr, fq);
    float* kvT = (float*)(p.ws + OFF_KVT) + ((size_t)item << 14);
#pragma unroll
    for (int nn = 0; nn < 8; ++nn)
#pragma unroll
        for (int jj = 0; jj < 4; ++jj) kvT[(wid * 16 + fq * 4 + jj) * 128 + nn * 16 + fr] = acc[nn][jj];
    __syncthreads();
}

constexpr int PREP_LD = 516;
__device__ __forceinline__ float red8(float v) {
    v += dpp_mov<0xB1>(v); v += dpp_mov<0x4E>(v); v += dpp_mov<0x141>(v);
    return v;
}
__device__ __forceinline__ void rwkv_prep_item(const Params& p, int l, int item, LAS bf16_t* lds) {
    const int tid = tid_(), wid = tid >> 6, lane = tid & 63, fr = lane & 15, fq = lane >> 4;
    const bf16_t* proj = (const bf16_t*)(p.ws + OFF_PROJ);
    const int tok0 = item * 32;
    LAS bf16_t* Aw = lds;
    LAS bf16_t* Aa = lds + 32 * 72;
    LAS float* LW = (LAS float*)(lds + 2 * 32 * 72);
    LAS float* LA = LW + 32 * PREP_LD;
    const float* mu = p.shift_mu + l * RW_W;
#pragma unroll
    for (int hh = 0; hh < 2; ++hh) {
        const int tt = (tid >> 5) + hh * 16, cc = (tid & 31) * 4, tok = tok0 + tt;
        const int ch = cc < 64 ? RW_WL + cc : RW_AL + (cc - 64);
        const u32x2 cu = *(const u32x2*)(proj + (size_t)tok * DINP + C_RW + ch);
        u32x2 pu = (u32x2){0u, 0u};
        if ((tok & (T - 1)) != 0) pu = *(const u32x2*)(proj + (size_t)(tok - 1) * DINP + C_RW + ch);
        const float xc[4] = {bflo(cu.x), bfhi(cu.x), bflo(cu.y), bfhi(cu.y)}, xp[4] = {bflo(pu.x), bfhi(pu.x), bflo(pu.y), bfhi(pu.y)};
        float o[4];
#pragma unroll
        for (int i = 0; i < 4; ++i) { o[i] = xc[i] + (xp[i] - xc[i]) * mu[ch + i]; if (cc < 64) o[i] = tanhf(o[i]); }
        LAS bf16_t* dp = (cc < 64 ? Aw + tt * 72 + cc : Aa + tt * 72 + (cc - 64));
        u32x2 w; w.x = pk2(o[0], o[1]); w.y = pk2(o[2], o[3]); *(LAS u32x2*)dp = w;
    }
    __syncthreads();
    {
        const bf16_t* W2T = (const bf16_t*)(p.ws + p.img_off + OFF_W2T); const bf16_t* A2T = (const bf16_t*)(p.ws + p.img_off + OFF_A2T);
        f32x4 lw[2][4], la[2][4];
#pragma unroll
        for (int mt = 0; mt < 2; ++mt)
#pragma unroll
            for (int n = 0; n < 4; ++n) { lw[mt][n] = (f32x4){0.f, 0.f, 0.f, 0.f}; la[mt][n] = (f32x4){0.f, 0.f, 0.f, 0.f}; }
#pragma unroll
        for (int kk = 0; kk < 2; ++kk) {
            bf16x8 aw[2], aa[2];
#pragma unroll
            for (int mt = 0; mt < 2; ++mt) { aw[mt] = *(const LAS bf16x8*)(Aw + (mt * 16 + fr) * 72 + kk * 32 + fq * 8); aa[mt] = *(const LAS bf16x8*)(Aa + (mt * 16 + fr) * 72 + kk * 32 + fq * 8); }
#pragma unroll
            for (int n = 0; n < 4; ++n) {
                const int chn = wid * 64 + n * 16 + fr;
                const bf16x8 bw = *(const bf16x8*)(W2T + (size_t)chn * 64 + kk * 32 + fq * 8);
                const bf16x8 ba = *(const bf16x8*)(A2T + (size_t)chn * 64 + kk * 32 + fq * 8);
#pragma unroll
                for (int mt = 0; mt < 2; ++mt) {
                    lw[mt][n] = __builtin_amdgcn_mfma_f32_16x16x32_bf16(aw[mt], bw, lw[mt][n], 0, 0, 0);
                    la[mt][n] = __builtin_amdgcn_mfma_f32_16x16x32_bf16(aa[mt], ba, la[mt][n], 0, 0, 0);
                }
            }
        }
#pragma unroll
        for (int mt = 0; mt < 2; ++mt)
#pragma unroll
            for (int n = 0; n < 4; ++n)
#pragma unroll
                for (int jj = 0; jj < 4; ++jj) { const int o = (mt * 16 + fq * 4 + jj) * PREP_LD + wid * 64 + n * 16 + fr; LW[o] = lw[mt][n][jj]; LA[o] = la[mt][n][jj]; }
    }
    __syncthreads();
    {
        const int cv = tid & 63, c0 = cv * 8, head = cv >> 3, cc = c0 & 63;
        float muR[8], muK[8], muV[8], w0v[8], a0v[8], kkw[8], kaw[8], rkw[8];
        ldf8(mu + RW_R + c0, muR); ldf8(mu + RW_K + c0, muK); ldf8(mu + RW_V + c0, muV);
        ldf8(p.w0 + l * BW + c0, w0v); ldf8(p.a0 + l * BW + c0, a0v); ldf8(p.k_k + l * BW + c0, kkw); ldf8(p.k_a + l * BW + c0, kaw); ldf8(p.r_k + l * BW + c0, rkw);
        unsigned char* stream = p.ws + OFF_STREAM; float* bonus = (float*)(p.ws + OFF_BONUS);
#pragma unroll
        for (int it = 0; it < 4; ++it) {
            const int tt = (tid >> 6) + it * 8, tok = tok0 + tt, tpos = tok & (T - 1), b = tok >> 12;
            const bf16_t* pc = proj + (size_t)tok * DINP + C_RW + c0;
            float rc[8], kc[8], vc[8], rp[8], kp[8], vp[8];
            unpack8(*(const u32x4*)(pc + RW_R), rc); unpack8(*(const u32x4*)(pc + RW_K), kc); unpack8(*(const u32x4*)(pc + RW_V), vc);
            if (tpos != 0) { unpack8(*(const u32x4*)(pc - DINP + RW_R), rp); unpack8(*(const u32x4*)(pc - DINP + RW_K), kp); unpack8(*(const u32x4*)(pc - DINP + RW_V), vp); }
            else {
#pragma unroll
                for (int i = 0; i < 8; ++i) { rp[i] = 0.f; kp[i] = 0.f; vp[i] = 0.f; } }
            float lwv[8], lav[8];
            { const f32x4 x0 = *(const LAS f32x4*)(LW + tt * PREP_LD + c0), x1 = *(const LAS f32x4*)(LW + tt * PREP_LD + c0 + 4), y0 = *(const LAS f32x4*)(LA + tt * PREP_LD + c0), y1 = *(const LAS f32x4*)(LA + tt * PREP_LD + c0 + 4);
#pragma unroll
              for (int i = 0; i < 4; ++i) { lwv[i] = x0[i]; lwv[4 + i] = x1[i]; lav[i] = y0[i]; lav[4 + i] = y1[i]; } }
            float rr[8], k2[8], vv[8], dec[8], av[8], kkv[8]; float ssq = 0.f, bsum = 0.f;
#pragma unroll
            for (int i = 0; i < 8; ++i) {
                const float r = rc[i] + (rp[i] - rc[i]) * muR[i], k = kc[i] + (kp[i] - kc[i]) * muK[i], v = vc[i] + (vp[i] - vc[i]) * muV[i];
                dec[i] = __expf(-0.6065306597126334f * sigmoidf_(w0v[i] + lwv[i]));
                const float a = sigmoidf_(a0v[i] + lav[i]);
                const float kq = k * kkw[i];
                ssq += kq * kq; kkv[i] = kq;
                const float kk2 = k * (1.0f + (a - 1.0f) * kaw[i]);
                bsum += r * kk2 * rkw[i];
                rr[i] = r; k2[i] = kk2; vv[i] = v; av[i] = a;
            }
            ssq = red8(ssq); bsum = red8(bsum);
            const float inv = 1.0f / fmaxf(sqrtf(ssq), 1e-12f);
            float na[8], nb[8];
#pragma unroll
            for (int i = 0; i < 8; ++i) { const float kn = kkv[i] * inv; na[i] = -kn; nb[i] = kn * av[i]; }
            unsigned char* rec = stream + ((size_t)(b * 8 + head) * T + tpos) * SREC;
            *(f32x4*)(rec + 4 * cc) = (f32x4){dec[0], dec[1], dec[2], dec[3]}; *(f32x4*)(rec + 4 * cc + 16) = (f32x4){dec[4], dec[5], dec[6], dec[7]};
            *(u32x4*)(rec + 256 + 2 * cc) = pack8(rr);
            *(u32x4*)(rec + 384 + 2 * cc) = pack8(k2);
            *(u32x4*)(rec + 512 + 2 * cc) = pack8(na);
            *(u32x4*)(rec + 640 + 2 * cc) = pack8(nb);
            *(u32x4*)(rec + 768 + 2 * cc) = pack8(vv);
            if ((cv & 7) == 0) bonus[(size_t)tok * 8 + head] = bsum;
        }
    }
    __syncthreads();
}

__device__ __forceinline__ void ret_r2(const Params& p) {
    const float* kvT = (const float*)(p.ws + OFF_KVT); bf16_t* rp = (bf16_t*)(p.ws + OFF_RPREV);
    const int gtid = blockIdx.x * 512 + tid_(), nth = gridDim.x * 512;
    for (int i2 = gtid; i2 < 16 * 8192; i2 += nth) {
        const int bh = i2 >> 13, ed = (i2 & 8191) * 2, h = bh & 3;
        const float cd = exp2f(128.0f * ret_lg(h));
        const size_t o0 = ((size_t)(bh * 32) << 14) + ed;
        f32x2 kv[31];
#pragma unroll
        for (int n = 0; n < 31; ++n) kv[n] = __builtin_nontemporal_load((const f32x2*)(kvT + o0 + ((size_t)n << 14)));
        float r0 = 0.f, r1 = 0.f;
#pragma unroll
        for (int n = 0; n < 32; ++n) {
            *(unsigned*)(rp + o0 + ((size_t)n << 14)) = pk2(r0, r1);
            if (n < 31) { r0 = cd * r0 + kv[n][0]; r1 = cd * r1 + kv[n][1]; }
        }
    }
}

constexpr int SCH = 32;
constexpr int SREC_F = 384;
constexpr int SBUF_F = SCH * SREC_F;
__device__ __forceinline__ void rwkv_scan_item(const Params& p, int item, LAS float* lds, LAS unsigned* roletab) {
    const int tid = tid_(), wid = tid >> 6, lane = tid & 63;
    const int bh = (item & 7) + 8 * ((item >> 3) & 3), rg = item >> 5, b = bh >> 3, h = bh & 7;
    const unsigned char* sbase = p.ws + OFF_STREAM + (size_t)bh * T * SREC;
    constexpr int NCH = T / SCH;
    if (lane == 0) roletab[wid] = (unsigned)__builtin_amdgcn_s_getreg((1 << 11) | (4 << 6) | 4) & 3u;
    __syncthreads();
    int srole = -1, lrole = -1;
    {
        int sd[8];
#pragma unroll
        for (int i = 0; i < 8; ++i) sd[i] = (int)roletab[i];
        const int sA = 0; int sB = -1;
#pragma unroll
        for (int i = 1; i < 8; ++i) if (sB < 0 && sd[i] != sd[0]) sB = i;
        if (sB < 0) sB = 1;
        int nl = 0;
#pragma unroll
        for (int i = 0; i < 8; ++i) { const bool free_ = (i != sA) && (i != sB) && sd[i] != sd[sA] && sd[i] != sd[sB]; if (free_ && nl < 4) { if (i == wid) lrole = nl; ++nl; } }
#pragma unroll
        for (int i = 0; i < 8; ++i) { const bool other = (i != sA) && (i != sB) && !(sd[i] != sd[sA] && sd[i] != sd[sB]); if (other && nl < 4) { if (i == wid) lrole = nl; ++nl; } }
        if (wid == sA) srole = 0; else if (wid == sB) srole = 1;
    }
    const bool scanner = srole >= 0, loader = lrole >= 0;
    const int lt = lrole * 64 + lane;
    LAS float* ybuf = lds + 2 * SBUF_F;
    bf16_t* proj = (bf16_t*)(p.ws + OFF_PROJ);
    float* ybase = (float*)(proj + (size_t)(b * T) * DINP + C_RW) + h * 64 + rg * 8;
    u32x4 reg[7];
    auto ld = [&](int c) {
        const u32x4* src = (const u32x4*)(sbase + (size_t)c * SCH * SREC);
#pragma unroll
        for (int i = 0; i < 7; ++i) reg[i] = src[lt + i * 256];
    };
    auto st = [&](int buf) {
        LAS float* dst = lds + buf * SBUF_F;
#pragma unroll
        for (int i = 0; i < 7; ++i) { const int v = lt + i * 256;
            const int s = v / 56, wi = v % 56; const u32x4 r = reg[i];
            if (wi < 16) { *(LAS u32x4*)(dst + s * SREC_F + wi * 4) = r; }
            else { const int a = (wi - 16) >> 3, pos = ((wi - 16) & 7) * 8; LAS float* d = dst + s * SREC_F + 64 + a * 64 + pos;
                *(LAS f32x4*)d = (f32x4){bflo(r.x), bfhi(r.x), bflo(r.y), bfhi(r.y)}; *(LAS f32x4*)(d + 4) = (f32x4){bflo(r.z), bfhi(r.z), bflo(r.w), bfhi(r.w)}; }
        }
    };
    auto yred = [&](int c) {
        const LAS float* yp = ybuf + (c & 1) * (SCH * 128) + lt * 16;
        const f32x4 a0 = *(const LAS f32x4*)yp, a1 = *(const LAS f32x4*)(yp + 4), a2 = *(const LAS f32x4*)(yp + 8), a3 = *(const LAS f32x4*)(yp + 12);
        const f32x4 sm = (a0 + a1) + (a2 + a3);
        ybase[(size_t)(c * SCH + (lt >> 3)) * (DINP / 2) + (lt & 7)] = (sm[0] + sm[1]) + (sm[2] + sm[3]);
    };
    if (loader) { ld(0); st(0); ld(1); }
    if (scanner) __builtin_amdgcn_s_setprio(3);
    __syncthreads();
    const int rr = lane >> 4, q = lane & 15, rl = (srole & 1) * 4 + rr, row = rg * 8 + rl;
    f32x2 S0 = (f32x2){0.f, 0.f}, S1 = (f32x2){0.f, 0.f};
    for (int c = 0; c < NCH; ++c) {
        if (loader) {
            if (c + 1 < NCH) st((c + 1) & 1);
            if (c + 2 < NCH) ld(c + 2);
            if (c > 0) yred(c - 1);
        } else if (scanner) {
            const LAS float* cb = lds + (c & 1) * SBUF_F + q * 4;
            const LAS float* vb = lds + (c & 1) * SBUF_F + 320 + row;
            LAS float* yb = ybuf + (c & 1) * (SCH * 128) + rl * 16 + q;
            f32x4 w4 = *(const LAS f32x4*)(cb), r4 = *(const LAS f32x4*)(cb + 64), k4 = *(const LAS f32x4*)(cb + 128), a4 = *(const LAS f32x4*)(cb + 192), b4 = *(const LAS f32x4*)(cb + 256);
            float vv = vb[0];
            f32x4 w5 = *(const LAS f32x4*)(cb + SREC_F), r5 = *(const LAS f32x4*)(cb + SREC_F + 64), k5 = *(const LAS f32x4*)(cb + SREC_F + 128), a5 = *(const LAS f32x4*)(cb + SREC_F + 192), b5 = *(const LAS f32x4*)(cb + SREC_F + 256);
            float v5 = vb[SREC_F];
#pragma unroll
            for (int s = 0; s < SCH; ++s) {
                f32x4 nw = w5, nr = r5, nk = k5, na = a5, nb = b5; float nv = v5;
                if (s + 2 < SCH) {
                    const LAS float* nbp = cb + (s + 2) * SREC_F;
                    nw = *(const LAS f32x4*)(nbp); nr = *(const LAS f32x4*)(nbp + 64); nk = *(const LAS f32x4*)(nbp + 128); na = *(const LAS f32x4*)(nbp + 192); nb = *(const LAS f32x4*)(nbp + 256);
                    nv = vb[(s + 2) * SREC_F];
                }
                f32x2 t = S0 * (f32x2){a4[0], a4[1]};
                t = __builtin_elementwise_fma(S1, (f32x2){a4[2], a4[3]}, t);
                float pa = t[0] + t[1];
                pa = red16(pa);
                const f32x2 vk0 = (f32x2){vv, vv} * (f32x2){k4[0], k4[1]}, vk1 = (f32x2){vv, vv} * (f32x2){k4[2], k4[3]};
                const f32x2 t0 = __builtin_elementwise_fma(S0, (f32x2){w4[0], w4[1]}, vk0), t1 = __builtin_elementwise_fma(S1, (f32x2){w4[2], w4[3]}, vk1);
                S0 = __builtin_elementwise_fma((f32x2){pa, pa}, (f32x2){b4[0], b4[1]}, t0);
                S1 = __builtin_elementwise_fma((f32x2){pa, pa}, (f32x2){b4[2], b4[3]}, t1);
                f32x2 u = S0 * (f32x2){r4[0], r4[1]};
                u = __builtin_elementwise_fma(S1, (f32x2){r4[2], r4[3]}, u);
                yb[s * 128] = u[0] + u[1];
                w4 = w5; r4 = r5; k4 = k5; a4 = a5; b4 = b5; vv = v5;
                w5 = nw; r5 = nr; k5 = nk; a5 = na; b5 = nb; v5 = nv;
            }
        }
        __syncthreads();
    }
    if (loader) yred(NCH - 1);
    if (scanner) __builtin_amdgcn_s_setprio(0);
    __syncthreads();
}

__device__ __forceinline__ void ret_r3_item(const Params& p, int l, int item, LAS bf16_t* lds) {
    const int tid = tid_(), wid = tid >> 6, lane = tid & 63, fr = lane & 15, fq = lane >> 4;
    const int n = item & 31, bh = item >> 5, h = bh & 3, b = bh >> 2, tok0 = b * T + n * 128;
    const float lg = ret_lg(h);
    LAS bf16_t* Q = lds; LAS bf16_t* Kk = lds + 128 * LDS_LD; LAS bf16_t* VT = lds + 2 * 128 * LDS_LD; LAS bf16_t* RP = lds + 3 * 128 * LDS_LD;
    {
        const bf16_t* rp = (const bf16_t*)(p.ws + OFF_RPREV) + ((size_t)item << 14);
        RotCS cs[2]; u32x4 qa[2], qb[2], ka[2], kb[2], rv[4], rpv[4];
        fetch_qk(p, qa, qb, tid, tok0, C_Q + h * 128); fetch_qk(p, ka, kb, tid, tok0, C_K + h * 128); fetch_cs(p, cs, tid, tok0);
        fetch_v(p, rv, tid, tok0, C_V + h * 128);
#pragma unroll
        for (int it = 0; it < 4; ++it) rpv[it] = *(const u32x4*)(rp + (size_t)(tid + it * 512) * 8);
        store_rot<false>(Q, qa, qb, cs, tid, 1.0f, 0.f);
        store_rot<false>(Kk, ka, kb, cs, tid, 0.08838834764831845f, 0.f);
        store_vT(VT, rv, tid);
#pragma unroll
        for (int it = 0; it < 4; ++it) { const int u = tid + it * 512, e = u >> 4, d0 = (u & 15) * 8; *(LAS u32x4*)(RP + e * LDS_LD + d0) = rpv[it]; }
    }
    __syncthreads();
    const int i0 = wid * 16;
    f32x4 acc[8], sc_[8];
#pragma unroll
    for (int i = 0; i < 8; ++i) { acc[i] = (f32x4){0.f, 0.f, 0.f, 0.f}; sc_[i] = (f32x4){0.f, 0.f, 0.f, 0.f}; }
    strip_mma(Q, i0, RP, acc, fr, fq);
    strip_mma(Q, i0, Kk, sc_, fr, fq);
#pragma unroll
    for (int jj = 0; jj < 4; ++jj) { const float sc = exp2f(lg * (float)(i0 + fq * 4 + jj + 1));
#pragma unroll
        for (int nn = 0; nn < 8; ++nn) acc[nn][jj] *= sc; }
    asm volatile("s_waitcnt lgkmcnt(0)" ::: "memory");
    LAS bf16_t* P = Q;
    {
        float rf[4], cf[8];
#pragma unroll
        for (int jj = 0; jj < 4; ++jj) rf[jj] = exp2f(lg * (float)(i0 + fq * 4 + jj));
#pragma unroll
        for (int nn = 0; nn < 8; ++nn) cf[nn] = exp2f(-lg * (float)(nn * 16 + fr));
#pragma unroll
        for (int nn = 0; nn < 8; ++nn)
#pragma unroll
            for (int jj = 0; jj < 4; ++jj) {
                const int i = i0 + fq * 4 + jj, j = nn * 16 + fr;
                const float m = (i >= j) ? rf[jj] * cf[nn] : 0.f;
                P[i * LDS_LD + j] = f2bf(sc_[nn][jj] * m);
            }
    }
    asm volatile("s_waitcnt lgkmcnt(0)" ::: "memory");
    strip_mma(P, i0, VT, acc, fr, fq);
    if (n == 0 && wid == 0 && fq == 0) {
        const float s0 = ((const float*)(p.ws + OFF_SACC))[b * 4 + h];
#pragma unroll
        for (int nn = 0; nn < 8; ++nn) acc[nn][0] = s0 * bf2f(VT[(nn * 16 + fr) * LDS_LD]);
    }
    asm volatile("s_waitcnt lgkmcnt(0)" ::: "memory");
    const bf16_t* proj = (const bf16_t*)(p.ws + OFF_PROJ);
    bf16_t* br1 = (bf16_t*)(p.ws + OFF_BR) + (size_t)BT * BW;
    const float* gn = p.ret_norm_g + l * BW + h * 128;
    float gv[8];
#pragma unroll
    for (int nn = 0; nn < 8; ++nn) gv[nn] = gn[nn * 16 + fr];
#pragma unroll
    for (int jj = 0; jj < 4; ++jj) {
        float s = 0.f;
#pragma unroll
        for (int nn = 0; nn < 8; ++nn) s += acc[nn][jj];
        s = red16(s); const float mean = s * (1.0f / 128.0f);
        float vs = 0.f;
#pragma unroll
        for (int nn = 0; nn < 8; ++nn) { const float d = acc[nn][jj] - mean; vs += d * d; }
        vs = red16(vs); const float rstd = rsqrtf(vs * (1.0f / 128.0f) + 1e-5f);
#pragma unroll
        for (int nn = 0; nn < 8; ++nn) Q[(i0 + fq * 4 + jj) * LDS_LD + nn * 16 + fr] = f2bf((acc[nn][jj] - mean) * rstd * gv[nn]);
    }
    asm volatile("s_waitcnt lgkmcnt(0)" ::: "memory");
#pragma unroll
    for (int it = 0; it < 4; ++it) {
        const int i = i0 + it * 4 + fq, e0 = fr * 8;
        const size_t tok = (size_t)(tok0 + i);
        float ov[8], gt[8], o[8];
        unpack8(*(const LAS u32x4*)(Q + i * LDS_LD + e0), ov);
        unpack8(*(const u32x4*)(proj + tok * DINP + C_RG + h * 128 + e0), gt);
#pragma unroll
        for (int k = 0; k < 8; ++k) o[k] = ov[k] * siluf_(gt[k]);
        *(u32x4*)(br1 + tok * BW + h * 128 + e0) = pack8(o);
    }
    __syncthreads();
}

__device__ __forceinline__ void c0_item(const Params& p, int l, unsigned char* shm) {
    const int tid = tid_(), b = tid >> 7, h = (tid >> 4) & 7, q = tid & 15, ch = h * 64 + q * 4;
    float* P0 = (float*)shm;
    {
        const float* pp = (const float*)(p.ws + OFF_P0F);
        float v18[18];
#pragma unroll
        for (int j = 0; j < 18; ++j) v18[j] = pp[tid + j * 512];
#pragma unroll
        for (int j = 0; j < 18; ++j) P0[tid + j * 512] = v18[j];
    }
    __syncthreads();
    {
        const int b2 = tid >> 7, h2 = (tid >> 5) & 3, l32 = tid & 31;
        const f32x4 qv = *(const f32x4*)(P0 + b2 * P0W + 1152 + h2 * 128 + l32 * 4), kv = *(const f32x4*)(P0 + b2 * P0W + 1664 + h2 * 128 + l32 * 4);
        float sp = (qv[0] * kv[0] + qv[1] * kv[1]) + (qv[2] * kv[2] + qv[3] * kv[3]);
        sp = red16(sp); sp += __shfl_xor(sp, 16);
        if (l32 == 0) ((float*)(p.ws + OFF_SACC))[b2 * 4 + h2] = sp * 0.08838834764831845f;
    }
    const float* p0 = P0 + b * P0W;
    const float* mu = p.shift_mu + l * RW_W;
    float* AL = P0 + NB * P0W;
    if (tid < 256) AL[tid] = P0[(tid >> 6) * P0W + 1024 + (tid & 63)] * (1.0f - mu[RW_AL + (tid & 63)]);
    __syncthreads();
    f32x4 aacc = *(const f32x4*)(p.a0 + l * BW + ch);
#pragma unroll
    for (int i0 = 0; i0 < 64; i0 += 32) {
        f32x4 rows[32];
#pragma unroll
        for (int j = 0; j < 32; ++j) rows[j] = *(const f32x4*)(p.a2 + ((size_t)l * 64 + i0 + j) * BW + ch);
#pragma unroll
        for (int j = 0; j < 32; ++j) aacc += AL[b * 64 + i0 + j] * rows[j];
    }
    const f32x4 r0 = *(const f32x4*)(p0 + ch), k0v = *(const f32x4*)(p0 + 512 + ch);
    const f32x4 ka = *(const f32x4*)(p.k_a + l * BW + ch);
    float cpart = 0.f;
#pragma unroll
    for (int i = 0; i < 4; ++i) { const float av = 1.0f / (1.0f + expf(-aacc[i]));
        const float rr_ = r0[i] * (1.0f - mu[RW_R + ch + i]), kk_ = k0v[i] * (1.0f - mu[RW_K + ch + i]);
        cpart += rr_ * (kk_ * (1.0f + (av - 1.0f) * ka[i])); }
    const float c0 = red16(cpart);
    if (q == 0) ((float*)(p.ws + OFF_CACC))[b * 8 + h] = c0;
    __syncthreads();
}
__device__ __forceinline__ void rwkv_post(const Params& p, int l) {
    const bf16_t* proj = (const bf16_t*)(p.ws + OFF_PROJ);
    bf16_t* br2 = (bf16_t*)(p.ws + OFF_BR) + (size_t)2 * BT * BW;
    const float* bonus = (const float*)(p.ws + OFF_BONUS);
    const unsigned char* stream = p.ws + OFF_STREAM;
    const float* ln_w = p.ln_w + l * BW; const float* ln_b = p.ln_b + l * BW;
    const int gtid = blockIdx.x * 512 + tid_(), nth = gridDim.x * 512;
    for (int idx = gtid; idx < BT * 128; idx += nth) {
        const int tok = idx >> 7, h = (idx >> 4) & 7, q = idx & 15, ch = h * 64 + q * 4, b = tok >> 12, tpos = tok & (T - 1);
        f32x4 y = *(const f32x4*)((const float*)(proj + (size_t)tok * DINP + C_RW) + ch);
        if (tpos == 0) {
            const float c0 = ((const float*)(p.ws + OFF_CACC))[b * 8 + h];
            const u32x2 vq = *(const u32x2*)(stream + ((size_t)(b * 8 + h) * T) * SREC + 768 + q * 8);
            y = (f32x4){bflo(vq.x) * c0, bfhi(vq.x) * c0, bflo(vq.y) * c0, bfhi(vq.y) * c0};
        }
        float s = (y[0] + y[1]) + (y[2] + y[3]); s = red16(s); const float mean = s * (1.0f / 64.0f);
        const f32x4 d = y - mean;
        float vs = (d[0] * d[0] + d[1] * d[1]) + (d[2] * d[2] + d[3] * d[3]); vs = red16(vs);
        const float rstd = rsqrtf(vs * (1.0f / 64.0f) + 64e-5f);
        const u32x2 vv = *(const u32x2*)(stream + ((size_t)(b * 8 + h) * T + tpos) * SREC + 768 + q * 8);
        const u32x2 gg = *(const u32x2*)(proj + (size_t)tok * DINP + C_RWG + ch);
        const float bs = bonus[(size_t)tok * 8 + h];
        const float v4[4] = {bflo(vv.x), bfhi(vv.x), bflo(vv.y), bfhi(vv.y)}, g4[4] = {bflo(gg.x), bfhi(gg.x), bflo(gg.y), bfhi(gg.y)};
        float o[4];
#pragma unroll
        for (int i = 0; i < 4; ++i) o[i] = (d[i] * rstd * ln_w[ch + i] + ln_b[ch + i] + bs * v4[i]) * siluf_(g4[i]);
        u32x2 w; w.x = pk2(o[0], o[1]); w.y = pk2(o[2], o[3]);
        *(u32x2*)(br2 + (size_t)tok * BW + ch) = w;
    }
}


__device__ __forceinline__ void gemm_inproj(const Params& p, LAS unsigned char* lds) {
    pg8::Gemm g{(const bf16_t*)(p.ws + OFF_H), (const bf16_t*)(p.ws + p.img_off + OFF_WIN), BT, DINP, D}; pg8::StaticOrder S; S.init(BT, DINP, (int)gridDim.x, (int)blockIdx.x); EpiProj E{(bf16_t*)(p.ws + OFF_PROJ)};
    pg8::gemm_phase<EpiProj, pg8::StaticOrder, false>(lds, g, S, E, nullptr);
}
template <int NBR> __device__ __forceinline__ void gemm_merge1(const Params& p, LAS unsigned char* lds) {
    const bf16_t* br = (const bf16_t*)(p.ws + OFF_BR); const bf16_t* Wt_br = (const bf16_t*)(p.ws + OFF_WBR);
    pg8::StaticOrder S; S.init(BT, D, (int)gridDim.x, (int)blockIdx.x);
    pg8::Gemm g{br + (size_t)NBR * BT * BW, Wt_br + (size_t)NBR * D * BW, BT, D, BW};
    EpiMerge<NBR> E{(const bf16_t*)(p.ws + OFF_PROJ), (float*)(p.ws + OFF_MERGED), (bf16_t*)(p.ws + OFF_MERGEDB)};
    pg8::gemm_phase<EpiMerge<NBR>, pg8::StaticOrder, false>(lds, g, S, E, nullptr);
}
__device__ __forceinline__ void gemm_merge(const Params& p, LAS unsigned char* lds) { gemm_merge1<0>(p, lds); gemm_merge1<1>(p, lds); gemm_merge1<2>(p, lds); }
__device__ __forceinline__ void gemm_merge_all(const Params& p, LAS unsigned char* lds) {
    pg8::Gemm g{(const bf16_t*)(p.ws + OFF_BR), (const bf16_t*)(p.ws + OFF_WBR), 3 * BT, 3 * D, BW};
    MergeOrder S; S.base.init(BT, D, (int)gridDim.x, (int)blockIdx.x);
    EpiMergeAll E{(const bf16_t*)(p.ws + OFF_PROJ), (float*)(p.ws + OFF_MERGED), (bf16_t*)(p.ws + OFF_MERGEDB)};
    pg8::gemm_phase<EpiMergeAll, MergeOrder, false>(lds, g, S, E, nullptr);
}
__device__ __forceinline__ void gemm_out(const Params& p, int l, const float* xin, LAS unsigned char* lds) {
    pg8::Gemm g{(const bf16_t*)(p.ws + OFF_MERGEDB), (const bf16_t*)(p.ws + p.img_off + OFF_WOUT), BT, D, D}; pg8::StaticOrder S; S.init(BT, D, (int)gridDim.x, (int)blockIdx.x);
    EpiOut E{xin, p.out, (const float*)(p.ws + OFF_MOD) + (size_t)l * NB * 3 * D + 2 * D};
    pg8::gemm_phase<EpiOut, pg8::StaticOrder, false>(lds, g, S, E, nullptr);
}
constexpr int MG_BK = 64, MG_A_BYTES = 256 * MG_BK * 2, MG_B_BYTES = 128 * MG_BK * 2, MG_STAGE = MG_A_BYTES + MG_B_BYTES;
template <int DRY> __device__ __forceinline__ void gemm_merge_fused(const Params& p, LAS unsigned char* lds) {
    const int tid = tid_(), wid = tid >> 6, lane = tid & 63, fr = lane & 15, fq = lane >> 4, wr = wid >> 1, wc = wid & 1;
    const bf16_t* br = (const bf16_t*)(p.ws + OFF_BR); const bf16_t* Wt = (const bf16_t*)(p.ws + p.img_off + OFF_WBR);
    const bf16_t* proj = (const bf16_t*)(p.ws + OFF_PROJ); bf16_t* mergedb = (bf16_t*)(p.ws + OFF_MERGEDB);
    int a_off[4], b_off[2];
#pragma unroll
    for (int i = 0; i < 4; ++i) { const int c = tid + i * 512, row = c >> 3; a_off[i] = row * BW + (((c & 7) ^ (row & 7)) * 8); }
#pragma unroll
    for (int i = 0; i < 2; ++i) { const int c = tid + i * 512, row = c >> 3; b_off[i] = row * BW + (((c & 7) ^ (row & 7)) * 8); }
    f32x4 tot[4][4], acc[4][4];
    int nmine = 0; for (int u = (int)blockIdx.x; u < 512; u += (int)gridDim.x) ++nmine;
    const int nsteps = nmine * 24;
    auto unit_of = [&](int ui, int& pm, int& pn) { const int u = (int)blockIdx.x + ui * (int)gridDim.x; pm = (u & 7) + 8 * (u >> 6); pn = (u >> 3) & 7; };
    auto dma = [&](int g) {
        const int ui = g / 24, r = g - ui * 24, n = r >> 3, t = r & 7; int pm, pn; unit_of(ui, pm, pn);
        const bf16_t* A = br + (size_t)n * BT * BW + (size_t)(pm * 256) * BW + t * MG_BK;
        const bf16_t* Bw = Wt + (size_t)n * D * BW + (size_t)(pn * 128) * BW + t * MG_BK;
        LAS unsigned char* base = lds + (g % 3) * MG_STAGE + wid * 1024;
#pragma unroll
        for (int i = 0; i < 4; ++i) __builtin_amdgcn_global_load_lds((const unsigned*)(A + a_off[i]), (LAS unsigned*)(base + i * 8192), 16, 0, 0);
#pragma unroll
        for (int i = 0; i < 2; ++i) __builtin_amdgcn_global_load_lds((const unsigned*)(Bw + b_off[i]), (LAS unsigned*)(base + MG_A_BYTES + i * 8192), 16, 0, 0);
    };
#pragma unroll
    for (int m = 0; m < 4; ++m)
#pragma unroll
        for (int n = 0; n < 4; ++n) { tot[m][n] = (f32x4){0.f, 0.f, 0.f, 0.f}; acc[m][n] = (f32x4){0.f, 0.f, 0.f, 0.f}; }
    if (nsteps > 0) { dma(0); if (nsteps > 1) { dma(1); asm volatile("s_waitcnt vmcnt(6)" ::: "memory"); } else asm volatile("s_waitcnt vmcnt(0)" ::: "memory"); }
    __builtin_amdgcn_s_barrier(); asm volatile("" ::: "memory");
    for (int g = 0; g < nsteps; ++g) {
        {
            const LAS unsigned char* Ab = lds + (g % 3) * MG_STAGE; const LAS unsigned char* Bb = Ab + MG_A_BYTES;
#pragma unroll
            for (int kk = 0; kk < 2; ++kk) {
                if (kk == 1 && g + 2 < nsteps) dma(g + 2);
                bf16x8 af[4], bfv[4];
#pragma unroll
                for (int m = 0; m < 4; ++m) { const int row = wr * 64 + m * 16 + fr; af[m] = *(const LAS bf16x8*)(Ab + row * 128 + (((kk * 4 + fq) ^ (row & 7)) * 16)); }
#pragma unroll
                for (int n = 0; n < 4; ++n) { const int row = wc * 64 + n * 16 + fr; bfv[n] = *(const LAS bf16x8*)(Bb + row * 128 + (((kk * 4 + fq) ^ (row & 7)) * 16)); }
                __builtin_amdgcn_s_setprio(1);
#pragma unroll
                for (int m = 0; m < 4; ++m)
#pragma unroll
                    for (int n = 0; n < 4; ++n) { if (DRY != 1) acc[m][n] = __builtin_amdgcn_mfma_f32_16x16x32_bf16(bfv[n], af[m], acc[m][n], 0, 0, 0); else { asm volatile("" :: "v"(bfv[n]), "v"(af[m])); } }
                __builtin_amdgcn_s_setprio(0);
            }
        }
        const int ui = g / 24, r = g - ui * 24, nb = r >> 3, t = r & 7;
        if (t == 7 && DRY == 0) {
            int pm, pn; unit_of(ui, pm, pn);
            const int row0 = pm * 256 + wr * 64 + fr, col0 = pn * 128 + wc * 64 + fq * 4;
#pragma unroll
            for (int m = 0; m < 4; ++m)
#pragma unroll
                for (int n = 0; n < 4; ++n) {
                    const u32x2 lg = *(const u32x2*)(proj + (size_t)(row0 + m * 16) * DINP + C_GATE + nb * D + col0 + n * 16);
                    tot[m][n][0] += sigmoidf_(bflo(lg.x)) * acc[m][n][0]; tot[m][n][1] += sigmoidf_(bfhi(lg.x)) * acc[m][n][1];
                    tot[m][n][2] += sigmoidf_(bflo(lg.y)) * acc[m][n][2]; tot[m][n][3] += sigmoidf_(bfhi(lg.y)) * acc[m][n][3];
                    acc[m][n] = (f32x4){0.f, 0.f, 0.f, 0.f};
                }
            if (nb == 2) {
#pragma unroll
                for (int m = 0; m < 4; ++m)
#pragma unroll
                    for (int n = 0; n < 4; ++n) {
                        u32x2 w; w.x = pk2(tot[m][n][0], tot[m][n][1]); w.y = pk2(tot[m][n][2], tot[m][n][3]);
                        *(u32x2*)(mergedb + (size_t)(row0 + m * 16) * D + col0 + n * 16) = w;
                        tot[m][n] = (f32x4){0.f, 0.f, 0.f, 0.f};
                    }
            }
        }
        if (g + 2 < nsteps) asm volatile("s_waitcnt vmcnt(6)" ::: "memory"); else asm volatile("s_waitcnt vmcnt(0)" ::: "memory");
        asm volatile("s_waitcnt lgkmcnt(0)" ::: "memory");
        __builtin_amdgcn_s_barrier(); asm volatile("" ::: "memory");
    }
    __syncthreads();
}

#ifndef DUP_P1
#define DUP_P1 0
#endif
#ifndef DUP_P2
#define DUP_P2 0
#endif
#ifndef DUP_P3A
#define DUP_P3A 0
#endif
#ifndef DUP_P3B
#define DUP_P3B 0
#endif
#ifndef DUP_P3C
#define DUP_P3C 0
#endif
#ifndef DUP_P4
#define DUP_P4 0
#endif
#ifndef DUP_P5A
#define DUP_P5A 0
#endif
#ifndef DUP_P5B
#define DUP_P5B 0
#endif
#ifndef DUP_P6
#define DUP_P6 0
#endif
#ifndef DUP_P7
#define DUP_P7 0
#endif
#ifndef DUP_P0
#define DUP_P0 0
#endif
#ifndef DUP_R2
#define DUP_R2 0
#endif
#ifndef DUP_P6DRY
#define DUP_P6DRY 0
#endif
#ifndef DUP_P6NOEPI
#define DUP_P6NOEPI 0
#endif
#ifndef DUP_SYNC
#define DUP_SYNC 0
#endif
#if defined(__HIP_DEVICE_COMPILE__)
#define FRESH_PARAMS(q) Params q; { const __attribute__((address_space(4))) Params* pp_ = (const __attribute__((address_space(4))) Params*)__builtin_amdgcn_kernarg_segment_ptr(); asm volatile("" : "+s"(pp_)); q = *pp_; }
#else
#define FRESH_PARAMS(q) Params q = p_unused;
#endif
__global__ void __launch_bounds__(512, 2) fwd_megakernel(Params p_unused) {
    extern __shared__ __attribute__((aligned(16))) unsigned char shm[];
    cg::grid_group grid = cg::this_grid();
    LAS unsigned char* lds = (LAS unsigned char*)shm;
    const int G = (int)gridDim.x, bid = (int)blockIdx.x;
    volatile LAS unsigned* xb_st = (volatile LAS unsigned*)(lds + LDS_MAIN);
    if (tid_() == 0) { xb_st[0] = 0u; xb_st[1] = 0u; xb_st[2] = 0u; xb_st[3] = 0u; }
    __syncthreads();
    { FRESH_PARAMS(p); (void)xcd_barrier_post((unsigned*)(p.ws + OFF_BAR), xb_st); }
#define GSYNC() do { FRESH_PARAMS(pb_); XcdBarrier b_; b_.bar = (unsigned*)(pb_.ws + OFF_BAR); b_.x = xb_xcc_id(); b_.st = xb_st; xcd_barrier(b_); } while (0)

    for (int rep = 0; rep <= DUP_P0; ++rep) { FRESH_PARAMS(p); phase0(p, shm); }
    __syncthreads();
    { FRESH_PARAMS(p); p.img_off = 0; phase_weights(p, 0, shm, bid, G); }
    grid.sync();

#pragma nounroll
    for (int l = 0; l < NL; ++l) {
        for (int rep = 0; rep <= DUP_P1; ++rep) {
        { FRESH_PARAMS(p); phase_norm(p, l, (l == 0) ? p.x : p.out); }
        }
        GSYNC();
        for (int rep = 0; rep <= DUP_P2; ++rep) { FRESH_PARAMS(p); p.img_off = (size_t)(l & 1) * IMG_STRIDE; gemm_inproj(p, lds); }
        if (l + 1 < NL) { FRESH_PARAMS(p); p.img_off = (size_t)((l + 1) & 1) * IMG_STRIDE;
            if (G == 256) { if (bid >= 64) phase_weights(p, l + 1, shm, bid - 64, 192); }
            else phase_weights(p, l + 1, shm, bid, G); }
        { FRESH_PARAMS(p); const int first = (G == 256) ? 64 : 0; for (int it = bid - first; it >= 0 && it < 264; it += G - first) gemv0_item(p, l, it, shm); }
        GSYNC();
        for (int rep = 0; rep <= DUP_P3A; ++rep) { FRESH_PARAMS(p); for (int it = bid; it < BT / 64; it += G) pool_item(p, l, it); }
        for (int rep = 0; rep <= DUP_P3B; ++rep) { FRESH_PARAMS(p); for (int it = bid; it < 512; it += G) ret_r1_item(p, it, (LAS bf16_t*)lds); }
        for (int rep = 0; rep <= DUP_P3C; ++rep) { FRESH_PARAMS(p); p.img_off = (size_t)(l & 1) * IMG_STRIDE; for (int it = bid; it < BT / 32; it += G) rwkv_prep_item(p, l, it, (LAS bf16_t*)lds); }
        if (bid == G - 1) { FRESH_PARAMS(p); c0_item(p, l, shm); }
        GSYNC();
        for (int rep = 0; rep <= DUP_R2; ++rep) { FRESH_PARAMS(p); ret_r2(p); }
        for (int rep = 0; rep <= DUP_P4; ++rep) { FRESH_PARAMS(p); for (int it = bid; it < 256; it += G) rwkv_scan_item(p, it, (LAS float*)lds, (LAS unsigned*)(lds + LDS_MAIN + 16)); }
        GSYNC();
        for (int rep = 0; rep <= DUP_P5A; ++rep) { FRESH_PARAMS(p); for (int it = bid; it < 512; it += G) ret_r3_item(p, l, it, (LAS bf16_t*)lds); }
        for (int rep = 0; rep <= DUP_P5B; ++rep) { FRESH_PARAMS(p); rwkv_post(p, l); }
        GSYNC();
        for (int rep = 0; rep <= DUP_P6; ++rep) {
        { FRESH_PARAMS(p); p.img_off = (size_t)(l & 1) * IMG_STRIDE; gemm_merge_fused<0>(p, lds); }
        }
        GSYNC();
        for (int rep = 0; rep < DUP_P7; ++rep) { FRESH_PARAMS(p); p.img_off = (size_t)(l & 1) * IMG_STRIDE; Params q = p; q.out = (float*)(p.ws + OFF_MERGED); gemm_out(q, l, (l == 0) ? p.x : p.out, lds); }
        { FRESH_PARAMS(p); p.img_off = (size_t)(l & 1) * IMG_STRIDE; gemm_out(p, l, (l == 0) ? p.x : p.out, lds); }
        GSYNC();
        for (int rep = 0; rep < DUP_SYNC; ++rep) GSYNC();
    }
    { FRESH_PARAMS(p); phase_final_norm(p); }
}

extern "C" void kernel_launch(void* const* d_in, const int* in_sizes, int n_in, void* d_out, int out_size, void* d_ws, size_t ws_size, hipStream_t stream) {
    (void)in_sizes; (void)n_in; (void)out_size;
    if (ws_size < WS_NEED) { fprintf(stderr, "workspace too small: %zu < %zu\n", ws_size, (size_t)WS_NEED); return; }
    static int grid_blocks = 0;
    if (!grid_blocks) {
        int dev = 0, cus = 0, per_cu = 0;
        hipGetDevice(&dev);
        hipDeviceGetAttribute(&cus, hipDeviceAttributeMultiprocessorCount, dev);
        hipFuncSetAttribute((const void*)fwd_megakernel, hipFuncAttributeMaxDynamicSharedMemorySize, LDS_BYTES);
        hipOccupancyMaxActiveBlocksPerMultiprocessor(&per_cu, fwd_megakernel, 512, LDS_BYTES);
        if (per_cu < 1) per_cu = 1;
        grid_blocks = cus * per_cu;
        if (grid_blocks > 256) grid_blocks = 256;
    }
    Params p{};
    p.x = (const float*)d_in[0]; p.c = (const float*)d_in[1]; p.pos = (const int*)d_in[2];
    p.norm_g = (const float*)d_in[3]; p.w_ada = (const float*)d_in[4]; p.b_ada = (const float*)d_in[5]; p.w_in = (const float*)d_in[6];
    p.pool_w = (const float*)d_in[7]; p.pool_scale = (const float*)d_in[8]; p.ret_norm_g = (const float*)d_in[9]; p.shift_mu = (const float*)d_in[10];
    p.w0 = (const float*)d_in[11]; p.w2 = (const float*)d_in[12]; p.a0 = (const float*)d_in[13]; p.a2 = (const float*)d_in[14];
    p.k_k = (const float*)d_in[15]; p.k_a = (const float*)d_in[16]; p.r_k = (const float*)d_in[17]; p.ln_w = (const float*)d_in[18]; p.ln_b = (const float*)d_in[19];
    p.w_branch = (const float*)d_in[20]; p.w_out = (const float*)d_in[21]; p.final_g = (const float*)d_in[22];
    p.out = (float*)d_out; p.ws = (unsigned char*)d_ws;
    (void)hipMemsetAsync((unsigned char*)d_ws + OFF_BAR, 0, SZ_BAR, stream);
    void* args[] = {&p};
    hipError_t e = hipLaunchCooperativeKernel((const void*)fwd_megakernel, dim3(grid_blocks), dim3(512), args, LDS_BYTES, stream);
    if (e != hipSuccess) fprintf(stderr, "cooperative launch failed: %s (grid %d)\n", hipGetErrorString(e), grid_blocks);
}
```

```cpp
#include <hip/hip_runtime.h>
#include <hip/hip_cooperative_groups.h>
#include <cstdio>
namespace cg = cooperative_groups;

__device__ __forceinline__ int tid_() { int t = (int)__builtin_amdgcn_workitem_id_x(); asm volatile("" : "+v"(t)); return t; }
#define LAS __attribute__((address_space(3)))

#define XB_TMO      128
#define XB_XCNT(j)  (256  + 64 * (j))
#define XB_XSUB(j)  (1280 + 64 * (j))
#define XB_XGEN(j)  (2304 + 64 * (j))
#define XB_TOP      3328
#define XB_TOPGEN   3392
#define XCD_BAR_WORDS 3456
#define XB_SPIN_CAP (1u << 18)

__device__ __forceinline__ unsigned xb_ld(unsigned* p)              { return __hip_atomic_load(p, __ATOMIC_RELAXED, __HIP_MEMORY_SCOPE_AGENT); }
__device__ __forceinline__ unsigned xb_add(unsigned* p, unsigned v) { return __hip_atomic_fetch_add(p, v, __ATOMIC_RELAXED, __HIP_MEMORY_SCOPE_AGENT); }
__device__ __forceinline__ unsigned xb_xcc_id() { return (unsigned)__builtin_amdgcn_s_getreg((3 << 11) | 20) & 0xFu; }
#define XB_SPIN(cond, bar) do { unsigned _sp = 0; while (cond) { __builtin_amdgcn_s_sleep(1); \
    if ((++_sp & 255u) == 0u) { if (xb_ld(&(bar)[XB_TMO])) break; if (_sp > XB_SPIN_CAP) { atomicAdd(&(bar)[XB_TMO], 1u); break; } } } } while (0)

struct XcdBarrier {
    unsigned* bar; unsigned x;
    volatile LAS unsigned* st;
};

__device__ __forceinline__ XcdBarrier xcd_barrier_post(unsigned* bar, volatile LAS unsigned* st) {
    XcdBarrier b; b.bar = bar; b.x = xb_xcc_id(); b.st = st;
    if (tid_() == 0) (void)xb_add(&bar[XB_XCNT(b.x)], 1u);
    return b;
}
__device__ __forceinline__ void xcd_barrier_complete(unsigned* bar, unsigned x, unsigned& nloc, unsigned& nx) {
    const unsigned G = gridDim.x * gridDim.y * gridDim.z;
    unsigned sum, cnt, mine, sp = 0u;
    for (;;) {
        sum = 0u; cnt = 0u; mine = 0u;
#pragma unroll
        for (unsigned j = 0; j < 16; ++j) { const unsigned c = xb_ld(&bar[XB_XCNT(j)]); sum += c; cnt += (c > 0u) ? 1u : 0u; mine = (j == x) ? c : mine; }
        if (sum == G) break;
        __builtin_amdgcn_s_sleep(1);
        if ((++sp & 255u) == 0u) { if (xb_ld(&bar[XB_TMO])) break; if (sp > XB_SPIN_CAP) { atomicAdd(&bar[XB_TMO], 1u); break; } }
    }
    nloc = mine > 0u ? mine : 1u; nx = cnt > 0u ? cnt : 1u;
}

__device__ __forceinline__ void xcd_barrier(const XcdBarrier& b) {
    asm volatile("s_waitcnt vmcnt(0)" ::: "memory");
    __syncthreads();
    if (tid_() == 0) {
        unsigned* bar = b.bar;
        __builtin_amdgcn_s_waitcnt(0);
        unsigned nloc = b.st[0], nx = b.st[1];
        if (nloc == 0u) { xcd_barrier_complete(bar, b.x, nloc, nx); b.st[0] = nloc; b.st[1] = nx; }
        const unsigned old = xb_add(&bar[XB_XSUB(b.x)], 1u);
        const unsigned gen = old / nloc;
        if (old + 1u == (gen + 1u) * nloc) {
            __builtin_amdgcn_fence(__ATOMIC_RELEASE, "agent");
            asm volatile("s_waitcnt vmcnt(0)" ::: "memory");
            const unsigned og = xb_add(&bar[XB_TOP], 1u);
            const unsigned tg = og / nx;
            if (og + 1u == (tg + 1u) * nx) xb_add(&bar[XB_TOPGEN], 1u);
            else XB_SPIN(xb_ld(&bar[XB_TOPGEN]) == tg, bar);
            __builtin_amdgcn_fence(__ATOMIC_ACQUIRE, "agent");
            xb_add(&bar[XB_XGEN(b.x)], 1u);
            asm volatile("s_waitcnt vmcnt(0)" ::: "memory");
        } else {
            XB_SPIN(xb_ld(&bar[XB_XGEN(b.x)]) == gen, bar);
            __builtin_amdgcn_fence(__ATOMIC_ACQUIRE, "agent");
            asm volatile("s_waitcnt vmcnt(0)" ::: "memory");
        }
    }
    __syncthreads();
}
namespace pg8 {
#define PG8_LAS __attribute__((address_space(3)))
typedef unsigned short bf16_t;
typedef short bf16x8 __attribute__((ext_vector_type(8)));
typedef float f32x4 __attribute__((ext_vector_type(4)));
typedef unsigned u32x4 __attribute__((ext_vector_type(4)));
constexpr int BM = 256, BK = 64, HALF = 128, HTB = HALF * BK * 2  , STAGE_BYTES = 8 * HTB, NXCD = 8, WGM = 8;

__host__ __device__ __forceinline__ int lds_byte(int r, int c) { const int st = (r >> 4) * 2 + (c >> 5), rr = r & 15, cc = c & 31, ob = rr * 64 + cc * 2; return st * 1024 + (ob ^ (((ob >> 9) & 1) << 5)); }
__host__ __device__ __forceinline__ void stage_rc(int b, int& R, int& C) { const int st = b / 1024, sb = b % 1024, swz = sb ^ (((sb >> 9) & 1) << 5); R = (st >> 1) * 16 + swz / 64; C = (st & 1) * 32 + (swz % 64) / 2; }
__host__ __device__ __forceinline__ int perm32(int rho) { const int n = rho >> 4, i = rho & 15; return 8 * (i >> 2) + 4 * n + (i & 3); }

struct Unit { int pm, pn; };
struct Gemm { const bf16_t* A; const bf16_t* Bt; int M, N, K; };

struct StaticOrder {
    int nM, nN, nwg, G, c;
    __host__ __device__ void init(int M, int N, int G_, int c_) { nM = M / BM; nN = N / BM; nwg = nM * nN; G = G_; c = c_; }
    __host__ __device__ bool next(int i, Unit& u) const {
        const long L = (long)i * G + c; if (L >= nwg) return false;
        int wgid = (int)L; { const int q = nwg / NXCD, r = nwg % NXCD, xcd = wgid % NXCD, off = wgid / NXCD; wgid = (xcd < r ? xcd * (q + 1) : r * (q + 1) + (xcd - r) * q) + off; }
        const int nig = WGM * nN, gid = wgid / nig, fm = gid * WGM, gsz = (nM - fm) < WGM ? (nM - fm) : WGM;
        u.pm = fm + ((wgid % nig) % gsz); u.pn = (wgid % nig) / gsz; return true;
    }
    __device__ __forceinline__ void a_ready(const Unit&) const {}
    __device__ __forceinline__ void done(const Unit&) const {}
};
__device__ __forceinline__ unsigned cvt_pk_bf16(float lo, float hi) { unsigned r; asm volatile("v_cvt_pk_bf16_f32 %0, %1, %2" : "=v"(r) : "v"(lo), "v"(hi)); return r; }
typedef float f32x2 __attribute__((ext_vector_type(2)));

template <class Epi, class Sched, bool STAMP = false>
__device__ __forceinline__ void gemm_phase(PG8_LAS unsigned char* lds, const Gemm g, const Sched& S, const Epi& E, unsigned long long* stamps) {
    const int tid = tid_(), wid = __builtin_amdgcn_readfirstlane(tid >> 6), lane = tid & 63, wr = wid >> 2, wc = wid & 3, fr = lane & 15, fq = lane >> 4;
    const int K = g.K, nt = K / BK;
    int ts_lo = 0, ts_hi = 0, nts = 0; const unsigned long long rt_entry = STAMP ? (unsigned long long)wall_clock64() : 0ull;
#define PG8_STAMP() do { if (STAMP && wid == 0 && nts < 64) { const unsigned long long _c = (unsigned long long)clock64(); \
        ts_lo = (lane == nts) ? (int)(unsigned)_c : ts_lo; ts_hi = (lane == nts) ? (int)(unsigned)(_c >> 32) : ts_hi; ++nts; } } while (0)
    PG8_STAMP();
    unsigned voffA[2], voffB[2];
#pragma unroll
    for (int i = 0; i < 2; ++i) { int R, C; stage_rc(tid * 16 + i * 8192, R, C); const int Rb = Epi::PERM ? ((R & ~31) + perm32(R & 31)) : R;
        voffA[i] = (unsigned)(R * K + C) * 2u; voffB[i] = (unsigned)(Rb * K + C) * 2u; }
    const size_t kstep = (size_t)(BK * 2);
    const size_t hstep = (size_t)HALF * K * 2;
    const size_t tstep = 2 * hstep;
    const unsigned ldsw = (unsigned)wid * 1024u;
    const int aoff = lds_byte(wr * 64 + fr, fq * 8), boff = lds_byte(wc * 32 + fr, fq * 8);
#define PG8_SA(b, h) (((b) * 2 + (h)) * HTB)
#define PG8_SB(b, h) ((4 + (b) * 2 + (h)) * HTB)
#define PG8_STAGE(bufoff, gbase, voff) do { _Pragma("unroll") for (int _i = 0; _i < 2; ++_i) \
        __builtin_amdgcn_global_load_lds((const unsigned*)((const char*)(gbase) + (voff)[_i]), (PG8_LAS unsigned*)(lds + (bufoff) + ldsw + _i * 8192), 16, 0, 0); } while (0)
#define PG8_LDA(dst, b, h) do { _Pragma("unroll") for (int m = 0; m < 4; ++m) _Pragma("unroll") for (int k = 0; k < 2; ++k) dst[m][k] = *(const PG8_LAS bf16x8*)(lds + PG8_SA(b, h) + aoff + m * 2048 + k * 1024); } while (0)
#define PG8_LDB(dst, b, h) do { _Pragma("unroll") for (int n = 0; n < 2; ++n) _Pragma("unroll") for (int k = 0; k < 2; ++k) dst[n][k] = *(const PG8_LAS bf16x8*)(lds + PG8_SB(b, h) + boff + n * 2048 + k * 1024); } while (0)
#define PG8_MMA(ai, bj, At, Bt) do { __builtin_amdgcn_s_setprio(1); _Pragma("unroll") for (int m = 0; m < 4; ++m) _Pragma("unroll") for (int n = 0; n < 2; ++n) _Pragma("unroll") for (int k = 0; k < 2; ++k) \
        acc[ai][bj][m][n] = __builtin_amdgcn_mfma_f32_16x16x32_bf16(Bt[n][k], At[m][k], acc[ai][bj][m][n], 0, 0, 0); __builtin_amdgcn_s_setprio(0); } while (0)
#define PG8_WAIT_V(n) asm volatile("s_waitcnt vmcnt(" #n ")" ::: "memory")
#define PG8_WAIT_L(n) asm volatile("s_waitcnt lgkmcnt(" #n ")" ::: "memory")
#define PG8_BAR __builtin_amdgcn_s_barrier()
#define PG8_SCHED __builtin_amdgcn_sched_barrier(0)
    Unit cur, nxt; int ui = 0;
    if (!S.next(0, cur)) return;
    f32x4 acc[2][2][4][2];
#pragma unroll
    for (int a = 0; a < 2; ++a)
#pragma unroll
        for (int b = 0; b < 2; ++b)
#pragma unroll
            for (int m = 0; m < 4; ++m)
#pragma unroll
                for (int n = 0; n < 2; ++n) acc[a][b][m][n] = (f32x4){0.f, 0.f, 0.f, 0.f};
    bf16x8 At[4][2], B0[2][2], B1[2][2];
    const char* cA = (const char*)g.A + (size_t)cur.pm * tstep; const char* cB = (const char*)g.Bt + (size_t)cur.pn * tstep;
    S.a_ready(cur);
    PG8_STAGE(PG8_SB(0, 0), cB, voffB); PG8_STAGE(PG8_SA(0, 0), cA, voffA); PG8_STAGE(PG8_SB(0, 1), cB + hstep, voffB); PG8_STAGE(PG8_SA(0, 1), cA + hstep, voffA);
    if (wr == 1) PG8_BAR;
    PG8_WAIT_V(4); PG8_BAR;
    PG8_STAGE(PG8_SB(1, 0), cB + kstep, voffB); PG8_STAGE(PG8_SA(1, 0), cA + kstep, voffA); PG8_STAGE(PG8_SB(1, 1), cB + hstep + kstep, voffB);
    PG8_WAIT_V(6); PG8_BAR;
    PG8_STAMP();
    for (;;) {
        const bool has_next = S.next(ui + 1, nxt);
        const char* nA = has_next ? (const char*)g.A + (size_t)nxt.pm * tstep : cA; const char* nB = has_next ? (const char*)g.Bt + (size_t)nxt.pn * tstep : cB;
        for (int t = 0; t < nt; t += 2) {
            const bool last = (t == nt - 2);
            const char* a1 = cA + (size_t)(t + 1) * kstep;
            const char* a2 = last ? nA : cA + (size_t)(t + 2) * kstep; const char* b2 = last ? nB : cB + (size_t)(t + 2) * kstep;
            const char* a3 = a2 + kstep; const char* b3 = b2 + kstep;
            if (last && has_next) S.a_ready(nxt);
            PG8_LDB(B0, 0, 0); PG8_SCHED; PG8_LDA(At, 0, 0); PG8_STAGE(PG8_SA(1, 1), a1 + hstep, voffA);
            PG8_WAIT_L(8); PG8_BAR; PG8_WAIT_L(0); PG8_MMA(0, 0, At, B0); PG8_BAR; PG8_SCHED;
            PG8_LDB(B1, 0, 1); PG8_STAGE(PG8_SB(0, 0), b2, voffB);
            PG8_BAR; PG8_WAIT_L(0); PG8_MMA(0, 1, At, B1); PG8_BAR;
            PG8_LDA(At, 0, 1); PG8_STAGE(PG8_SA(0, 0), a2, voffA);
            PG8_BAR; PG8_WAIT_L(0); PG8_MMA(1, 0, At, B0); PG8_BAR; PG8_SCHED;
            PG8_STAGE(PG8_SB(0, 1), b2 + hstep, voffB);
            PG8_WAIT_V(6); PG8_BAR; PG8_MMA(1, 1, At, B1); PG8_BAR;
            PG8_LDB(B0, 1, 0); PG8_SCHED; PG8_LDA(At, 1, 0); PG8_STAGE(PG8_SA(0, 1), a2 + hstep, voffA);
            PG8_WAIT_L(8); PG8_BAR; PG8_WAIT_L(0); PG8_MMA(0, 0, At, B0); PG8_BAR; PG8_SCHED;
            PG8_LDB(B1, 1, 1); PG8_STAGE(PG8_SB(1, 0), b3, voffB);
            PG8_BAR; PG8_WAIT_L(0); PG8_MMA(0, 1, At, B1); PG8_BAR;
            PG8_LDA(At, 1, 1); PG8_STAGE(PG8_SA(1, 0), a3, voffA);
            PG8_BAR; PG8_WAIT_L(0); PG8_MMA(1, 0, At, B0); PG8_BAR; PG8_SCHED;
            PG8_STAGE(PG8_SB(1, 1), b3 + hstep, voffB);
            PG8_WAIT_V(6); PG8_BAR; PG8_MMA(1, 1, At, B1); PG8_BAR;
        }
        PG8_STAMP();
        if constexpr (!Epi::AFTER_DRAIN) { E(acc, cur, wr, wc, fr, fq); S.done(cur); }
        PG8_STAMP();
        if (!has_next) break;
#pragma unroll
        for (int a = 0; a < 2; ++a)
#pragma unroll
            for (int b = 0; b < 2; ++b)
#pragma unroll
                for (int m = 0; m < 4; ++m)
#pragma unroll
                    for (int n = 0; n < 2; ++n) acc[a][b][m][n] = (f32x4){0.f, 0.f, 0.f, 0.f};
        cur = nxt; cA = nA; cB = nB; ++ui;
    }
    PG8_WAIT_V(0);
    if (wr == 0) PG8_BAR;
    PG8_BAR;
    if constexpr (Epi::AFTER_DRAIN) { E.fused(acc, cur, wr, wc, fr, fq, lds, wid, lane); S.done(cur); }
    PG8_STAMP();
    if (STAMP && wid == 0) { stamps[lane] = lane < nts ? (((unsigned long long)(unsigned)ts_hi << 32) | (unsigned)ts_lo) : 0ull;
        if (lane == 62) stamps[62] = rt_entry; if (lane == 63) stamps[63] = (unsigned long long)wall_clock64(); }
#undef PG8_STAMP
#undef PG8_SA
#undef PG8_SB
#undef PG8_STAGE
#undef PG8_LDA
#undef PG8_LDB
#undef PG8_MMA
#undef PG8_WAIT_V
#undef PG8_WAIT_L
#undef PG8_BAR
#undef PG8_SCHED
}
}

typedef unsigned short bf16_t;
typedef short bf16x8 __attribute__((ext_vector_type(8)));
typedef float f32x4 __attribute__((ext_vector_type(4)));
typedef float f32x2 __attribute__((ext_vector_type(2)));
typedef unsigned u32x4 __attribute__((ext_vector_type(4)));
typedef unsigned u32x2 __attribute__((ext_vector_type(2)));

constexpr int D = 1024, NB = 4, T = 4096, NL = 4, BT = NB * T, BW = 512;
constexpr int DIN = 8320, DINP = 8448;
constexpr int C_PU = 0, C_PG = 512, C_Q = 1024, C_K = 1536, C_V = 2048, C_RG = 2560, C_RW = 3072, C_RWG = 4736, C_GATE = 5248;
constexpr int RW_R = 0, RW_WL = 512, RW_K = 576, RW_V = 1088, RW_AL = 1600, RW_W = 1664;
constexpr int SREC = 896;
constexpr int LDS_MAIN = 147456, LDS_BYTES = LDS_MAIN + 64;

constexpr size_t SZ_WIN = (size_t)DINP * D * 2, SZ_WBR = (size_t)3 * D * BW * 2, SZ_WOUT = (size_t)D * D * 2, SZ_LORA = (size_t)BW * 64 * 2;
constexpr size_t OFF_WIN = 0, OFF_WBR = OFF_WIN + SZ_WIN, OFF_WOUT = OFF_WBR + SZ_WBR, OFF_W2T = OFF_WOUT + SZ_WOUT, OFF_A2T = OFF_W2T + SZ_LORA;
constexpr size_t IMG_STRIDE = OFF_A2T + SZ_LORA;
constexpr size_t OFF_MOD = 2 * IMG_STRIDE, SZ_MOD = (size_t)NL * NB * 3 * D * 4;
constexpr size_t OFF_COS = OFF_MOD + SZ_MOD, SZ_TAB = (size_t)BT * 64 * 4, OFF_SIN = OFF_COS + SZ_TAB;
constexpr size_t OFF_BONUS = OFF_SIN + SZ_TAB, SZ_BONUS = (size_t)BT * 8 * 4;
constexpr size_t OFF_PROJ = OFF_BONUS + SZ_BONUS, SZ_PROJ = (size_t)BT * DINP * 2;
constexpr size_t OFF_BR = OFF_PROJ + SZ_PROJ, SZ_BR = (size_t)3 * BT * BW * 2;
constexpr size_t OFF_X = OFF_BR + SZ_BR;
constexpr size_t OFF_H = OFF_X;
constexpr size_t OFF_STREAM = OFF_X, SZ_STREAM = (size_t)BT * 8 * SREC;
constexpr size_t OFF_KVT = OFF_BR + SZ_BR / 3, SZ_KVT = (size_t)16 * 32 * 128 * 128 * 4;
constexpr size_t OFF_RPREV = OFF_STREAM + SZ_STREAM, SZ_RPREV = SZ_KVT / 2;
constexpr size_t OFF_MERGED = OFF_X, SZ_MERGED = (size_t)BT * D * 4;
constexpr size_t OFF_MERGEDB = OFF_MERGED + SZ_MERGED;
constexpr size_t OFF_H0F = OFF_RPREV + SZ_RPREV, SZ_H0F = (size_t)NB * D * 4;
constexpr int P0W = 2304;
constexpr size_t OFF_P0F = OFF_H0F + SZ_H0F, SZ_P0F = (size_t)NB * P0W * 4;
constexpr size_t OFF_CACC = OFF_P0F + SZ_P0F, SZ_CACC = 256;
constexpr size_t OFF_SACC = OFF_CACC + 128;
constexpr size_t OFF_BAR = OFF_CACC + SZ_CACC, SZ_BAR = (size_t)XCD_BAR_WORDS * 4;
constexpr size_t WS_NEED = OFF_BAR + SZ_BAR;

struct Params {
    const float* x; const float* c; const int* pos;
    const float *norm_g, *w_ada, *b_ada, *w_in, *pool_w, *pool_scale, *ret_norm_g, *shift_mu, *w0, *w2, *a0, *a2, *k_k, *k_a, *r_k, *ln_w, *ln_b, *w_branch, *w_out, *final_g;
    float* out; unsigned char* ws; size_t img_off;
};

__device__ __forceinline__ float bf2f(unsigned v) { return __uint_as_float(v << 16); }
__device__ __forceinline__ float bflo(unsigned v) { return __uint_as_float(v << 16); }
__device__ __forceinline__ float bfhi(unsigned v) { return __uint_as_float(v & 0xffff0000u); }
__device__ __forceinline__ unsigned pk2(float lo, float hi) { return pg8::cvt_pk_bf16(lo, hi); }
__device__ __forceinline__ bf16_t f2bf(float f) { return (bf16_t)(pk2(f, 0.f) & 0xffffu); }
__device__ __forceinline__ float sigmoidf_(float x) { return __builtin_amdgcn_rcpf(1.0f + __expf(-x)); }
__device__ __forceinline__ float siluf_(float x) { return x / (1.0f + __expf(-x)); }

__device__ __forceinline__ void unpack8(const u32x4 a, float (&o)[8]) { o[0] = bflo(a.x); o[1] = bfhi(a.x); o[2] = bflo(a.y); o[3] = bfhi(a.y); o[4] = bflo(a.z); o[5] = bfhi(a.z); o[6] = bflo(a.w); o[7] = bfhi(a.w); }
__device__ __forceinline__ u32x4 pack8(const float (&o)[8]) { u32x4 w; w.x = pk2(o[0], o[1]); w.y = pk2(o[2], o[3]); w.z = pk2(o[4], o[5]); w.w = pk2(o[6], o[7]); return w; }
__device__ __forceinline__ void ldf8(const float* p, float (&o)[8]) { const f32x4 a = *(const f32x4*)p, b = *(const f32x4*)(p + 4); o[0] = a[0]; o[1] = a[1]; o[2] = a[2]; o[3] = a[3]; o[4] = b[0]; o[5] = b[1]; o[6] = b[2]; o[7] = b[3]; }
template <int CTRL> __device__ __forceinline__ float dpp_mov(float v) { return __int_as_float(__builtin_amdgcn_update_dpp(0, __float_as_int(v), CTRL, 0xF, 0xF, false)); }
__device__ __forceinline__ float red16(float v) {
    v += dpp_mov<0xB1>(v);
    v += dpp_mov<0x4E>(v);
    v += dpp_mov<0x141>(v);
    v += dpp_mov<0x140>(v);
    return v;
}
__device__ __forceinline__ float red64(float v) {
    v = red16(v);
    v += __shfl_xor(v, 16); v += __shfl_xor(v, 32);
    return v;
}

constexpr int LDS_LD = 136;
__device__ __forceinline__ void strip_mma(const LAS bf16_t* A, int row0, const LAS bf16_t* Bm, f32x4 (&acc)[8], int fr, int fq) {
#pragma unroll
    for (int kk = 0; kk < 4; ++kk) {
        const bf16x8 a = *(const LAS bf16x8*)(A + (row0 + fr) * LDS_LD + kk * 32 + fq * 8);
#pragma unroll
        for (int n = 0; n < 8; ++n) {
            const bf16x8 b = *(const LAS bf16x8*)(Bm + (n * 16 + fr) * LDS_LD + kk * 32 + fq * 8);
            acc[n] = __builtin_amdgcn_mfma_f32_16x16x32_bf16(a, b, acc[n], 0, 0, 0);
        }
    }
}

struct EpiProj {
    static constexpr bool PERM = true, AFTER_DRAIN = false;
    bf16_t* O;
    __device__ __forceinline__ void operator()(const f32x4 (&acc)[2][2][4][2], const pg8::Unit& u, int wr, int wc, int fr, int fq) const {
        const int row0 = u.pm * 256 + wr * 64 + fr, col0 = u.pn * 256 + wc * 32 + 8 * fq;
#pragma unroll
        for (int ai = 0; ai < 2; ++ai)
#pragma unroll
            for (int m = 0; m < 4; ++m) { bf16_t* rowp = O + (size_t)(row0 + ai * 128 + m * 16) * DINP + col0;
#pragma unroll
                for (int bj = 0; bj < 2; ++bj) { const f32x4 v0 = acc[ai][bj][m][0], v1 = acc[ai][bj][m][1];
                    u32x4 w; w.x = pk2(v0[0], v0[1]); w.y = pk2(v0[2], v0[3]); w.z = pk2(v1[0], v1[1]); w.w = pk2(v1[2], v1[3]);
                    *(u32x4*)(rowp + bj * 128) = w; } }
    }
};
template <int NBR> struct EpiMerge {
    static constexpr bool PERM = true, AFTER_DRAIN = false;
    const bf16_t* proj; float* merged; bf16_t* mergedb;
    __device__ __forceinline__ void operator()(const f32x4 (&acc)[2][2][4][2], const pg8::Unit& u, int wr, int wc, int fr, int fq) const {
        const int row0 = u.pm * 256 + wr * 64 + fr, col0 = u.pn * 256 + wc * 32 + 8 * fq;
#pragma unroll
        for (int ai = 0; ai < 2; ++ai)
#pragma unroll
            for (int m = 0; m < 4; ++m) {
                const size_t row = (size_t)(row0 + ai * 128 + m * 16);
#pragma unroll
                for (int bj = 0; bj < 2; ++bj) {
                    const int col = col0 + bj * 128;
                    const u32x4 lg = *(const u32x4*)(proj + row * DINP + C_GATE + NBR * D + col);
                    const f32x4 v0 = acc[ai][bj][m][0], v1 = acc[ai][bj][m][1];
                    f32x4 o0, o1;
                    o0[0] = sigmoidf_(bflo(lg.x)) * v0[0]; o0[1] = sigmoidf_(bfhi(lg.x)) * v0[1]; o0[2] = sigmoidf_(bflo(lg.y)) * v0[2]; o0[3] = sigmoidf_(bfhi(lg.y)) * v0[3];
                    o1[0] = sigmoidf_(bflo(lg.z)) * v1[0]; o1[1] = sigmoidf_(bfhi(lg.z)) * v1[1]; o1[2] = sigmoidf_(bflo(lg.w)) * v1[2]; o1[3] = sigmoidf_(bfhi(lg.w)) * v1[3];
                    float* mp = merged + row * D + col;
                    if (NBR > 0) { o0 += *(const f32x4*)mp; o1 += *(const f32x4*)(mp + 4); }
                    if (NBR < 2) { *(f32x4*)mp = o0; *(f32x4*)(mp + 4) = o1; }
                    else { u32x4 w; w.x = pk2(o0[0], o0[1]); w.y = pk2(o0[2], o0[3]); w.z = pk2(o1[0], o1[1]); w.w = pk2(o1[2], o1[3]); *(u32x4*)(mergedb + row * D + col) = w; }
                }
            }
    }
};

struct MergeOrder {
    pg8::StaticOrder base;
    __device__ __forceinline__ bool next(int i, pg8::Unit& u) const { const int r = i / 3, n = i - 3 * r; pg8::Unit t; if (!base.next(r, t)) return false; u.pm = n * 64 + t.pm; u.pn = n * 4 + t.pn; return true; }
    __device__ __forceinline__ void a_ready(const pg8::Unit&) const {}
    __device__ __forceinline__ void done(const pg8::Unit&) const {}
};
struct EpiMergeAll {
    static constexpr bool PERM = true, AFTER_DRAIN = false;
    const bf16_t* proj; float* merged; bf16_t* mergedb;
    __device__ __forceinline__ void operator()(const f32x4 (&acc)[2][2][4][2], const pg8::Unit& u, int wr, int wc, int fr, int fq) const {
        const int n = u.pm >> 6; pg8::Unit t; t.pm = u.pm & 63; t.pn = u.pn & 3;
        if (n == 0) { EpiMerge<0> e{proj, merged, mergedb}; e(acc, t, wr, wc, fr, fq); }
        else if (n == 1) { EpiMerge<1> e{proj, merged, mergedb}; e(acc, t, wr, wc, fr, fq); }
        else { EpiMerge<2> e{proj, merged, mergedb}; e(acc, t, wr, wc, fr, fq); }
    }
};
struct EpiOut {
    static constexpr bool PERM = false, AFTER_DRAIN = false;
    const float* xin; float* xout; const float* gate;
    __device__ __forceinline__ void operator()(const f32x4 (&acc)[2][2][4][2], const pg8::Unit& u, int wr, int wc, int fr, int fq) const {
        const int row0 = u.pm * 256 + wr * 64 + fr, col0 = u.pn * 256 + wc * 32 + 4 * fq;
        const float* gp = gate + (size_t)(u.pm >> 4) * 3 * D + col0;
        f32x4 gv[2][2];
#pragma unroll
        for (int bj = 0; bj < 2; ++bj)
#pragma unroll
            for (int n = 0; n < 2; ++n) gv[bj][n] = *(const f32x4*)(gp + bj * 128 + n * 16);
#pragma unroll
        for (int ai = 0; ai < 2; ++ai)
#pragma unroll
            for (int m = 0; m < 4; ++m) {
                const size_t ro = (size_t)(row0 + ai * 128 + m * 16) * D + col0;
#pragma unroll
                for (int bj = 0; bj < 2; ++bj)
#pragma unroll
                    for (int n = 0; n < 2; ++n) {
                        const f32x4 xi = *(const f32x4*)(xin + ro + bj * 128 + n * 16);
                        *(f32x4*)(xout + ro + bj * 128 + n * 16) = xi + gv[bj][n] * acc[ai][bj][m][n];
                    }
            }
    }
};

__device__ __forceinline__ void phase0(const Params& p, unsigned char* shm) {
    const int tid = tid_(), wid = tid >> 6, lane = tid & 63;
    const int gtid = blockIdx.x * 512 + tid, nth = gridDim.x * 512;
    { const int nz = (DINP - DIN) * D * 2 / 16;
      for (int st_ = 0; st_ < 2; ++st_) { u32x4* z = (u32x4*)(p.ws + st_ * IMG_STRIDE + OFF_WIN + (size_t)DIN * D * 2);
        for (int i = gtid; i < nz; i += nth) z[i] = (u32x4){0u, 0u, 0u, 0u}; } }
    { float* COS = (float*)(p.ws + OFF_COS); float* SIN = (float*)(p.ws + OFF_SIN);
      for (int idx = gtid; idx < BT * 64; idx += nth) {
          const int i = idx & 63, tok = idx >> 6;
          double f = 1.0; for (int j = 0; j < i; ++j) f *= 0.8659643233600653;
          const float freq = (float)f;
          const float ang = (float)p.pos[tok] * freq;
          const double ad = (double)ang;
          const double nq = rint(ad * 0.6366197723675814);
          double r = fma(-nq, 1.5707963267948966, ad); r = fma(-nq, 6.123233995736766e-17, r);
          const float rf = (float)r; const float sr = sinf(rf), cr = cosf(rf);
          const int q = ((int)nq) & 3;
          float s, c;
          if (q == 0) { s = sr; c = cr; } else if (q == 1) { s = cr; c = -sr; } else if (q == 2) { s = -sr; c = -cr; } else { s = -cr; c = sr; }
          COS[idx] = c; SIN[idx] = s;
      } }
    float* cs = (float*)shm;
    float* red = cs + 4096;
    for (int i = tid; i < 4096; i += 512) { const int b = i >> 10, k = i & 1023; cs[k * 4 + b] = siluf_(p.c[b * 1024 + k]); }
    __syncthreads();
    float* mod = (float*)(p.ws + OFF_MOD);
    for (int item = blockIdx.x; item < NL * 48; item += gridDim.x) {
        const int l = item / 48, cgp = item % 48, col = cgp * 64 + lane;
        const float* wp = p.w_ada + (size_t)l * D * 3 * D + col;
        const int k0 = wid * 128;
        float a0 = 0.f, a1 = 0.f, a2 = 0.f, a3 = 0.f;
#pragma unroll 32
        for (int k = k0; k < k0 + 128; ++k) { const float w = wp[(size_t)k * 3 * D]; const f32x4 c4 = *(const f32x4*)(cs + k * 4); a0 += w * c4[0]; a1 += w * c4[1]; a2 += w * c4[2]; a3 += w * c4[3]; }
        red[(wid * 4 + 0) * 64 + lane] = a0; red[(wid * 4 + 1) * 64 + lane] = a1; red[(wid * 4 + 2) * 64 + lane] = a2; red[(wid * 4 + 3) * 64 + lane] = a3;
        __syncthreads();
        if (tid < 256) { const int b = tid >> 6; float s = 0.f;
#pragma unroll
            for (int w = 0; w < 8; ++w) s += red[(w * 4 + b) * 64 + lane];
            mod[(size_t)(l * NB + b) * 3 * D + col] = s + p.b_ada[l * 3 * D + col]; }
        __syncthreads();
    }
}

__device__ __forceinline__ void tconv64(const float* src, int ld_src, bf16_t* dst, int ld_dst, int r0, int c0, float* tile) {
    const int tid = tid_();
    { const int r = tid >> 3, cc = (tid & 7) * 8; const float* sp = src + (size_t)(r0 + r) * ld_src + c0 + cc;
      const f32x4 v0 = *(const f32x4*)sp, v1 = *(const f32x4*)(sp + 4); float* tp = tile + r * 65 + cc;
      tp[0] = v0[0]; tp[1] = v0[1]; tp[2] = v0[2]; tp[3] = v0[3]; tp[4] = v1[0]; tp[5] = v1[1]; tp[6] = v1[2]; tp[7] = v1[3]; }
    __syncthreads();
    { const int c = tid >> 3, rc = (tid & 7) * 8; const float* tp = tile + rc * 65 + c;
      u32x4 w; w.x = pk2(tp[0], tp[65]); w.y = pk2(tp[130], tp[195]); w.z = pk2(tp[260], tp[325]); w.w = pk2(tp[390], tp[455]);
      *(u32x4*)(dst + (size_t)(c0 + c) * ld_dst + r0 + rc) = w; }
    __syncthreads();
}
__device__ __forceinline__ void poolfold64(const float* w_in_l, const float* pool_w_l, bf16_t* dst, int k0, int n0, float* lds) {
    const int tid = tid_(), g = n0 >> 7, nb = n0 & 127;
    float* Ain = lds;
    float* Pw = lds + 64 * 129;
    for (int i = tid; i < 64 * 32; i += 512) { const int r = i >> 5, c4 = (i & 31) * 4; const f32x4 v = *(const f32x4*)(w_in_l + (size_t)(k0 + r) * DIN + g * 128 + c4);
        float* tp = Ain + r * 129 + c4; tp[0] = v[0]; tp[1] = v[1]; tp[2] = v[2]; tp[3] = v[3]; }
    for (int i = tid; i < 128 * 16; i += 512) { const int c = i >> 4, n4 = (i & 15) * 4; const f32x4 v = *(const f32x4*)(pool_w_l + (size_t)(g * 128 + c) * 128 + nb + n4);
        float* tp = Pw + c * 65 + n4; tp[0] = v[0]; tp[1] = v[1]; tp[2] = v[2]; tp[3] = v[3]; }
    __syncthreads();
    { const int nn = tid >> 3, rc = (tid & 7) * 8; float acc[8];
#pragma unroll
      for (int i = 0; i < 8; ++i) acc[i] = 0.f;
      for (int c = 0; c < 128; ++c) { const float pw = Pw[c * 65 + nn];
#pragma unroll
          for (int i = 0; i < 8; ++i) acc[i] += Ain[(rc + i) * 129 + c] * pw; }
      u32x4 w; w.x = pk2(acc[0], acc[1]); w.y = pk2(acc[2], acc[3]); w.z = pk2(acc[4], acc[5]); w.w = pk2(acc[6], acc[7]);
      *(u32x4*)(dst + (size_t)(n0 + nn) * D + k0 + rc) = w; }
    __syncthreads();
}
__device__ __forceinline__ void phase_weights(const Params& p, int l, unsigned char* shm, int job0, int jstride) {
    float* tile = (float*)shm;
    unsigned char* img = p.ws + p.img_off;
    bf16_t* Wt_in = (bf16_t*)(img + OFF_WIN); bf16_t* Wt_br = (bf16_t*)(img + OFF_WBR); bf16_t* Wt_out = (bf16_t*)(img + OFF_WOUT);
    bf16_t* W2T = (bf16_t*)(img + OFF_W2T); bf16_t* A2T = (bf16_t*)(img + OFF_A2T);
    const float* w_in_l = p.w_in + (size_t)l * D * DIN;
    constexpr int J_IN = 16 * 130, J_BR = 3 * 8 * 16, J_OUT = 16 * 16, J_LORA = 16;
    constexpr int NJ = J_IN + J_BR + J_OUT + J_LORA;
    for (int job = job0; job < NJ; job += jstride) {
        int j = job;
        if (j < J_IN) { const int kt = j & 15, nt = j >> 4;
            if (nt < 8) poolfold64(w_in_l, p.pool_w + (size_t)l * 4 * 128 * 128, Wt_in, kt * 64, nt * 64, tile);
            else tconv64(w_in_l, DIN, Wt_in, D, kt * 64, nt * 64, tile);
            continue; }
        j -= J_IN;
        if (j < J_BR) { const int nb = j / 128, r = j % 128, wt = r & 7, dt = r >> 3;
            tconv64(p.w_branch + ((size_t)l * 3 + nb) * BW * D, D, Wt_br + (size_t)nb * D * BW, BW, wt * 64, dt * 64, tile); continue; }
        j -= J_BR;
        if (j < J_OUT) { const int kt = j & 15, dt = j >> 4; tconv64(p.w_out + (size_t)l * D * D, D, Wt_out, D, kt * 64, dt * 64, tile); continue; }
        j -= J_OUT;
        if (j < 8) tconv64(p.w2 + (size_t)l * 64 * BW, BW, W2T, 64, 0, j * 64, tile);
        else tconv64(p.a2 + (size_t)l * 64 * BW, BW, A2T, 64, 0, (j - 8) * 64, tile);
    }
}
__device__ __forceinline__ void phase_norm(const Params& p, int l, const float* xin) {
    const int tid = tid_(), wid = tid >> 6, lane = tid & 63;
    bf16_t* h = (bf16_t*)(p.ws + OFF_H);
    const float* mod = (const float*)(p.ws + OFF_MOD) + (size_t)l * NB * 3 * D;
    const float* g = p.norm_g + l * D;
    { float* z = (float*)(p.ws + OFF_P0F); const int g_ = blockIdx.x * 512 + tid; if (g_ < NB * P0W) z[g_] = 0.f; }
    for (int row = blockIdx.x * 8 + wid; row < BT; row += gridDim.x * 8) {
        const int b = row >> 12;
        const float* xp = xin + (size_t)row * D;
        f32x4 v[4]; float ss = 0.f;
#pragma unroll
        for (int j = 0; j < 2; ++j) { v[2 * j] = *(const f32x4*)(xp + j * 512 + lane * 8); v[2 * j + 1] = *(const f32x4*)(xp + j * 512 + lane * 8 + 4); }
#pragma unroll
        for (int j = 0; j < 4; ++j) ss += v[j][0] * v[j][0] + v[j][1] * v[j][1] + v[j][2] * v[j][2] + v[j][3] * v[j][3];
        ss = red64(ss);
        const float rstd = rsqrtf(ss * (1.0f / D) + 1e-6f);
        const float* sh = mod + (size_t)b * 3 * D; const float* sc = sh + D;
#pragma unroll
        for (int j = 0; j < 2; ++j) {
            const int c0 = j * 512 + lane * 8; float o[8];
#pragma unroll
            for (int i = 0; i < 8; ++i) { const float xv = v[2 * j + (i >> 2)][i & 3]; o[i] = xv * rstd * g[c0 + i] * (1.0f + sc[c0 + i]) + sh[c0 + i]; }
            u32x4 w; w.x = pk2(o[0], o[1]); w.y = pk2(o[2], o[3]); w.z = pk2(o[4], o[5]); w.w = pk2(o[6], o[7]);
            *(u32x4*)(h + (size_t)row * D + c0) = w;
            if ((row & (T - 1)) == 0) { float* hf = (float*)(p.ws + OFF_H0F) + (size_t)b * D + c0;
                *(f32x4*)hf = (f32x4){o[0], o[1], o[2], o[3]}; *(f32x4*)(hf + 4) = (f32x4){o[4], o[5], o[6], o[7]}; }
        }
    }
}
__device__ __forceinline__ void gemv0_item(const Params& p, int l, int item, unsigned char* shm) {
    const int tid = tid_(), wid = tid >> 6, lane = tid & 63, cg_ = item >> 3, kc = item & 7;
    float* red = (float*)shm;
    const float* h0 = (const float*)(p.ws + OFF_H0F);
    const int src = cg_ < 8 ? C_RW + RW_R + 64 * cg_ : cg_ < 16 ? C_RW + RW_K + 64 * (cg_ - 8) : cg_ == 16 ? C_RW + RW_AL : cg_ < 25 ? C_Q + 64 * (cg_ - 17) : C_K + 64 * (cg_ - 25);
    const int dst = cg_ < 8 ? 64 * cg_ : cg_ < 16 ? 512 + 64 * (cg_ - 8) : cg_ == 16 ? 1024 : 1152 + 64 * (cg_ - 17);
    const int k0 = kc * 128 + wid * 16;
    const float* wp = p.w_in + (size_t)l * D * DIN + (size_t)k0 * DIN + src + lane;
    float w[16];
#pragma unroll
    for (int i = 0; i < 16; ++i) w[i] = wp[(size_t)i * DIN];
    float a0 = 0.f, a1 = 0.f, a2 = 0.f, a3 = 0.f;
#pragma unroll
    for (int i = 0; i < 16; ++i) { a0 += w[i] * h0[k0 + i]; a1 += w[i] * h0[D + k0 + i]; a2 += w[i] * h0[2 * D + k0 + i]; a3 += w[i] * h0[3 * D + k0 + i]; }
    red[(wid * 4 + 0) * 64 + lane] = a0; red[(wid * 4 + 1) * 64 + lane] = a1; red[(wid * 4 + 2) * 64 + lane] = a2; red[(wid * 4 + 3) * 64 + lane] = a3;
    __syncthreads();
    if (tid < 256) { const int b = tid >> 6; float sm = 0.f;
#pragma unroll
        for (int w_ = 0; w_ < 8; ++w_) sm += red[(w_ * 4 + b) * 64 + lane];
        atomicAdd((float*)(p.ws + OFF_P0F) + (size_t)b * P0W + dst + lane, sm); }
    __syncthreads();
}

__device__ __forceinline__ void phase_final_norm(const Params& p) {
    const int tid = tid_(), wid = tid >> 6, lane = tid & 63;
    for (int row = blockIdx.x * 8 + wid; row < BT; row += gridDim.x * 8) {
        float* xp = p.out + (size_t)row * D;
        f32x4 v[4]; float ss = 0.f;
#pragma unroll
        for (int j = 0; j < 4; ++j) v[j] = *(const f32x4*)(xp + j * 256 + lane * 4);
#pragma unroll
        for (int j = 0; j < 4; ++j) ss += v[j][0] * v[j][0] + v[j][1] * v[j][1] + v[j][2] * v[j][2] + v[j][3] * v[j][3];
        ss = red64(ss);
        const float rstd = rsqrtf(ss * (1.0f / D) + 1e-6f);
#pragma unroll
        for (int j = 0; j < 4; ++j) { const f32x4 gg = *(const f32x4*)(p.final_g + j * 256 + lane * 4); *(f32x4*)(xp + j * 256 + lane * 4) = v[j] * rstd * gg; }
    }
}

__device__ __forceinline__ void pool_item(const Params& p, int l, int item) {
    const int tid = tid_(), cv = tid & 63, tl = tid >> 6, c0 = cv * 8, g = c0 >> 7, win = 2 << g;
    const bf16_t* proj = (const bf16_t*)(p.ws + OFF_PROJ);
    bf16_t* br0 = (bf16_t*)(p.ws + OFF_BR);
    float sc[8]; ldf8(p.pool_scale + l * BW + c0, sc);
    const int tokA = item * 64 + tl * 8, tposA = tokA & (T - 1);
    u32x4 rows[23];
#pragma unroll
    for (int i = 0; i < 23; ++i) {
        const int d = i - 15;
        const bool ok = (tposA + d >= 0) && (d > -win);
        rows[i] = ok ? *(const u32x4*)(proj + (size_t)(tokA + d) * DINP + C_PU + c0) : (u32x4){0u, 0u, 0u, 0u};
    }
    u32x4 gts[8];
#pragma unroll
    for (int tt = 0; tt < 8; ++tt) gts[tt] = *(const u32x4*)(proj + (size_t)(tokA + tt) * DINP + C_PG + c0);
#pragma unroll
    for (int tt = 0; tt < 8; ++tt) {
        const int tpos = tposA + tt, cnt = min(tpos + 1, win);
        float s[8];
#pragma unroll
        for (int i = 0; i < 8; ++i) s[i] = 0.f;
#pragma unroll
        for (int j = 0; j < 16; ++j) {
            if (j < win) { float u[8]; unpack8(rows[15 + tt - j], u);
#pragma unroll
                for (int i = 0; i < 8; ++i) s[i] += u[i]; }
        }
        const float inv = 1.0f / (float)cnt;
        float uu[8], gg[8], o[8]; unpack8(rows[15 + tt], uu); unpack8(gts[tt], gg);
#pragma unroll
        for (int i = 0; i < 8; ++i) o[i] = (s[i] * inv - uu[i]) * sc[i] * siluf_(gg[i]);
        *(u32x4*)(br0 + (size_t)(tokA + tt) * BW + c0) = pack8(o);
    }
}

__device__ __forceinline__ float ret_lg(int h) { return h == 0 ? -0.04580368961312479f : h == 1 ? -0.02272007650008353f : h == 2 ? -0.011315313227834146f : -0.005646563141142063f; }

struct RotCS { f32x4 c0, c1, s0, s1; };
__device__ __forceinline__ void fetch_cs(const Params& p, RotCS (&cs)[2], int tid, int tok0) {
    const float* COS = (const float*)(p.ws + OFF_COS); const float* SIN = (const float*)(p.ws + OFF_SIN);
#pragma unroll
    for (int it = 0; it < 2; ++it) { const int u = tid + it * 512, j = u >> 3, d0 = (u & 7) * 8;
        const float* cp = COS + (size_t)(tok0 + j) * 64 + d0; const float* sn = SIN + (size_t)(tok0 + j) * 64 + d0;
        cs[it].c0 = *(const f32x4*)cp; cs[it].c1 = *(const f32x4*)(cp + 4); cs[it].s0 = *(const f32x4*)sn; cs[it].s1 = *(const f32x4*)(sn + 4); }
}
__device__ __forceinline__ void fetch_qk(const Params& p, u32x4 (&ra)[2], u32x4 (&rb)[2], int tid, int tok0, int col) {
    const bf16_t* proj = (const bf16_t*)(p.ws + OFF_PROJ);
#pragma unroll
    for (int it = 0; it < 2; ++it) { const int u = tid + it * 512, j = u >> 3, d0 = (u & 7) * 8;
        const bf16_t* sp = proj + (size_t)(tok0 + j) * DINP + col + d0; ra[it] = *(const u32x4*)sp; rb[it] = *(const u32x4*)(sp + 64); }
}
template <bool TRANS> __device__ __forceinline__ void store_rot(LAS bf16_t* dst, const u32x4 (&ra)[2], const u32x4 (&rb)[2], const RotCS (&cs)[2], int tid, float scale, float lgt) {
#pragma unroll
    for (int it = 0; it < 2; ++it) {
        const int u = tid + it * 512, j = u >> 3, d0 = (u & 7) * 8;
        float x1[8], x2[8]; unpack8(ra[it], x1); unpack8(rb[it], x2);
        const float cc[8] = {cs[it].c0[0], cs[it].c0[1], cs[it].c0[2], cs[it].c0[3], cs[it].c1[0], cs[it].c1[1], cs[it].c1[2], cs[it].c1[3]};
        const float ss[8] = {cs[it].s0[0], cs[it].s0[1], cs[it].s0[2], cs[it].s0[3], cs[it].s1[0], cs[it].s1[1], cs[it].s1[2], cs[it].s1[3]};
        const float sc = (lgt != 0.f) ? scale * exp2f(lgt * (float)(127 - j)) : scale;
        float o1[8], o2[8];
#pragma unroll
        for (int i = 0; i < 8; ++i) { o1[i] = (x1[i] * cc[i] - x2[i] * ss[i]) * sc; o2[i] = (x1[i] * ss[i] + x2[i] * cc[i]) * sc; }
        if (TRANS) {
#pragma unroll
            for (int i = 0; i < 8; ++i) { dst[(d0 + i) * LDS_LD + j] = f2bf(o1[i]); dst[(d0 + 64 + i) * LDS_LD + j] = f2bf(o2[i]); }
        } else {
            *(LAS u32x4*)(dst + j * LDS_LD + d0) = pack8(o1); *(LAS u32x4*)(dst + j * LDS_LD + d0 + 64) = pack8(o2);
        }
    }
}
__device__ __forceinline__ void fetch_v(const Params& p, u32x4 (&rv)[4], int tid, int tok0, int col) {
    const bf16_t* proj = (const bf16_t*)(p.ws + OFF_PROJ);
#pragma unroll
    for (int it = 0; it < 4; ++it) { const int u = tid + it * 512, j = u >> 4, e0 = (u & 15) * 8; rv[it] = *(const u32x4*)(proj + (size_t)(tok0 + j) * DINP + col + e0); }
}
__device__ __forceinline__ void store_vT(LAS bf16_t* dst, const u32x4 (&rv)[4], int tid) {
#pragma unroll
    for (int it = 0; it < 4; ++it) {
        const int u = tid + it * 512, j = u >> 4, e0 = (u & 15) * 8; const u32x4 a = rv[it];
        dst[(e0 + 0) * LDS_LD + j] = (bf16_t)(a.x & 0xffffu); dst[(e0 + 1) * LDS_LD + j] = (bf16_t)(a.x >> 16);
        dst[(e0 + 2) * LDS_LD + j] = (bf16_t)(a.y & 0xffffu); dst[(e0 + 3) * LDS_LD + j] = (bf16_t)(a.y >> 16);
        dst[(e0 + 4) * LDS_LD + j] = (bf16_t)(a.z & 0xffffu); dst[(e0 + 5) * LDS_LD + j] = (bf16_t)(a.z >> 16);
        dst[(e0 + 6) * LDS_LD + j] = (bf16_t)(a.w & 0xffffu); dst[(e0 + 7) * LDS_LD + j] = (bf16_t)(a.w >> 16);
    }
}

__device__ __forceinline__ void ret_r1_item(const Params& p, int item, LAS bf16_t* lds) {
    const int tid = tid_(), wid = tid >> 6, lane = tid & 63, fr = lane & 15, fq = lane >> 4;
    const int n = item & 31, bh = item >> 5, h = bh & 3, b = bh >> 2, tok0 = b * T + n * 128;
    LAS bf16_t* KT = lds; LAS bf16_t* VT = lds + 128 * LDS_LD;
    { RotCS cs[2]; u32x4 ka[2], kb[2], rv[4];
      fetch_qk(p, ka, kb, tid, tok0, C_K + h * 128); fetch_cs(p, cs, tid, tok0); fetch_v(p, rv, tid, tok0, C_V + h * 128);
      store_rot<true>(KT, ka, kb, cs, tid, 0.08838834764831845f, ret_lg(h));
      store_vT(VT, rv, tid); }
    __syncthreads();
    f32x4 acc[8];
#pragma unroll
    for (int i = 0; i < 8; ++i) acc[i] = (f32x4){0.f, 0.f, 0.f, 0.f};
    strip_mma(VT, wid * 16, KT, acc, fr, fq);
    float* kvT = (float*)(p.ws + OFF_KVT) + ((size_t)item << 14);
#pragma unroll
    for (int nn = 0; nn < 8; ++nn)
#pragma unroll
        for (int jj = 0; jj < 4; ++jj) kvT[(wid * 16 + fq * 4 + jj) * 128 + nn * 16 + fr] = acc[nn][jj];
    __syncthreads();
}

constexpr int PREP_LD = 516;
__device__ __forceinline__ float red8(float v) {
    v += dpp_mov<0xB1>(v); v += dpp_mov<0x4E>(v); v += dpp_mov<0x141>(v);
    return v;
}
__device__ __forceinline__ void rwkv_prep_item(const Params& p, int l, int item, LAS bf16_t* lds) {
    const int tid = tid_(), wid = tid >> 6, lane = tid & 63, fr = lane & 15, fq = lane >> 4;
    const bf16_t* proj = (const bf16_t*)(p.ws + OFF_PROJ);
    const int tok0 = item * 32;
    LAS bf16_t* Aw = lds;
    LAS bf16_t* Aa = lds + 32 * 72;
    LAS float* LW = (LAS float*)(lds + 2 * 32 * 72);
    LAS float* LA = LW + 32 * PREP_LD;
    const float* mu = p.shift_mu + l * RW_W;
#pragma unroll
    for (int hh = 0; hh < 2; ++hh) {
        const int tt = (tid >> 5) + hh * 16, cc = (tid & 31) * 4, tok = tok0 + tt;
        const int ch = cc < 64 ? RW_WL + cc : RW_AL + (cc - 64);
        const u32x2 cu = *(const u32x2*)(proj + (size_t)tok * DINP + C_RW + ch);
        u32x2 pu = (u32x2){0u, 0u};
        if ((tok & (T - 1)) != 0) pu = *(const u32x2*)(proj + (size_t)(tok - 1) * DINP + C_RW + ch);
        const float xc[4] = {bflo(cu.x), bfhi(cu.x), bflo(cu.y), bfhi(cu.y)}, xp[4] = {bflo(pu.x), bfhi(pu.x), bflo(pu.y), bfhi(pu.y)};
        float o[4];
#pragma unroll
        for (int i = 0; i < 4; ++i) { o[i] = xc[i] + (xp[i] - xc[i]) * mu[ch + i]; if (cc < 64) o[i] = tanhf(o[i]); }
        LAS bf16_t* dp = (cc < 64 ? Aw + tt * 72 + cc : Aa + tt * 72 + (cc - 64));
        u32x2 w; w.x = pk2(o[0], o[1]); w.y = pk2(o[2], o[3]); *(LAS u32x2*)dp = w;
    }
    __syncthreads();
    {
        const bf16_t* W2T = (const bf16_t*)(p.ws + p.img_off + OFF_W2T); const bf16_t* A2T = (const bf16_t*)(p.ws + p.img_off + OFF_A2T);
        f32x4 lw[2][4], la[2][4];
#pragma unroll
        for (int mt = 0; mt < 2; ++mt)
#pragma unroll
            for (int n = 0; n < 4; ++n) { lw[mt][n] = (f32x4){0.f, 0.f, 0.f, 0.f}; la[mt][n] = (f32x4){0.f, 0.f, 0.f, 0.f}; }
#pragma unroll
        for (int kk = 0; kk < 2; ++kk) {
            bf16x8 aw[2], aa[2];
#pragma unroll
            for (int mt = 0; mt < 2; ++mt) { aw[mt] = *(const LAS bf16x8*)(Aw + (mt * 16 + fr) * 72 + kk * 32 + fq * 8); aa[mt] = *(const LAS bf16x8*)(Aa + (mt * 16 + fr) * 72 + kk * 32 + fq * 8); }
#pragma unroll
            for (int n = 0; n < 4; ++n) {
                const int chn = wid * 64 + n * 16 + fr;
                const bf16x8 bw = *(const bf16x8*)(W2T + (size_t)chn * 64 + kk * 32 + fq * 8);
                const bf16x8 ba = *(const bf16x8*)(A2T + (size_t)chn * 64 + kk * 32 + fq * 8);
#pragma unroll
                for (int mt = 0; mt < 2; ++mt) {
                    lw[mt][n] = __builtin_amdgcn_mfma_f32_16x16x32_bf16(aw[mt], bw, lw[mt][n], 0, 0, 0);
                    la[mt][n] = __builtin_amdgcn_mfma_f32_16x16x32_bf16(aa[mt], ba, la[mt][n], 0, 0, 0);
                }
            }
        }
#pragma unroll
        for (int mt = 0; mt < 2; ++mt)
#pragma unroll
            for (int n = 0; n < 4; ++n)
#pragma unroll
                for (int jj = 0; jj < 4; ++jj) { const int o = (mt * 16 + fq * 4 + jj) * PREP_LD + wid * 64 + n * 16 + fr; LW[o] = lw[mt][n][jj]; LA[o] = la[mt][n][jj]; }
    }
    __syncthreads();
    {
        const int cv = tid & 63, c0 = cv * 8, head = cv >> 3, cc = c0 & 63;
        float muR[8], muK[8], muV[8], w0v[8], a0v[8], kkw[8], kaw[8], rkw[8];
        ldf8(mu + RW_R + c0, muR); ldf8(mu + RW_K + c0, muK); ldf8(mu + RW_V + c0, muV);
        ldf8(p.w0 + l * BW + c0, w0v); ldf8(p.a0 + l * BW + c0, a0v); ldf8(p.k_k + l * BW + c0, kkw); ldf8(p.k_a + l * BW + c0, kaw); ldf8(p.r_k + l * BW + c0, rkw);
        unsigned char* stream = p.ws + OFF_STREAM; float* bonus = (float*)(p.ws + OFF_BONUS);
#pragma unroll
        for (int it = 0; it < 4; ++it) {
            const int tt = (tid >> 6) + it * 8, tok = tok0 + tt, tpos = tok & (T - 1), b = tok >> 12;
            const bf16_t* pc = proj + (size_t)tok * DINP + C_RW + c0;
            float rc[8], kc[8], vc[8], rp[8], kp[8], vp[8];
            unpack8(*(const u32x4*)(pc + RW_R), rc); unpack8(*(const u32x4*)(pc + RW_K), kc); unpack8(*(const u32x4*)(pc + RW_V), vc);
            if (tpos != 0) { unpack8(*(const u32x4*)(pc - DINP + RW_R), rp); unpack8(*(const u32x4*)(pc - DINP + RW_K), kp); unpack8(*(const u32x4*)(pc - DINP + RW_V), vp); }
            else {
#pragma unroll
                for (int i = 0; i < 8; ++i) { rp[i] = 0.f; kp[i] = 0.f; vp[i] = 0.f; } }
            float lwv[8], lav[8];
            { const f32x4 x0 = *(const LAS f32x4*)(LW + tt * PREP_LD + c0), x1 = *(const LAS f32x4*)(LW + tt * PREP_LD + c0 + 4), y0 = *(const LAS f32x4*)(LA + tt * PREP_LD + c0), y1 = *(const LAS f32x4*)(LA + tt * PREP_LD + c0 + 4);
#pragma unroll
              for (int i = 0; i < 4; ++i) { lwv[i] = x0[i]; lwv[4 + i] = x1[i]; lav[i] = y0[i]; lav[4 + i] = y1[i]; } }
            float rr[8], k2[8], vv[8], dec[8], av[8], kkv[8]; float ssq = 0.f, bsum = 0.f;
#pragma unroll
            for (int i = 0; i < 8; ++i) {
                const float r = rc[i] + (rp[i] - rc[i]) * muR[i], k = kc[i] + (kp[i] - kc[i]) * muK[i], v = vc[i] + (vp[i] - vc[i]) * muV[i];
                dec[i] = __expf(-0.6065306597126334f * sigmoidf_(w0v[i] + lwv[i]));
                const float a = sigmoidf_(a0v[i] + lav[i]);
                const float kq = k * kkw[i];
                ssq += kq * kq; kkv[i] = kq;
                const float kk2 = k * (1.0f + (a - 1.0f) * kaw[i]);
                bsum += r * kk2 * rkw[i];
                rr[i] = r; k2[i] = kk2; vv[i] = v; av[i] = a;
            }
            ssq = red8(ssq); bsum = red8(bsum);
            const float inv = 1.0f / fmaxf(sqrtf(ssq), 1e-12f);
            float na[8], nb[8];
#pragma unroll
            for (int i = 0; i < 8; ++i) { const float kn = kkv[i] * inv; na[i] = -kn; nb[i] = kn * av[i]; }
            unsigned char* rec = stream + ((size_t)(b * 8 + head) * T + tpos) * SREC;
            *(f32x4*)(rec + 4 * cc) = (f32x4){dec[0], dec[1], dec[2], dec[3]}; *(f32x4*)(rec + 4 * cc + 16) = (f32x4){dec[4], dec[5], dec[6], dec[7]};
            *(u32x4*)(rec + 256 + 2 * cc) = pack8(rr);
            *(u32x4*)(rec + 384 + 2 * cc) = pack8(k2);
            *(u32x4*)(rec + 512 + 2 * cc) = pack8(na);
            *(u32x4*)(rec + 640 + 2 * cc) = pack8(nb);
            *(u32x4*)(rec + 768 + 2 * cc) = pack8(vv);
            if ((cv & 7) == 0) bonus[(size_t)tok * 8 + head] = bsum;
        }
    }
    __syncthreads();
}

__device__ __forceinline__ void ret_r2(const Params& p) {
    const float* kvT = (const float*)(p.ws + OFF_KVT); bf16_t* rp = (bf16_t*)(p.ws + OFF_RPREV);
    const int gtid = blockIdx.x * 512 + tid_(), nth = gridDim.x * 512;
    for (int i2 = gtid; i2 < 16 * 8192; i2 += nth) {
        const int bh = i2 >> 13, ed = (i2 & 8191) * 2, h = bh & 3;
        const float cd = exp2f(128.0f * ret_lg(h));
        const size_t o0 = ((size_t)(bh * 32) << 14) + ed;
        f32x2 kv[31];
#pragma unroll
        for (int n = 0; n < 31; ++n) kv[n] = __builtin_nontemporal_load((const f32x2*)(kvT + o0 + ((size_t)n << 14)));
        float r0 = 0.f, r1 = 0.f;
#pragma unroll
        for (int n = 0; n < 32; ++n) {
            *(unsigned*)(rp + o0 + ((size_t)n << 14)) = pk2(r0, r1);
            if (n < 31) { r0 = cd * r0 + kv[n][0]; r1 = cd * r1 + kv[n][1]; }
        }
    }
}

constexpr int SCH = 32;
constexpr int SREC_F = 384;
constexpr int SBUF_F = SCH * SREC_F;
__device__ __forceinline__ void rwkv_scan_item(const Params& p, int item, LAS float* lds, LAS unsigned* roletab) {
    const int tid = tid_(), wid = tid >> 6, lane = tid & 63;
    const int bh = (item & 7) + 8 * ((item >> 3) & 3), rg = item >> 5, b = bh >> 3, h = bh & 7;
    const unsigned char* sbase = p.ws + OFF_STREAM + (size_t)bh * T * SREC;
    constexpr int NCH = T / SCH;
    if (lane == 0) roletab[wid] = (unsigned)__builtin_amdgcn_s_getreg((1 << 11) | (4 << 6) | 4) & 3u;
    __syncthreads();
    int srole = -1, lrole = -1;
    {
        int sd[8];
#pragma unroll
        for (int i = 0; i < 8; ++i) sd[i] = (int)roletab[i];
        const int sA = 0; int sB = -1;
#pragma unroll
        for (int i = 1; i < 8; ++i) if (sB < 0 && sd[i] != sd[0]) sB = i;
        if (sB < 0) sB = 1;
        int nl = 0;
#pragma unroll
        for (int i = 0; i < 8; ++i) { const bool free_ = (i != sA) && (i != sB) && sd[i] != sd[sA] && sd[i] != sd[sB]; if (free_ && nl < 4) { if (i == wid) lrole = nl; ++nl; } }
#pragma unroll
        for (int i = 0; i < 8; ++i) { const bool other = (i != sA) && (i != sB) && !(sd[i] != sd[sA] && sd[i] != sd[sB]); if (other && nl < 4) { if (i == wid) lrole = nl; ++nl; } }
        if (wid == sA) srole = 0; else if (wid == sB) srole = 1;
    }
    const bool scanner = srole >= 0, loader = lrole >= 0;
    const int lt = lrole * 64 + lane;
    LAS float* ybuf = lds + 2 * SBUF_F;
    bf16_t* proj = (bf16_t*)(p.ws + OFF_PROJ);
    float* ybase = (float*)(proj + (size_t)(b * T) * DINP + C_RW) + h * 64 + rg * 8;
    u32x4 reg[7];
    auto ld = [&](int c) {
        const u32x4* src = (const u32x4*)(sbase + (size_t)c * SCH * SREC);
#pragma unroll
        for (int i = 0; i < 7; ++i) reg[i] = src[lt + i * 256];
    };
    auto st = [&](int buf) {
        LAS float* dst = lds + buf * SBUF_F;
#pragma unroll
        for (int i = 0; i < 7; ++i) { const int v = lt + i * 256;
            const int s = v / 56, wi = v % 56; const u32x4 r = reg[i];
            if (wi < 16) { *(LAS u32x4*)(dst + s * SREC_F + wi * 4) = r; }
            else { const int a = (wi - 16) >> 3, pos = ((wi - 16) & 7) * 8; LAS float* d = dst + s * SREC_F + 64 + a * 64 + pos;
                *(LAS f32x4*)d = (f32x4){bflo(r.x), bfhi(r.x), bflo(r.y), bfhi(r.y)}; *(LAS f32x4*)(d + 4) = (f32x4){bflo(r.z), bfhi(r.z), bflo(r.w), bfhi(r.w)}; }
        }
    };
    auto yred = [&](int c) {
        const LAS float* yp = ybuf + (c & 1) * (SCH * 128) + lt * 16;
        const f32x4 a0 = *(const LAS f32x4*)yp, a1 = *(const LAS f32x4*)(yp + 4), a2 = *(const LAS f32x4*)(yp + 8), a3 = *(const LAS f32x4*)(yp + 12);
        const f32x4 sm = (a0 + a1) + (a2 + a3);
        ybase[(size_t)(c * SCH + (lt >> 3)) * (DINP / 2) + (lt & 7)] = (sm[0] + sm[1]) + (sm[2] + sm[3]);
    };
    if (loader) { ld(0); st(0); ld(1); }
    if (scanner) __builtin_amdgcn_s_setprio(3);
    __syncthreads();
    const int rr = lane >> 4, q = lane & 15, rl = (srole & 1) * 4 + rr, row = rg * 8 + rl;
    f32x2 S0 = (f32x2){0.f, 0.f}, S1 = (f32x2){0.f, 0.f};
    for (int c = 0; c < NCH; ++c) {
        if (loader) {
            if (c + 1 < NCH) st((c + 1) & 1);
            if (c + 2 < NCH) ld(c + 2);
            if (c > 0) yred(c - 1);
        } else if (scanner) {
            const LAS float* cb = lds + (c & 1) * SBUF_F + q * 4;
            const LAS float* vb = lds + (c & 1) * SBUF_F + 320 + row;
            LAS float* yb = ybuf + (c & 1) * (SCH * 128) + rl * 16 + q;
            f32x4 w4 = *(const LAS f32x4*)(cb), r4 = *(const LAS f32x4*)(cb + 64), k4 = *(const LAS f32x4*)(cb + 128), a4 = *(const LAS f32x4*)(cb + 192), b4 = *(const LAS f32x4*)(cb + 256);
            float vv = vb[0];
            f32x4 w5 = *(const LAS f32x4*)(cb + SREC_F), r5 = *(const LAS f32x4*)(cb + SREC_F + 64), k5 = *(const LAS f32x4*)(cb + SREC_F + 128), a5 = *(const LAS f32x4*)(cb + SREC_F + 192), b5 = *(const LAS f32x4*)(cb + SREC_F + 256);
            float v5 = vb[SREC_F];
#pragma unroll
            for (int s = 0; s < SCH; ++s) {
                f32x4 nw = w5, nr = r5, nk = k5, na = a5, nb = b5; float nv = v5;
                if (s + 2 < SCH) {
                    const LAS float* nbp = cb + (s + 2) * SREC_F;
                    nw = *(const LAS f32x4*)(nbp); nr = *(const LAS f32x4*)(nbp + 64); nk = *(const LAS f32x4*)(nbp + 128); na = *(const LAS f32x4*)(nbp + 192); nb = *(const LAS f32x4*)(nbp + 256);
                    nv = vb[(s + 2) * SREC_F];
                }
                f32x2 t = S0 * (f32x2){a4[0], a4[1]};
                t = __builtin_elementwise_fma(S1, (f32x2){a4[2], a4[3]}, t);
                float pa = t[0] + t[1];
                pa = red16(pa);
                const f32x2 vk0 = (f32x2){vv, vv} * (f32x2){k4[0], k4[1]}, vk1 = (f32x2){vv, vv} * (f32x2){k4[2], k4[3]};
                const f32x2 t0 = __builtin_elementwise_fma(S0, (f32x2){w4[0], w4[1]}, vk0), t1 = __builtin_elementwise_fma(S1, (f32x2){w4[2], w4[3]}, vk1);
                S0 = __builtin_elementwise_fma((f32x2){pa, pa}, (f32x2){b4[0], b4[1]}, t0);
                S1 = __builtin_elementwise_fma((f32x2){pa, pa}, (f32x2){b4[2], b4[3]}, t1);
                f32x2 u = S0 * (f32x2){r4[0], r4[1]};
                u = __builtin_elementwise_fma(S1, (f32x2){r4[2], r4[3]}, u);
                yb[s * 128] = u[0] + u[1];
                w4 = w5; r4 = r5; k4 = k5; a4 = a5; b4 = b5; vv = v5;
                w5 = nw; r5 = nr; k5 = nk; a5 = na; b5 = nb; v5 = nv;
            }
        }
        __syncthreads();
    }
    if (loader) yred(NCH - 1);
    if (scanner) __builtin_amdgcn_s_setprio(0);
    __syncthreads();
}

__device__ __forceinline__ void ret_r3_item(const Params& p, int l, int item, LAS bf16_t* lds) {
    const int tid = tid_(), wid = tid >> 6, lane = tid & 63, fr = lane & 15, fq = lane >> 4;
    const int n = item & 31, bh = item >> 5, h = bh & 3, b = bh >> 2, tok0 = b * T + n * 128;
    const float lg = ret_lg(h);
    LAS bf16_t* Q = lds; LAS bf16_t* Kk = lds + 128 * LDS_LD; LAS bf16_t* VT = lds + 2 * 128 * LDS_LD; LAS bf16_t* RP = lds + 3 * 128 * LDS_LD;
    {
        const bf16_t* rp = (const bf16_t*)(p.ws + OFF_RPREV) + ((size_t)item << 14);
        RotCS cs[2]; u32x4 qa[2], qb[2], ka[2], kb[2], rv[4], rpv[4];
        fetch_qk(p, qa, qb, tid, tok0, C_Q + h * 128); fetch_qk(p, ka, kb, tid, tok0, C_K + h * 128); fetch_cs(p, cs, tid, tok0);
        fetch_v(p, rv, tid, tok0, C_V + h * 128);
#pragma unroll
        for (int it = 0; it < 4; ++it) rpv[it] = *(const u32x4*)(rp + (size_t)(tid + it * 512) * 8);
        store_rot<false>(Q, qa, qb, cs, tid, 1.0f, 0.f);
        store_rot<false>(Kk, ka, kb, cs, tid, 0.08838834764831845f, 0.f);
        store_vT(VT, rv, tid);
#pragma unroll
        for (int it = 0; it < 4; ++it) { const int u = tid + it * 512, e = u >> 4, d0 = (u & 15) * 8; *(LAS u32x4*)(RP + e * LDS_LD + d0) = rpv[it]; }
    }
    __syncthreads();
    const int i0 = wid * 16;
    f32x4 acc[8], sc_[8];
#pragma unroll
    for (int i = 0; i < 8; ++i) { acc[i] = (f32x4){0.f, 0.f, 0.f, 0.f}; sc_[i] = (f32x4){0.f, 0.f, 0.f, 0.f}; }
    strip_mma(Q, i0, RP, acc, fr, fq);
    strip_mma(Q, i0, Kk, sc_, fr, fq);
#pragma unroll
    for (int jj = 0; jj < 4; ++jj) { const float sc = exp2f(lg * (float)(i0 + fq * 4 + jj + 1));
#pragma unroll
        for (int nn = 0; nn < 8; ++nn) acc[nn][jj] *= sc; }
    asm volatile("s_waitcnt lgkmcnt(0)" ::: "memory");
    LAS bf16_t* P = Q;
    {
        float rf[4], cf[8];
#pragma unroll
        for (int jj = 0; jj < 4; ++jj) rf[jj] = exp2f(lg * (float)(i0 + fq * 4 + jj));
#pragma unroll
        for (int nn = 0; nn < 8; ++nn) cf[nn] = exp2f(-lg * (float)(nn * 16 + fr));
#pragma unroll
        for (int nn = 0; nn < 8; ++nn)
#pragma unroll
            for (int jj = 0; jj < 4; ++jj) {
                const int i = i0 + fq * 4 + jj, j = nn * 16 + fr;
                const float m = (i >= j) ? rf[jj] * cf[nn] : 0.f;
                P[i * LDS_LD + j] = f2bf(sc_[nn][jj] * m);
            }
    }
    asm volatile("s_waitcnt lgkmcnt(0)" ::: "memory");
    strip_mma(P, i0, VT, acc, fr, fq);
    if (n == 0 && wid == 0 && fq == 0) {
        const float s0 = ((const float*)(p.ws + OFF_SACC))[b * 4 + h];
#pragma unroll
        for (int nn = 0; nn < 8; ++nn) acc[nn][0] = s0 * bf2f(VT[(nn * 16 + fr) * LDS_LD]);
    }
    asm volatile("s_waitcnt lgkmcnt(0)" ::: "memory");
    const bf16_t* proj = (const bf16_t*)(p.ws + OFF_PROJ);
    bf16_t* br1 = (bf16_t*)(p.ws + OFF_BR) + (size_t)BT * BW;
    const float* gn = p.ret_norm_g + l * BW + h * 128;
    float gv[8];
#pragma unroll
    for (int nn = 0; nn < 8; ++nn) gv[nn] = gn[nn * 16 + fr];
#pragma unroll
    for (int jj = 0; jj < 4; ++jj) {
        float s = 0.f;
#pragma unroll
        for (int nn = 0; nn < 8; ++nn) s += acc[nn][jj];
        s = red16(s); const float mean = s * (1.0f / 128.0f);
        float vs = 0.f;
#pragma unroll
        for (int nn = 0; nn < 8; ++nn) { const float d = acc[nn][jj] - mean; vs += d * d; }
        vs = red16(vs); const float rstd = rsqrtf(vs * (1.0f / 128.0f) + 1e-5f);
#pragma unroll
        for (int nn = 0; nn < 8; ++nn) Q[(i0 + fq * 4 + jj) * LDS_LD + nn * 16 + fr] = f2bf((acc[nn][jj] - mean) * rstd * gv[nn]);
    }
    asm volatile("s_waitcnt lgkmcnt(0)" ::: "memory");
#pragma unroll
    for (int it = 0; it < 4; ++it) {
        const int i = i0 + it * 4 + fq, e0 = fr * 8;
        const size_t tok = (size_t)(tok0 + i);
        float ov[8], gt[8], o[8];
        unpack8(*(const LAS u32x4*)(Q + i * LDS_LD + e0), ov);
        unpack8(*(const u32x4*)(proj + tok * DINP + C_RG + h * 128 + e0), gt);
#pragma unroll
        for (int k = 0; k < 8; ++k) o[k] = ov[k] * siluf_(gt[k]);
        *(u32x4*)(br1 + tok * BW + h * 128 + e0) = pack8(o);
    }
    __syncthreads();
}

__device__ __forceinline__ void c0_item(const Params& p, int l, unsigned char* shm) {
    const int tid = tid_(), b = tid >> 7, h = (tid >> 4) & 7, q = tid & 15, ch = h * 64 + q * 4;
    float* P0 = (float*)shm;
    {
        const float* pp = (const float*)(p.ws + OFF_P0F);
        float v18[18];
#pragma unroll
        for (int j = 0; j < 18; ++j) v18[j] = pp[tid + j * 512];
#pragma unroll
        for (int j = 0; j < 18; ++j) P0[tid + j * 512] = v18[j];
    }
    __syncthreads();
    {
        const int b2 = tid >> 7, h2 = (tid >> 5) & 3, l32 = tid & 31;
        const f32x4 qv = *(const f32x4*)(P0 + b2 * P0W + 1152 + h2 * 128 + l32 * 4), kv = *(const f32x4*)(P0 + b2 * P0W + 1664 + h2 * 128 + l32 * 4);
        float sp = (qv[0] * kv[0] + qv[1] * kv[1]) + (qv[2] * kv[2] + qv[3] * kv[3]);
        sp = red16(sp); sp += __shfl_xor(sp, 16);
        if (l32 == 0) ((float*)(p.ws + OFF_SACC))[b2 * 4 + h2] = sp * 0.08838834764831845f;
    }
    const float* p0 = P0 + b * P0W;
    const float* mu = p.shift_mu + l * RW_W;
    float* AL = P0 + NB * P0W;
    if (tid < 256) AL[tid] = P0[(tid >> 6) * P0W + 1024 + (tid & 63)] * (1.0f - mu[RW_AL + (tid & 63)]);
    __syncthreads();
    f32x4 aacc = *(const f32x4*)(p.a0 + l * BW + ch);
#pragma unroll
    for (int i0 = 0; i0 < 64; i0 += 32) {
        f32x4 rows[32];
#pragma unroll
        for (int j = 0; j < 32; ++j) rows[j] = *(const f32x4*)(p.a2 + ((size_t)l * 64 + i0 + j) * BW + ch);
#pragma unroll
        for (int j = 0; j < 32; ++j) aacc += AL[b * 64 + i0 + j] * rows[j];
    }
    const f32x4 r0 = *(const f32x4*)(p0 + ch), k0v = *(const f32x4*)(p0 + 512 + ch);
    const f32x4 ka = *(const f32x4*)(p.k_a + l * BW + ch);
    float cpart = 0.f;
#pragma unroll
    for (int i = 0; i < 4; ++i) { const float av = 1.0f / (1.0f + expf(-aacc[i]));
        const float rr_ = r0[i] * (1.0f - mu[RW_R + ch + i]), kk_ = k0v[i] * (1.0f - mu[RW_K + ch + i]);
        cpart += rr_ * (kk_ * (1.0f + (av - 1.0f) * ka[i])); }
    const float c0 = red16(cpart);
    if (q == 0) ((float*)(p.ws + OFF_CACC))[b * 8 + h] = c0;
    __syncthreads();
}
__device__ __forceinline__ void rwkv_post(const Params& p, int l) {
    const bf16_t* proj = (const bf16_t*)(p.ws + OFF_PROJ);
    bf16_t* br2 = (bf16_t*)(p.ws + OFF_BR) + (size_t)2 * BT * BW;
    const float* bonus = (const float*)(p.ws + OFF_BONUS);
    const unsigned char* stream = p.ws + OFF_STREAM;
    const float* ln_w = p.ln_w + l * BW; const float* ln_b = p.ln_b + l * BW;
    const int gtid = blockIdx.x * 512 + tid_(), nth = gridDim.x * 512;
    for (int idx = gtid; idx < BT * 128; idx += nth) {
        const int tok = idx >> 7, h = (idx >> 4) & 7, q = idx & 15, ch = h * 64 + q * 4, b = tok >> 12, tpos = tok & (T - 1);
        f32x4 y = *(const f32x4*)((const float*)(proj + (size_t)tok * DINP + C_RW) + ch);
        if (tpos == 0) {
            const float c0 = ((const float*)(p.ws + OFF_CACC))[b * 8 + h];
            const u32x2 vq = *(const u32x2*)(stream + ((size_t)(b * 8 + h) * T) * SREC + 768 + q * 8);
            y = (f32x4){bflo(vq.x) * c0, bfhi(vq.x) * c0, bflo(vq.y) * c0, bfhi(vq.y) * c0};
        }
        float s = (y[0] + y[1]) + (y[2] + y[3]); s = red16(s); const float mean = s * (1.0f / 64.0f);
        const f32x4 d = y - mean;
        float vs = (d[0] * d[0] + d[1] * d[1]) + (d[2] * d[2] + d[3] * d[3]); vs = red16(vs);
        const float rstd = rsqrtf(vs * (1.0f / 64.0f) + 64e-5f);
        const u32x2 vv = *(const u32x2*)(stream + ((size_t)(b * 8 + h) * T + tpos) * SREC + 768 + q * 8);
        const u32x2 gg = *(const u32x2*)(proj + (size_t)tok * DINP + C_RWG + ch);
        const float bs = bonus[(size_t)tok * 8 + h];
        const float v4[4] = {bflo(vv.x), bfhi(vv.x), bflo(vv.y), bfhi(vv.y)}, g4[4] = {bflo(gg.x), bfhi(gg.x), bflo(gg.y), bfhi(gg.y)};
        float o[4];
#pragma unroll
        for (int i = 0; i < 4; ++i) o[i] = (d[i] * rstd * ln_w[ch + i] + ln_b[ch + i] + bs * v4[i]) * siluf_(g4[i]);
        u32x2 w; w.x = pk2(o[0], o[1]); w.y = pk2(o[2], o[3]);
        *(u32x2*)(br2 + (size_t)tok * BW + ch) = w;
    }
}


__device__ __forceinline__ void gemm_inproj(const Params& p, LAS unsigned char* lds) {
    pg8::Gemm g{(const bf16_t*)(p.ws + OFF_H), (const bf16_t*)(p.ws + p.img_off + OFF_WIN), BT, DINP, D}; pg8::StaticOrder S; S.init(BT, DINP, (int)gridDim.x, (int)blockIdx.x); EpiProj E{(bf16_t*)(p.ws + OFF_PROJ)};
    pg8::gemm_phase<EpiProj, pg8::StaticOrder, false>(lds, g, S, E, nullptr);
}
template <int NBR> __device__ __forceinline__ void gemm_merge1(const Params& p, LAS unsigned char* lds) {
    const bf16_t* br = (const bf16_t*)(p.ws + OFF_BR); const bf16_t* Wt_br = (const bf16_t*)(p.ws + OFF_WBR);
    pg8::StaticOrder S; S.init(BT, D, (int)gridDim.x, (int)blockIdx.x);
    pg8::Gemm g{br + (size_t)NBR * BT * BW, Wt_br + (size_t)NBR * D * BW, BT, D, BW};
    EpiMerge<NBR> E{(const bf16_t*)(p.ws + OFF_PROJ), (float*)(p.ws + OFF_MERGED), (bf16_t*)(p.ws + OFF_MERGEDB)};
    pg8::gemm_phase<EpiMerge<NBR>, pg8::StaticOrder, false>(lds, g, S, E, nullptr);
}
__device__ __forceinline__ void gemm_merge(const Params& p, LAS unsigned char* lds) { gemm_merge1<0>(p, lds); gemm_merge1<1>(p, lds); gemm_merge1<2>(p, lds); }
__device__ __forceinline__ void gemm_merge_all(const Params& p, LAS unsigned char* lds) {
    pg8::Gemm g{(const bf16_t*)(p.ws + OFF_BR), (const bf16_t*)(p.ws + OFF_WBR), 3 * BT, 3 * D, BW};
    MergeOrder S; S.base.init(BT, D, (int)gridDim.x, (int)blockIdx.x);
    EpiMergeAll E{(const bf16_t*)(p.ws + OFF_PROJ), (float*)(p.ws + OFF_MERGED), (bf16_t*)(p.ws + OFF_MERGEDB)};
    pg8::gemm_phase<EpiMergeAll, MergeOrder, false>(lds, g, S, E, nullptr);
}
__device__ __forceinline__ void gemm_out(const Params& p, int l, const float* xin, LAS unsigned char* lds) {
    pg8::Gemm g{(const bf16_t*)(p.ws + OFF_MERGEDB), (const bf16_t*)(p.ws + p.img_off + OFF_WOUT), BT, D, D}; pg8::StaticOrder S; S.init(BT, D, (int)gridDim.x, (int)blockIdx.x);
    EpiOut E{xin, p.out, (const float*)(p.ws + OFF_MOD) + (size_t)l * NB * 3 * D + 2 * D};
    pg8::gemm_phase<EpiOut, pg8::StaticOrder, false>(lds, g, S, E, nullptr);
}
constexpr int MG_BK = 64, MG_A_BYTES = 256 * MG_BK * 2, MG_B_BYTES = 128 * MG_BK * 2, MG_STAGE = MG_A_BYTES + MG_B_BYTES;
template <int DRY> __device__ __forceinline__ void gemm_merge_fused(const Params& p, LAS unsigned char* lds) {
    const int tid = tid_(), wid = tid >> 6, lane = tid & 63, fr = lane & 15, fq = lane >> 4, wr = wid >> 1, wc = wid & 1;
    const bf16_t* br = (const bf16_t*)(p.ws + OFF_BR); const bf16_t* Wt = (const bf16_t*)(p.ws + p.img_off + OFF_WBR);
    const bf16_t* proj = (const bf16_t*)(p.ws + OFF_PROJ); bf16_t* mergedb = (bf16_t*)(p.ws + OFF_MERGEDB);
    int a_off[4], b_off[2];
#pragma unroll
    for (int i = 0; i < 4; ++i) { const int c = tid + i * 512, row = c >> 3; a_off[i] = row * BW + (((c & 7) ^ (row & 7)) * 8); }
#pragma unroll
    for (int i = 0; i < 2; ++i) { const int c = tid + i * 512, row = c >> 3, rho = row & 31, srow = (row & ~31) + 8 * ((rho & 15) >> 2) + 4 * (rho >> 4) + (rho & 3);
        b_off[i] = srow * BW + (((c & 7) ^ (row & 7)) * 8); }
    f32x4 tot[4][4], acc[4][4];
    int nmine = 0; for (int u = (int)blockIdx.x; u < 512; u += (int)gridDim.x) ++nmine;
    const int nsteps = nmine * 24;
    auto unit_of = [&](int ui, int& pm, int& pn) { const int u = (int)blockIdx.x + ui * (int)gridDim.x; pm = (u & 7) + 8 * (u >> 6); pn = (u >> 3) & 7; };
    auto dma = [&](int g) {
        const int ui = g / 24, r = g - ui * 24, n = r >> 3, t = r & 7; int pm, pn; unit_of(ui, pm, pn);
        const bf16_t* A = br + (size_t)n * BT * BW + (size_t)(pm * 256) * BW + t * MG_BK;
        const bf16_t* Bw = Wt + (size_t)n * D * BW + (size_t)(pn * 128) * BW + t * MG_BK;
        LAS unsigned char* base = lds + (g % 3) * MG_STAGE + wid * 1024;
#pragma unroll
        for (int i = 0; i < 4; ++i) __builtin_amdgcn_global_load_lds((const unsigned*)(A + a_off[i]), (LAS unsigned*)(base + i * 8192), 16, 0, 0);
#pragma unroll
        for (int i = 0; i < 2; ++i) __builtin_amdgcn_global_load_lds((const unsigned*)(Bw + b_off[i]), (LAS unsigned*)(base + MG_A_BYTES + i * 8192), 16, 0, 0);
    };
#pragma unroll
    for (int m = 0; m < 4; ++m)
#pragma unroll
        for (int n = 0; n < 4; ++n) { tot[m][n] = (f32x4){0.f, 0.f, 0.f, 0.f}; acc[m][n] = (f32x4){0.f, 0.f, 0.f, 0.f}; }
    if (nsteps > 0) { dma(0); if (nsteps > 1) { dma(1); asm volatile("s_waitcnt vmcnt(6)" ::: "memory"); } else asm volatile("s_waitcnt vmcnt(0)" ::: "memory"); }
    __builtin_amdgcn_s_barrier(); asm volatile("" ::: "memory");
    for (int g = 0; g < nsteps; ++g) {
        {
            const LAS unsigned char* Ab = lds + (g % 3) * MG_STAGE; const LAS unsigned char* Bb = Ab + MG_A_BYTES;
#pragma unroll
            for (int kk = 0; kk < 2; ++kk) {
                if (kk == 1 && g + 2 < nsteps) dma(g + 2);
                bf16x8 af[4], bfv[4];
#pragma unroll
                for (int m = 0; m < 4; ++m) { const int row = wr * 64 + m * 16 + fr; af[m] = *(const LAS bf16x8*)(Ab + row * 128 + (((kk * 4 + fq) ^ (row & 7)) * 16)); }
#pragma unroll
                for (int n = 0; n < 4; ++n) { const int row = wc * 64 + n * 16 + fr; bfv[n] = *(const LAS bf16x8*)(Bb + row * 128 + (((kk * 4 + fq) ^ (row & 7)) * 16)); }
                __builtin_amdgcn_s_setprio(1);
#pragma unroll
                for (int m = 0; m < 4; ++m)
#pragma unroll
                    for (int n = 0; n < 4; ++n) { if (DRY != 1) acc[m][n] = __builtin_amdgcn_mfma_f32_16x16x32_bf16(bfv[n], af[m], acc[m][n], 0, 0, 0); else { asm volatile("" :: "v"(bfv[n]), "v"(af[m])); } }
                __builtin_amdgcn_s_setprio(0);
            }
        }
        const int ui = g / 24, r = g - ui * 24, nb = r >> 3, t = r & 7;
        if (t == 7 && DRY == 0) {
            int pm, pn; unit_of(ui, pm, pn);
            const int row0 = pm * 256 + wr * 64 + fr, col0 = pn * 128 + wc * 64 + fq * 8;
#pragma unroll
            for (int m = 0; m < 4; ++m)
#pragma unroll
                for (int pp_ = 0; pp_ < 2; ++pp_) {
                    const u32x4 lg = *(const u32x4*)(proj + (size_t)(row0 + m * 16) * DINP + C_GATE + nb * D + col0 + pp_ * 32);
                    f32x4& t0 = tot[m][2 * pp_]; f32x4& t1 = tot[m][2 * pp_ + 1]; f32x4& c0 = acc[m][2 * pp_]; f32x4& c1 = acc[m][2 * pp_ + 1];
                    t0[0] += sigmoidf_(bflo(lg.x)) * c0[0]; t0[1] += sigmoidf_(bfhi(lg.x)) * c0[1]; t0[2] += sigmoidf_(bflo(lg.y)) * c0[2]; t0[3] += sigmoidf_(bfhi(lg.y)) * c0[3];
                    t1[0] += sigmoidf_(bflo(lg.z)) * c1[0]; t1[1] += sigmoidf_(bfhi(lg.z)) * c1[1]; t1[2] += sigmoidf_(bflo(lg.w)) * c1[2]; t1[3] += sigmoidf_(bfhi(lg.w)) * c1[3];
                    c0 = (f32x4){0.f, 0.f, 0.f, 0.f}; c1 = (f32x4){0.f, 0.f, 0.f, 0.f};
                }
            if (nb == 2) {
#pragma unroll
                for (int m = 0; m < 4; ++m)
#pragma unroll
                    for (int pp_ = 0; pp_ < 2; ++pp_) {
                        f32x4& t0 = tot[m][2 * pp_]; f32x4& t1 = tot[m][2 * pp_ + 1];
                        u32x4 w; w.x = pk2(t0[0], t0[1]); w.y = pk2(t0[2], t0[3]); w.z = pk2(t1[0], t1[1]); w.w = pk2(t1[2], t1[3]);
                        *(u32x4*)(mergedb + (size_t)(row0 + m * 16) * D + col0 + pp_ * 32) = w;
                        t0 = (f32x4){0.f, 0.f, 0.f, 0.f}; t1 = (f32x4){0.f, 0.f, 0.f, 0.f};
                    }
            }
        }
        if (g + 2 < nsteps) asm volatile("s_waitcnt vmcnt(6)" ::: "memory"); else asm volatile("s_waitcnt vmcnt(0)" ::: "memory");
        asm volatile("s_waitcnt lgkmcnt(0)" ::: "memory");
        __builtin_amdgcn_s_barrier(); asm volatile("" ::: "memory");
    }
    __syncthreads();
}

#ifndef DUP_P1
#define DUP_P1 0
#endif
#ifndef DUP_P2
#define DUP_P2 0
#endif
#ifndef DUP_P3A
#define DUP_P3A 0
#endif
#ifndef DUP_P3B
#define DUP_P3B 0
#endif
#ifndef DUP_P3C
#define DUP_P3C 0
#endif
#ifndef DUP_P4
#define DUP_P4 0
#endif
#ifndef DUP_P5A
#define DUP_P5A 0
#endif
#ifndef DUP_P5B
#define DUP_P5B 0
#endif
#ifndef DUP_P6
#define DUP_P6 0
#endif
#ifndef DUP_P7
#define DUP_P7 0
#endif
#ifndef DUP_P0
#define DUP_P0 0
#endif
#ifndef DUP_R2
#define DUP_R2 0
#endif
#ifndef DUP_P6DRY
#define DUP_P6DRY 0
#endif
#ifndef DUP_P6NOEPI
#define DUP_P6NOEPI 0
#endif
#ifndef DUP_SYNC
#define DUP_SYNC 0
#endif
#if defined(__HIP_DEVICE_COMPILE__)
#define FRESH_PARAMS(q) Params q; { const __attribute__((address_space(4))) Params* pp_ = (const __attribute__((address_space(4))) Params*)__builtin_amdgcn_kernarg_segment_ptr(); asm volatile("" : "+s"(pp_)); q = *pp_; }
#else
#define FRESH_PARAMS(q) Params q = p_unused;
#endif
__global__ void __launch_bounds__(512, 2) fwd_megakernel(Params p_unused) {
    extern __shared__ __attribute__((aligned(16))) unsigned char shm[];
    cg::grid_group grid = cg::this_grid();
    LAS unsigned char* lds = (LAS unsigned char*)shm;
    const int G = (int)gridDim.x, bid = (int)blockIdx.x;
    volatile LAS unsigned* xb_st = (volatile LAS unsigned*)(lds + LDS_MAIN);
    if (tid_() == 0) { xb_st[0] = 0u; xb_st[1] = 0u; xb_st[2] = 0u; xb_st[3] = 0u; }
    __syncthreads();
    { FRESH_PARAMS(p); (void)xcd_barrier_post((unsigned*)(p.ws + OFF_BAR), xb_st); }
#define GSYNC() do { FRESH_PARAMS(pb_); XcdBarrier b_; b_.bar = (unsigned*)(pb_.ws + OFF_BAR); b_.x = xb_xcc_id(); b_.st = xb_st; xcd_barrier(b_); } while (0)

    for (int rep = 0; rep <= DUP_P0; ++rep) { FRESH_PARAMS(p); phase0(p, shm); }
    __syncthreads();
    { FRESH_PARAMS(p); p.img_off = 0; phase_weights(p, 0, shm, bid, G); }
    grid.sync();

#pragma nounroll
    for (int l = 0; l < NL; ++l) {
        for (int rep = 0; rep <= DUP_P1; ++rep) {
        { FRESH_PARAMS(p); phase_norm(p, l, (l == 0) ? p.x : p.out); }
        }
        GSYNC();
        for (int rep = 0; rep <= DUP_P2; ++rep) { FRESH_PARAMS(p); p.img_off = (size_t)(l & 1) * IMG_STRIDE; gemm_inproj(p, lds); }
        if (l + 1 < NL) { FRESH_PARAMS(p); p.img_off = (size_t)((l + 1) & 1) * IMG_STRIDE;
            if (G == 256) { if (bid >= 64) phase_weights(p, l + 1, shm, bid - 64, 192); }
            else phase_weights(p, l + 1, shm, bid, G); }
        { FRESH_PARAMS(p); const int first = (G == 256) ? 64 : 0; for (int it = bid - first; it >= 0 && it < 264; it += G - first) gemv0_item(p, l, it, shm); }
        GSYNC();
        for (int rep = 0; rep <= DUP_P3A; ++rep) { FRESH_PARAMS(p); for (int it = bid; it < BT / 64; it += G) pool_item(p, l, it); }
        for (int rep = 0; rep <= DUP_P3B; ++rep) { FRESH_PARAMS(p); for (int it = bid; it < 512; it += G) ret_r1_item(p, it, (LAS bf16_t*)lds); }
        for (int rep = 0; rep <= DUP_P3C; ++rep) { FRESH_PARAMS(p); p.img_off = (size_t)(l & 1) * IMG_STRIDE; for (int it = bid; it < BT / 32; it += G) rwkv_prep_item(p, l, it, (LAS bf16_t*)lds); }
        if (bid == G - 1) { FRESH_PARAMS(p); c0_item(p, l, shm); }
        GSYNC();
        for (int rep = 0; rep <= DUP_R2; ++rep) { FRESH_PARAMS(p); ret_r2(p); }
        for (int rep = 0; rep <= DUP_P4; ++rep) { FRESH_PARAMS(p); for (int it = bid; it < 256; it += G) rwkv_scan_item(p, it, (LAS float*)lds, (LAS unsigned*)(lds + LDS_MAIN + 16)); }
        GSYNC();
        for (int rep = 0; rep <= DUP_P5A; ++rep) { FRESH_PARAMS(p); for (int it = bid; it < 512; it += G) ret_r3_item(p, l, it, (LAS bf16_t*)lds); }
        for (int rep = 0; rep <= DUP_P5B; ++rep) { FRESH_PARAMS(p); rwkv_post(p, l); }
        GSYNC();
        for (int rep = 0; rep <= DUP_P6; ++rep) {
        { FRESH_PARAMS(p); p.img_off = (size_t)(l & 1) * IMG_STRIDE; gemm_merge_fused<0>(p, lds); }
        }
        GSYNC();
        for (int rep = 0; rep < DUP_P7; ++rep) { FRESH_PARAMS(p); p.img_off = (size_t)(l & 1) * IMG_STRIDE; Params q = p; q.out = (float*)(p.ws + OFF_MERGED); gemm_out(q, l, (l == 0) ? p.x : p.out, lds); }
        { FRESH_PARAMS(p); p.img_off = (size_t)(l & 1) * IMG_STRIDE; gemm_out(p, l, (l == 0) ? p.x : p.out, lds); }
        GSYNC();
        for (int rep = 0; rep < DUP_SYNC; ++rep) GSYNC();
    }
    { FRESH_PARAMS(p); phase_final_norm(p); }
}

extern "C" void kernel_launch(void* const* d_in, const int* in_sizes, int n_in, void* d_out, int out_size, void* d_ws, size_t ws_size, hipStream_t stream) {
    (void)in_sizes; (void)n_in; (void)out_size;
    if (ws_size < WS_NEED) { fprintf(stderr, "workspace too small: %zu < %zu\n", ws_size, (size_t)WS_NEED); return; }
    static int grid_blocks = 0;
    if (!grid_blocks) {
        int dev = 0, cus = 0, per_cu = 0;
        hipGetDevice(&dev);
        hipDeviceGetAttribute(&cus, hipDeviceAttributeMultiprocessorCount, dev);
        hipFuncSetAttribute((const void*)fwd_megakernel, hipFuncAttributeMaxDynamicSharedMemorySize, LDS_BYTES);
        hipOccupancyMaxActiveBlocksPerMultiprocessor(&per_cu, fwd_megakernel, 512, LDS_BYTES);
        if (per_cu < 1) per_cu = 1;
        grid_blocks = cus * per_cu;
        if (grid_blocks > 256) grid_blocks = 256;
    }
    Params p{};
    p.x = (const float*)d_in[0]; p.c = (const float*)d_in[1]; p.pos = (const int*)d_in[2];
    p.norm_g = (const float*)d_in[3]; p.w_ada = (const float*)d_in[4]; p.b_ada = (const float*)d_in[5]; p.w_in = (const float*)d_in[6];
    p.pool_w = (const float*)d_in[7]; p.pool_scale = (const float*)d_in[8]; p.ret_norm_g = (const float*)d_in[9]; p.shift_mu = (const float*)d_in[10];
    p.w0 = (const float*)d_in[11]; p.w2 = (const float*)d_in[12]; p.a0 = (const float*)d_in[13]; p.a2 = (const float*)d_in[14];
    p.k_k = (const float*)d_in[15]; p.k_a = (const float*)d_in[16]; p.r_k = (const float*)d_in[17]; p.ln_w = (const float*)d_in[18]; p.ln_b = (const float*)d_in[19];
    p.w_branch = (const float*)d_in[20]; p.w_out = (const float*)d_in[21]; p.final_g = (const float*)d_in[22];
    p.out = (float*)d_out; p.ws = (unsigned char*)d_ws;
    (void)hipMemsetAsync((unsigned char*)d_ws + OFF_BAR, 0, SZ_BAR, stream);
    void* args[] = {&p};
    hipError_t e = hipLaunchCooperativeKernel((const void*)fwd_megakernel, dim3(grid_blocks), dim3(512), args, LDS_BYTES, stream);
    if (e != hipSuccess) fprintf(stderr, "cooperative launch failed: %s (grid %d)\n", hipGetErrorString(e), grid_blocks);
}
```

```cpp
#include <hip/hip_runtime.h>
#include <hip/hip_cooperative_groups.h>
#include <cstdio>
namespace cg = cooperative_groups;

__device__ __forceinline__ int tid_() { int t = (int)__builtin_amdgcn_workitem_id_x(); asm volatile("" : "+v"(t)); return t; }
#define LAS __attribute__((address_space(3)))

#define XB_TMO      128
#define XB_XCNT(j)  (256  + 64 * (j))
#define XB_XSUB(j)  (1280 + 64 * (j))
#define XB_XGEN(j)  (2304 + 64 * (j))
#define XB_TOP      3328
#define XB_TOPGEN   3392
#define XCD_BAR_WORDS 3456
#define XB_SPIN_CAP (1u << 18)

__device__ __forceinline__ unsigned xb_ld(unsigned* p)              { return __hip_atomic_load(p, __ATOMIC_RELAXED, __HIP_MEMORY_SCOPE_AGENT); }
__device__ __forceinline__ unsigned xb_add(unsigned* p, unsigned v) { return __hip_atomic_fetch_add(p, v, __ATOMIC_RELAXED, __HIP_MEMORY_SCOPE_AGENT); }
__device__ __forceinline__ unsigned xb_xcc_id() { return (unsigned)__builtin_amdgcn_s_getreg((3 << 11) | 20) & 0xFu; }
#define XB_SPIN(cond, bar) do { unsigned _sp = 0; while (cond) { __builtin_amdgcn_s_sleep(1); \
    if ((++_sp & 255u) == 0u) { if (xb_ld(&(bar)[XB_TMO])) break; if (_sp > XB_SPIN_CAP) { atomicAdd(&(bar)[XB_TMO], 1u); break; } } } } while (0)

struct XcdBarrier {
    unsigned* bar; unsigned x;
    volatile LAS unsigned* st;
};

__device__ __forceinline__ XcdBarrier xcd_barrier_post(unsigned* bar, volatile LAS unsigned* st) {
    XcdBarrier b; b.bar = bar; b.x = xb_xcc_id(); b.st = st;
    if (tid_() == 0) (void)xb_add(&bar[XB_XCNT(b.x)], 1u);
    return b;
}
__device__ __forceinline__ void xcd_barrier_complete(unsigned* bar, unsigned x, unsigned& nloc, unsigned& nx) {
    const unsigned G = gridDim.x * gridDim.y * gridDim.z;
    unsigned sum, cnt, mine, sp = 0u;
    for (;;) {
        sum = 0u; cnt = 0u; mine = 0u;
#pragma unroll
        for (unsigned j = 0; j < 16; ++j) { const unsigned c = xb_ld(&bar[XB_XCNT(j)]); sum += c; cnt += (c > 0u) ? 1u : 0u; mine = (j == x) ? c : mine; }
        if (sum == G) break;
        __builtin_amdgcn_s_sleep(1);
        if ((++sp & 255u) == 0u) { if (xb_ld(&bar[XB_TMO])) break; if (sp > XB_SPIN_CAP) { atomicAdd(&bar[XB_TMO], 1u); break; } }
    }
    nloc = mine > 0u ? mine : 1u; nx = cnt > 0u ? cnt : 1u;
}

__device__ __forceinline__ void xcd_barrier(const XcdBarrier& b) {
    asm volatile("s_waitcnt vmcnt(0)" ::: "memory");
    __syncthreads();
    if (tid_() == 0) {
        unsigned* bar = b.bar;
        __builtin_amdgcn_s_waitcnt(0);
        unsigned nloc = b.st[0], nx = b.st[1];
        if (nloc == 0u) { xcd_barrier_complete(bar, b.x, nloc, nx); b.st[0] = nloc; b.st[1] = nx; }
        const unsigned old = xb_add(&bar[XB_XSUB(b.x)], 1u);
        const unsigned gen = old / nloc;
        if (old + 1u == (gen + 1u) * nloc) {
            __builtin_amdgcn_fence(__ATOMIC_RELEASE, "agent");
            asm volatile("s_waitcnt vmcnt(0)" ::: "memory");
            const unsigned og = xb_add(&bar[XB_TOP], 1u);
            const unsigned tg = og / nx;
            if (og + 1u == (tg + 1u) * nx) xb_add(&bar[XB_TOPGEN], 1u);
            else XB_SPIN(xb_ld(&bar[XB_TOPGEN]) == tg, bar);
            __builtin_amdgcn_fence(__ATOMIC_ACQUIRE, "agent");
            xb_add(&bar[XB_XGEN(b.x)], 1u);
            asm volatile("s_waitcnt vmcnt(0)" ::: "memory");
        } else {
            XB_SPIN(xb_ld(&bar[XB_XGEN(b.x)]) == gen, bar);
            __builtin_amdgcn_fence(__ATOMIC_ACQUIRE, "agent");
            asm volatile("s_waitcnt vmcnt(0)" ::: "memory");
        }
    }
    __syncthreads();
}
namespace pg8 {
#define PG8_LAS __attribute__((address_space(3)))
typedef unsigned short bf16_t;
typedef short bf16x8 __attribute__((ext_vector_type(8)));
typedef float f32x4 __attribute__((ext_vector_type(4)));
typedef unsigned u32x4 __attribute__((ext_vector_type(4)));
constexpr int BM = 256, BK = 64, HALF = 128, HTB = HALF * BK * 2  , STAGE_BYTES = 8 * HTB, NXCD = 8, WGM = 8;

__host__ __device__ __forceinline__ int lds_byte(int r, int c) { const int st = (r >> 4) * 2 + (c >> 5), rr = r & 15, cc = c & 31, ob = rr * 64 + cc * 2; return st * 1024 + (ob ^ (((ob >> 9) & 1) << 5)); }
__host__ __device__ __forceinline__ void stage_rc(int b, int& R, int& C) { const int st = b / 1024, sb = b % 1024, swz = sb ^ (((sb >> 9) & 1) << 5); R = (st >> 1) * 16 + swz / 64; C = (st & 1) * 32 + (swz % 64) / 2; }
__host__ __device__ __forceinline__ int perm32(int rho) { const int n = rho >> 4, i = rho & 15; return 8 * (i >> 2) + 4 * n + (i & 3); }

struct Unit { int pm, pn; };
struct Gemm { const bf16_t* A; const bf16_t* Bt; int M, N, K; };

struct StaticOrder {
    int nM, nN, nwg, G, c;
    __host__ __device__ void init(int M, int N, int G_, int c_) { nM = M / BM; nN = N / BM; nwg = nM * nN; G = G_; c = c_; }
    __host__ __device__ bool next(int i, Unit& u) const {
        const long L = (long)i * G + c; if (L >= nwg) return false;
        int wgid = (int)L; { const int q = nwg / NXCD, r = nwg % NXCD, xcd = wgid % NXCD, off = wgid / NXCD; wgid = (xcd < r ? xcd * (q + 1) : r * (q + 1) + (xcd - r) * q) + off; }
        const int nig = WGM * nN, gid = wgid / nig, fm = gid * WGM, gsz = (nM - fm) < WGM ? (nM - fm) : WGM;
        u.pm = fm + ((wgid % nig) % gsz); u.pn = (wgid % nig) / gsz; return true;
    }
    __device__ __forceinline__ void a_ready(const Unit&) const {}
    __device__ __forceinline__ void done(const Unit&) const {}
};
__device__ __forceinline__ unsigned cvt_pk_bf16(float lo, float hi) { unsigned r; asm volatile("v_cvt_pk_bf16_f32 %0, %1, %2" : "=v"(r) : "v"(lo), "v"(hi)); return r; }
typedef float f32x2 __attribute__((ext_vector_type(2)));

template <class Epi, class Sched, bool STAMP = false>
__device__ __forceinline__ void gemm_phase(PG8_LAS unsigned char* lds, const Gemm g, const Sched& S, const Epi& E, unsigned long long* stamps) {
    const int tid = tid_(), wid = __builtin_amdgcn_readfirstlane(tid >> 6), lane = tid & 63, wr = wid >> 2, wc = wid & 3, fr = lane & 15, fq = lane >> 4;
    const int K = g.K, nt = K / BK;
    int ts_lo = 0, ts_hi = 0, nts = 0; const unsigned long long rt_entry = STAMP ? (unsigned long long)wall_clock64() : 0ull;
#define PG8_STAMP() do { if (STAMP && wid == 0 && nts < 64) { const unsigned long long _c = (unsigned long long)clock64(); \
        ts_lo = (lane == nts) ? (int)(unsigned)_c : ts_lo; ts_hi = (lane == nts) ? (int)(unsigned)(_c >> 32) : ts_hi; ++nts; } } while (0)
    PG8_STAMP();
    unsigned voffA[2], voffB[2];
#pragma unroll
    for (int i = 0; i < 2; ++i) { int R, C; stage_rc(tid * 16 + i * 8192, R, C); const int Rb = Epi::PERM ? ((R & ~31) + perm32(R & 31)) : R;
        voffA[i] = (unsigned)(R * K + C) * 2u; voffB[i] = (unsigned)(Rb * K + C) * 2u; }
    const size_t kstep = (size_t)(BK * 2);
    const size_t hstep = (size_t)HALF * K * 2;
    const size_t tstep = 2 * hstep;
    const unsigned ldsw = (unsigned)wid * 1024u;
    const int aoff = lds_byte(wr * 64 + fr, fq * 8), boff = lds_byte(wc * 32 + fr, fq * 8);
#define PG8_SA(b, h) (((b) * 2 + (h)) * HTB)
#define PG8_SB(b, h) ((4 + (b) * 2 + (h)) * HTB)
#define PG8_STAGE(bufoff, gbase, voff) do { _Pragma("unroll") for (int _i = 0; _i < 2; ++_i) \
        __builtin_amdgcn_global_load_lds((const unsigned*)((const char*)(gbase) + (voff)[_i]), (PG8_LAS unsigned*)(lds + (bufoff) + ldsw + _i * 8192), 16, 0, 0); } while (0)
#define PG8_LDA(dst, b, h) do { _Pragma("unroll") for (int m = 0; m < 4; ++m) _Pragma("unroll") for (int k = 0; k < 2; ++k) dst[m][k] = *(const PG8_LAS bf16x8*)(lds + PG8_SA(b, h) + aoff + m * 2048 + k * 1024); } while (0)
#define PG8_LDB(dst, b, h) do { _Pragma("unroll") for (int n = 0; n < 2; ++n) _Pragma("unroll") for (int k = 0; k < 2; ++k) dst[n][k] = *(const PG8_LAS bf16x8*)(lds + PG8_SB(b, h) + boff + n * 2048 + k * 1024); } while (0)
#define PG8_MMA(ai, bj, At, Bt) do { __builtin_amdgcn_s_setprio(1); _Pragma("unroll") for (int m = 0; m < 4; ++m) _Pragma("unroll") for (int n = 0; n < 2; ++n) _Pragma("unroll") for (int k = 0; k < 2; ++k) \
        acc[ai][bj][m][n] = __builtin_amdgcn_mfma_f32_16x16x32_bf16(Bt[n][k], At[m][k], acc[ai][bj][m][n], 0, 0, 0); __builtin_amdgcn_s_setprio(0); } while (0)
#define PG8_WAIT_V(n) asm volatile("s_waitcnt vmcnt(" #n ")" ::: "memory")
#define PG8_WAIT_L(n) asm volatile("s_waitcnt lgkmcnt(" #n ")" ::: "memory")
#define PG8_BAR __builtin_amdgcn_s_barrier()
#define PG8_SCHED __builtin_amdgcn_sched_barrier(0)
    Unit cur, nxt; int ui = 0;
    if (!S.next(0, cur)) return;
    f32x4 acc[2][2][4][2];
#pragma unroll
    for (int a = 0; a < 2; ++a)
#pragma unroll
        for (int b = 0; b < 2; ++b)
#pragma unroll
            for (int m = 0; m < 4; ++m)
#pragma unroll
                for (int n = 0; n < 2; ++n) acc[a][b][m][n] = (f32x4){0.f, 0.f, 0.f, 0.f};
    bf16x8 At[4][2], B0[2][2], B1[2][2];
    const char* cA = (const char*)g.A + (size_t)cur.pm * tstep; const char* cB = (const char*)g.Bt + (size_t)cur.pn * tstep;
    S.a_ready(cur);
    PG8_STAGE(PG8_SB(0, 0), cB, voffB); PG8_STAGE(PG8_SA(0, 0), cA, voffA); PG8_STAGE(PG8_SB(0, 1), cB + hstep, voffB); PG8_STAGE(PG8_SA(0, 1), cA + hstep, voffA);
    if (wr == 1) PG8_BAR;
    PG8_WAIT_V(4); PG8_BAR;
    PG8_STAGE(PG8_SB(1, 0), cB + kstep, voffB); PG8_STAGE(PG8_SA(1, 0), cA + kstep, voffA); PG8_STAGE(PG8_SB(1, 1), cB + hstep + kstep, voffB);
    PG8_WAIT_V(6); PG8_BAR;
    PG8_STAMP();
    for (;;) {
        const bool has_next = S.next(ui + 1, nxt);
        const char* nA = has_next ? (const char*)g.A + (size_t)nxt.pm * tstep : cA; const char* nB = has_next ? (const char*)g.Bt + (size_t)nxt.pn * tstep : cB;
        for (int t = 0; t < nt; t += 2) {
            const bool last = (t == nt - 2);
            const char* a1 = cA + (size_t)(t + 1) * kstep;
            const char* a2 = last ? nA : cA + (size_t)(t + 2) * kstep; const char* b2 = last ? nB : cB + (size_t)(t + 2) * kstep;
            const char* a3 = a2 + kstep; const char* b3 = b2 + kstep;
            if (last && has_next) S.a_ready(nxt);
            PG8_LDB(B0, 0, 0); PG8_SCHED; PG8_LDA(At, 0, 0); PG8_STAGE(PG8_SA(1, 1), a1 + hstep, voffA);
            PG8_WAIT_L(8); PG8_BAR; PG8_WAIT_L(0); PG8_MMA(0, 0, At, B0); PG8_BAR; PG8_SCHED;
            PG8_LDB(B1, 0, 1); PG8_STAGE(PG8_SB(0, 0), b2, voffB);
            PG8_BAR; PG8_WAIT_L(0); PG8_MMA(0, 1, At, B1); PG8_BAR;
            PG8_LDA(At, 0, 1); PG8_STAGE(PG8_SA(0, 0), a2, voffA);
            PG8_BAR; PG8_WAIT_L(0); PG8_MMA(1, 0, At, B0); PG8_BAR; PG8_SCHED;
            PG8_STAGE(PG8_SB(0, 1), b2 + hstep, voffB);
            PG8_WAIT_V(6); PG8_BAR; PG8_MMA(1, 1, At, B1); PG8_BAR;
            PG8_LDB(B0, 1, 0); PG8_SCHED; PG8_LDA(At, 1, 0); PG8_STAGE(PG8_SA(0, 1), a2 + hstep, voffA);
            PG8_WAIT_L(8); PG8_BAR; PG8_WAIT_L(0); PG8_MMA(0, 0, At, B0); PG8_BAR; PG8_SCHED;
            PG8_LDB(B1, 1, 1); PG8_STAGE(PG8_SB(1, 0), b3, voffB);
            PG8_BAR; PG8_WAIT_L(0); PG8_MMA(0, 1, At, B1); PG8_BAR;
            PG8_LDA(At, 1, 1); PG8_STAGE(PG8_SA(1, 0), a3, voffA);
            PG8_BAR; PG8_WAIT_L(0); PG8_MMA(1, 0, At, B0); PG8_BAR; PG8_SCHED;
            PG8_STAGE(PG8_SB(1, 1), b3 + hstep, voffB);
            PG8_WAIT_V(6); PG8_BAR; PG8_MMA(1, 1, At, B1); PG8_BAR;
        }
        PG8_STAMP();
        if constexpr (!Epi::AFTER_DRAIN) { E(acc, cur, wr, wc, fr, fq); S.done(cur); }
        PG8_STAMP();
        if (!has_next) break;
#pragma unroll
        for (int a = 0; a < 2; ++a)
#pragma unroll
            for (int b = 0; b < 2; ++b)
#pragma unroll
                for (int m = 0; m < 4; ++m)
#pragma unroll
                    for (int n = 0; n < 2; ++n) acc[a][b][m][n] = (f32x4){0.f, 0.f, 0.f, 0.f};
        cur = nxt; cA = nA; cB = nB; ++ui;
    }
    PG8_WAIT_V(0);
    if (wr == 0) PG8_BAR;
    PG8_BAR;
    if constexpr (Epi::AFTER_DRAIN) { E.fused(acc, cur, wr, wc, fr, fq, lds, wid, lane); S.done(cur); }
    PG8_STAMP();
    if (STAMP && wid == 0) { stamps[lane] = lane < nts ? (((unsigned long long)(unsigned)ts_hi << 32) | (unsigned)ts_lo) : 0ull;
        if (lane == 62) stamps[62] = rt_entry; if (lane == 63) stamps[63] = (unsigned long long)wall_clock64(); }
#undef PG8_STAMP
#undef PG8_SA
#undef PG8_SB
#undef PG8_STAGE
#undef PG8_LDA
#undef PG8_LDB
#undef PG8_MMA
#undef PG8_WAIT_V
#undef PG8_WAIT_L
#undef PG8_BAR
#undef PG8_SCHED
}
}

typedef unsigned short bf16_t;
typedef short bf16x8 __attribute__((ext_vector_type(8)));
typedef float f32x4 __attribute__((ext_vector_type(4)));
typedef float f32x2 __attribute__((ext_vector_type(2)));
typedef unsigned u32x4 __attribute__((ext_vector_type(4)));
typedef unsigned u32x2 __attribute__((ext_vector_type(2)));

constexpr int D = 1024, NB = 4, T = 4096, NL = 4, BT = NB * T, BW = 512;
constexpr int DIN = 8320, DINP = 8448;
constexpr int C_PU = 0, C_PG = 512, C_Q = 1024, C_K = 1536, C_V = 2048, C_RG = 2560, C_RW = 3072, C_RWG = 4736, C_GATE = 5248;
constexpr int RW_R = 0, RW_WL = 512, RW_K = 576, RW_V = 1088, RW_AL = 1600, RW_W = 1664;
constexpr int SREC = 896;
constexpr int LDS_MAIN = 147456, LDS_BYTES = LDS_MAIN + 64;

constexpr size_t SZ_WIN = (size_t)DINP * D * 2, SZ_WBR = (size_t)3 * D * BW * 2, SZ_WOUT = (size_t)D * D * 2, SZ_LORA = (size_t)BW * 64 * 2;
constexpr size_t OFF_WIN = 0, OFF_WBR = OFF_WIN + SZ_WIN, OFF_WOUT = OFF_WBR + SZ_WBR, OFF_W2T = OFF_WOUT + SZ_WOUT, OFF_A2T = OFF_W2T + SZ_LORA;
constexpr size_t IMG_STRIDE = OFF_A2T + SZ_LORA;
constexpr size_t OFF_MOD = 2 * IMG_STRIDE, SZ_MOD = (size_t)NL * NB * 3 * D * 4;
constexpr size_t OFF_COS = OFF_MOD + SZ_MOD, SZ_TAB = (size_t)BT * 64 * 4, OFF_SIN = OFF_COS + SZ_TAB;
constexpr size_t OFF_BONUS = OFF_SIN + SZ_TAB, SZ_BONUS = (size_t)BT * 8 * 4;
constexpr size_t OFF_PROJ = OFF_BONUS + SZ_BONUS, SZ_PROJ = (size_t)BT * DINP * 2;
constexpr size_t OFF_BR = OFF_PROJ + SZ_PROJ, SZ_BR = (size_t)3 * BT * BW * 2;
constexpr size_t OFF_X = OFF_BR + SZ_BR;
constexpr size_t OFF_H = OFF_X;
constexpr size_t OFF_STREAM = OFF_X, SZ_STREAM = (size_t)BT * 8 * SREC;
constexpr size_t OFF_KVT = OFF_BR + SZ_BR / 3, SZ_KVT = (size_t)16 * 32 * 128 * 128 * 4;
constexpr size_t OFF_RPREV = OFF_STREAM + SZ_STREAM, SZ_RPREV = SZ_KVT / 2;
constexpr size_t OFF_MERGED = OFF_X, SZ_MERGED = (size_t)BT * D * 4;
constexpr size_t OFF_MERGEDB = OFF_MERGED + SZ_MERGED;
constexpr size_t OFF_H0F = OFF_RPREV + SZ_RPREV, SZ_H0F = (size_t)NB * D * 4;
constexpr int P0W = 2304;
constexpr size_t OFF_P0F = OFF_H0F + SZ_H0F, SZ_P0F = (size_t)NB * P0W * 4;
constexpr size_t OFF_CACC = OFF_P0F + SZ_P0F, SZ_CACC = 256;
constexpr size_t OFF_SACC = OFF_CACC + 128;
constexpr size_t OFF_BAR = OFF_CACC + SZ_CACC, SZ_BAR = (size_t)XCD_BAR_WORDS * 4;
constexpr size_t WS_NEED = OFF_BAR + SZ_BAR;

struct Params {
    const float* x; const float* c; const int* pos;
    const float *norm_g, *w_ada, *b_ada, *w_in, *pool_w, *pool_scale, *ret_norm_g, *shift_mu, *w0, *w2, *a0, *a2, *k_k, *k_a, *r_k, *ln_w, *ln_b, *w_branch, *w_out, *final_g;
    float* out; unsigned char* ws; size_t img_off;
};

__device__ __forceinline__ float bf2f(unsigned v) { return __uint_as_float(v << 16); }
__device__ __forceinline__ float bflo(unsigned v) { return __uint_as_float(v << 16); }
__device__ __forceinline__ float bfhi(unsigned v) { return __uint_as_float(v & 0xffff0000u); }
__device__ __forceinline__ unsigned pk2(float lo, float hi) { return pg8::cvt_pk_bf16(lo, hi); }
__device__ __forceinline__ bf16_t f2bf(float f) { return (bf16_t)(pk2(f, 0.f) & 0xffffu); }
__device__ __forceinline__ float sigmoidf_(float x) { return __builtin_amdgcn_rcpf(1.0f + __expf(-x)); }
__device__ __forceinline__ float siluf_(float x) { return x / (1.0f + __expf(-x)); }

__device__ __forceinline__ void unpack8(const u32x4 a, float (&o)[8]) { o[0] = bflo(a.x); o[1] = bfhi(a.x); o[2] = bflo(a.y); o[3] = bfhi(a.y); o[4] = bflo(a.z); o[5] = bfhi(a.z); o[6] = bflo(a.w); o[7] = bfhi(a.w); }
__device__ __forceinline__ u32x4 pack8(const float (&o)[8]) { u32x4 w; w.x = pk2(o[0], o[1]); w.y = pk2(o[2], o[3]); w.z = pk2(o[4], o[5]); w.w = pk2(o[6], o[7]); return w; }
__device__ __forceinline__ void ldf8(const float* p, float (&o)[8]) { const f32x4 a = *(const f32x4*)p, b = *(const f32x4*)(p + 4); o[0] = a[0]; o[1] = a[1]; o[2] = a[2]; o[3] = a[3]; o[4] = b[0]; o[5] = b[1]; o[6] = b[2]; o[7] = b[3]; }
template <int CTRL> __device__ __forceinline__ float dpp_mov(float v) { return __int_as_float(__builtin_amdgcn_update_dpp(0, __float_as_int(v), CTRL, 0xF, 0xF, false)); }
__device__ __forceinline__ float red16(float v) {
    v += dpp_mov<0xB1>(v);
    v += dpp_mov<0x4E>(v);
    v += dpp_mov<0x141>(v);
    v += dpp_mov<0x140>(v);
    return v;
}
__device__ __forceinline__ float red64(float v) {
    v = red16(v);
    v += __shfl_xor(v, 16); v += __shfl_xor(v, 32);
    return v;
}

constexpr int LDS_LD = 136;
__device__ __forceinline__ void strip_mma(const LAS bf16_t* A, int row0, const LAS bf16_t* Bm, f32x4 (&acc)[8], int fr, int fq) {
#pragma unroll
    for (int kk = 0; kk < 4; ++kk) {
        const bf16x8 a = *(const LAS bf16x8*)(A + (row0 + fr) * LDS_LD + kk * 32 + fq * 8);
#pragma unroll
        for (int n = 0; n < 8; ++n) {
            const bf16x8 b = *(const LAS bf16x8*)(Bm + (n * 16 + fr) * LDS_LD + kk * 32 + fq * 8);
            acc[n] = __builtin_amdgcn_mfma_f32_16x16x32_bf16(a, b, acc[n], 0, 0, 0);
        }
    }
}

struct EpiProj {
    static constexpr bool PERM = true, AFTER_DRAIN = false;
    bf16_t* O;
    __device__ __forceinline__ void operator()(const f32x4 (&acc)[2][2][4][2], const pg8::Unit& u, int wr, int wc, int fr, int fq) const {
        const int row0 = u.pm * 256 + wr * 64 + fr, col0 = u.pn * 256 + wc * 32 + 8 * fq;
#pragma unroll
        for (int ai = 0; ai < 2; ++ai)
#pragma unroll
            for (int m = 0; m < 4; ++m) { bf16_t* rowp = O + (size_t)(row0 + ai * 128 + m * 16) * DINP + col0;
#pragma unroll
                for (int bj = 0; bj < 2; ++bj) { const f32x4 v0 = acc[ai][bj][m][0], v1 = acc[ai][bj][m][1];
                    u32x4 w; w.x = pk2(v0[0], v0[1]); w.y = pk2(v0[2], v0[3]); w.z = pk2(v1[0], v1[1]); w.w = pk2(v1[2], v1[3]);
                    *(u32x4*)(rowp + bj * 128) = w; } }
    }
};
template <int NBR> struct EpiMerge {
    static constexpr bool PERM = true, AFTER_DRAIN = false;
    const bf16_t* proj; float* merged; bf16_t* mergedb;
    __device__ __forceinline__ void operator()(const f32x4 (&acc)[2][2][4][2], const pg8::Unit& u, int wr, int wc, int fr, int fq) const {
        const int row0 = u.pm * 256 + wr * 64 + fr, col0 = u.pn * 256 + wc * 32 + 8 * fq;
#pragma unroll
        for (int ai = 0; ai < 2; ++ai)
#pragma unroll
            for (int m = 0; m < 4; ++m) {
                const size_t row = (size_t)(row0 + ai * 128 + m * 16);
#pragma unroll
                for (int bj = 0; bj < 2; ++bj) {
                    const int col = col0 + bj * 128;
                    const u32x4 lg = *(const u32x4*)(proj + row * DINP + C_GATE + NBR * D + col);
                    const f32x4 v0 = acc[ai][bj][m][0], v1 = acc[ai][bj][m][1];
                    f32x4 o0, o1;
                    o0[0] = sigmoidf_(bflo(lg.x)) * v0[0]; o0[1] = sigmoidf_(bfhi(lg.x)) * v0[1]; o0[2] = sigmoidf_(bflo(lg.y)) * v0[2]; o0[3] = sigmoidf_(bfhi(lg.y)) * v0[3];
                    o1[0] = sigmoidf_(bflo(lg.z)) * v1[0]; o1[1] = sigmoidf_(bfhi(lg.z)) * v1[1]; o1[2] = sigmoidf_(bflo(lg.w)) * v1[2]; o1[3] = sigmoidf_(bfhi(lg.w)) * v1[3];
                    float* mp = merged + row * D + col;
                    if (NBR > 0) { o0 += *(const f32x4*)mp; o1 += *(const f32x4*)(mp + 4); }
                    if (NBR < 2) { *(f32x4*)mp = o0; *(f32x4*)(mp + 4) = o1; }
                    else { u32x4 w; w.x = pk2(o0[0], o0[1]); w.y = pk2(o0[2], o0[3]); w.z = pk2(o1[0], o1[1]); w.w = pk2(o1[2], o1[3]); *(u32x4*)(mergedb + row * D + col) = w; }
                }
            }
    }
};

struct MergeOrder {
    pg8::StaticOrder base;
    __device__ __forceinline__ bool next(int i, pg8::Unit& u) const { const int r = i / 3, n = i - 3 * r; pg8::Unit t; if (!base.next(r, t)) return false; u.pm = n * 64 + t.pm; u.pn = n * 4 + t.pn; return true; }
    __device__ __forceinline__ void a_ready(const pg8::Unit&) const {}
    __device__ __forceinline__ void done(const pg8::Unit&) const {}
};
struct EpiMergeAll {
    static constexpr bool PERM = true, AFTER_DRAIN = false;
    const bf16_t* proj; float* merged; bf16_t* mergedb;
    __device__ __forceinline__ void operator()(const f32x4 (&acc)[2][2][4][2], const pg8::Unit& u, int wr, int wc, int fr, int fq) const {
        const int n = u.pm >> 6; pg8::Unit t; t.pm = u.pm & 63; t.pn = u.pn & 3;
        if (n == 0) { EpiMerge<0> e{proj, merged, mergedb}; e(acc, t, wr, wc, fr, fq); }
        else if (n == 1) { EpiMerge<1> e{proj, merged, mergedb}; e(acc, t, wr, wc, fr, fq); }
        else { EpiMerge<2> e{proj, merged, mergedb}; e(acc, t, wr, wc, fr, fq); }
    }
};
struct EpiOut {
    static constexpr bool PERM = false, AFTER_DRAIN = false;
    const float* xin; float* xout; const float* gate;
    __device__ __forceinline__ void operator()(const f32x4 (&acc)[2][2][4][2], const pg8::Unit& u, int wr, int wc, int fr, int fq) const {
        const int row0 = u.pm * 256 + wr * 64 + fr, col0 = u.pn * 256 + wc * 32 + 4 * fq;
        const float* gp = gate + (size_t)(u.pm >> 4) * 3 * D + col0;
        f32x4 gv[2][2];
#pragma unroll
        for (int bj = 0; bj < 2; ++bj)
#pragma unroll
            for (int n = 0; n < 2; ++n) gv[bj][n] = *(const f32x4*)(gp + bj * 128 + n * 16);
#pragma unroll
        for (int ai = 0; ai < 2; ++ai)
#pragma unroll
            for (int m = 0; m < 4; ++m) {
                const size_t ro = (size_t)(row0 + ai * 128 + m * 16) * D + col0;
#pragma unroll
                for (int bj = 0; bj < 2; ++bj)
#pragma unroll
                    for (int n = 0; n < 2; ++n) {
                        const f32x4 xi = *(const f32x4*)(xin + ro + bj * 128 + n * 16);
                        *(f32x4*)(xout + ro + bj * 128 + n * 16) = xi + gv[bj][n] * acc[ai][bj][m][n];
                    }
            }
    }
};

__device__ __forceinline__ void phase0(const Params& p, unsigned char* shm) {
    const int tid = tid_(), wid = tid >> 6, lane = tid & 63;
    const int gtid = blockIdx.x * 512 + tid, nth = gridDim.x * 512;
    { const int nz = (DINP - DIN) * D * 2 / 16;
      for (int st_ = 0; st_ < 2; ++st_) { u32x4* z = (u32x4*)(p.ws + st_ * IMG_STRIDE + OFF_WIN + (size_t)DIN * D * 2);
        for (int i = gtid; i < nz; i += nth) z[i] = (u32x4){0u, 0u, 0u, 0u}; } }
    { float* COS = (float*)(p.ws + OFF_COS); float* SIN = (float*)(p.ws + OFF_SIN);
      for (int idx = gtid; idx < BT * 64; idx += nth) {
          const int i = idx & 63, tok = idx >> 6;
          double f = 1.0; for (int j = 0; j < i; ++j) f *= 0.8659643233600653;
          const float freq = (float)f;
          const float ang = (float)p.pos[tok] * freq;
          const double ad = (double)ang;
          const double nq = rint(ad * 0.6366197723675814);
          double r = fma(-nq, 1.5707963267948966, ad); r = fma(-nq, 6.123233995736766e-17, r);
          const float rf = (float)r; const float sr = sinf(rf), cr = cosf(rf);
          const int q = ((int)nq) & 3;
          float s, c;
          if (q == 0) { s = sr; c = cr; } else if (q == 1) { s = cr; c = -sr; } else if (q == 2) { s = -sr; c = -cr; } else { s = -cr; c = sr; }
          COS[idx] = c; SIN[idx] = s;
      } }
    float* cs = (float*)shm;
    float* red = cs + 4096;
    for (int i = tid; i < 4096; i += 512) { const int b = i >> 10, k = i & 1023; cs[k * 4 + b] = siluf_(p.c[b * 1024 + k]); }
    __syncthreads();
    float* mod = (float*)(p.ws + OFF_MOD);
    for (int item = blockIdx.x; item < NL * 48; item += gridDim.x) {
        const int l = item / 48, cgp = item % 48, col = cgp * 64 + lane;
        const float* wp = p.w_ada + (size_t)l * D * 3 * D + col;
        const int k0 = wid * 128;
        float a0 = 0.f, a1 = 0.f, a2 = 0.f, a3 = 0.f;
#pragma unroll 32
        for (int k = k0; k < k0 + 128; ++k) { const float w = wp[(size_t)k * 3 * D]; const f32x4 c4 = *(const f32x4*)(cs + k * 4); a0 += w * c4[0]; a1 += w * c4[1]; a2 += w * c4[2]; a3 += w * c4[3]; }
        red[(wid * 4 + 0) * 64 + lane] = a0; red[(wid * 4 + 1) * 64 + lane] = a1; red[(wid * 4 + 2) * 64 + lane] = a2; red[(wid * 4 + 3) * 64 + lane] = a3;
        __syncthreads();
        if (tid < 256) { const int b = tid >> 6; float s = 0.f;
#pragma unroll
            for (int w = 0; w < 8; ++w) s += red[(w * 4 + b) * 64 + lane];
            mod[(size_t)(l * NB + b) * 3 * D + col] = s + p.b_ada[l * 3 * D + col]; }
        __syncthreads();
    }
}

__device__ __forceinline__ void tconv64(const float* src, int ld_src, bf16_t* dst, int ld_dst, int r0, int c0, float* tile) {
    const int tid = tid_();
    { const int r = tid >> 3, cc = (tid & 7) * 8; const float* sp = src + (size_t)(r0 + r) * ld_src + c0 + cc;
      const f32x4 v0 = *(const f32x4*)sp, v1 = *(const f32x4*)(sp + 4); float* tp = tile + r * 65 + cc;
      tp[0] = v0[0]; tp[1] = v0[1]; tp[2] = v0[2]; tp[3] = v0[3]; tp[4] = v1[0]; tp[5] = v1[1]; tp[6] = v1[2]; tp[7] = v1[3]; }
    __syncthreads();
    { const int c = tid >> 3, rc = (tid & 7) * 8; const float* tp = tile + rc * 65 + c;
      u32x4 w; w.x = pk2(tp[0], tp[65]); w.y = pk2(tp[130], tp[195]); w.z = pk2(tp[260], tp[325]); w.w = pk2(tp[390], tp[455]);
      *(u32x4*)(dst + (size_t)(c0 + c) * ld_dst + r0 + rc) = w; }
    __syncthreads();
}
__device__ __forceinline__ void poolfold64(const float* w_in_l, const float* pool_w_l, bf16_t* dst, int k0, int n0, float* lds) {
    const int tid = tid_(), g = n0 >> 7, nb = n0 & 127;
    float* Ain = lds;
    float* Pw = lds + 64 * 129;
    for (int i = tid; i < 64 * 32; i += 512) { const int r = i >> 5, c4 = (i & 31) * 4; const f32x4 v = *(const f32x4*)(w_in_l + (size_t)(k0 + r) * DIN + g * 128 + c4);
        float* tp = Ain + r * 129 + c4; tp[0] = v[0]; tp[1] = v[1]; tp[2] = v[2]; tp[3] = v[3]; }
    for (int i = tid; i < 128 * 16; i += 512) { const int c = i >> 4, n4 = (i & 15) * 4; const f32x4 v = *(const f32x4*)(pool_w_l + (size_t)(g * 128 + c) * 128 + nb + n4);
        float* tp = Pw + c * 65 + n4; tp[0] = v[0]; tp[1] = v[1]; tp[2] = v[2]; tp[3] = v[3]; }
    __syncthreads();
    { const int nn = tid >> 3, rc = (tid & 7) * 8; float acc[8];
#pragma unroll
      for (int i = 0; i < 8; ++i) acc[i] = 0.f;
      for (int c = 0; c < 128; ++c) { const float pw = Pw[c * 65 + nn];
#pragma unroll
          for (int i = 0; i < 8; ++i) acc[i] += Ain[(rc + i) * 129 + c] * pw; }
      u32x4 w; w.x = pk2(acc[0], acc[1]); w.y = pk2(acc[2], acc[3]); w.z = pk2(acc[4], acc[5]); w.w = pk2(acc[6], acc[7]);
      *(u32x4*)(dst + (size_t)(n0 + nn) * D + k0 + rc) = w; }
    __syncthreads();
}
__device__ __forceinline__ void phase_weights(const Params& p, int l, unsigned char* shm, int job0, int jstride) {
    float* tile = (float*)shm;
    unsigned char* img = p.ws + p.img_off;
    bf16_t* Wt_in = (bf16_t*)(img + OFF_WIN); bf16_t* Wt_br = (bf16_t*)(img + OFF_WBR); bf16_t* Wt_out = (bf16_t*)(img + OFF_WOUT);
    bf16_t* W2T = (bf16_t*)(img + OFF_W2T); bf16_t* A2T = (bf16_t*)(img + OFF_A2T);
    const float* w_in_l = p.w_in + (size_t)l * D * DIN;
    constexpr int J_IN = 16 * 130, J_BR = 3 * 8 * 16, J_OUT = 16 * 16, J_LORA = 16;
    constexpr int NJ = J_IN + J_BR + J_OUT + J_LORA;
    for (int job = job0; job < NJ; job += jstride) {
        int j = job;
        if (j < J_IN) { const int kt = j & 15, nt = j >> 4;
            if (nt < 8) poolfold64(w_in_l, p.pool_w + (size_t)l * 4 * 128 * 128, Wt_in, kt * 64, nt * 64, tile);
            else tconv64(w_in_l, DIN, Wt_in, D, kt * 64, nt * 64, tile);
            continue; }
        j -= J_IN;
        if (j < J_BR) { const int nb = j / 128, r = j % 128, wt = r & 7, dt = r >> 3;
            tconv64(p.w_branch + ((size_t)l * 3 + nb) * BW * D, D, Wt_br + (size_t)nb * D * BW, BW, wt * 64, dt * 64, tile); continue; }
        j -= J_BR;
        if (j < J_OUT) { const int kt = j & 15, dt = j >> 4; tconv64(p.w_out + (size_t)l * D * D, D, Wt_out, D, kt * 64, dt * 64, tile); continue; }
        j -= J_OUT;
        if (j < 8) tconv64(p.w2 + (size_t)l * 64 * BW, BW, W2T, 64, 0, j * 64, tile);
        else tconv64(p.a2 + (size_t)l * 64 * BW, BW, A2T, 64, 0, (j - 8) * 64, tile);
    }
}
__device__ __forceinline__ void phase_norm(const Params& p, int l, const float* xin) {
    const int tid = tid_(), wid = tid >> 6, lane = tid & 63;
    bf16_t* h = (bf16_t*)(p.ws + OFF_H);
    const float* mod = (const float*)(p.ws + OFF_MOD) + (size_t)l * NB * 3 * D;
    const float* g = p.norm_g + l * D;
    { float* z = (float*)(p.ws + OFF_P0F); const int g_ = blockIdx.x * 512 + tid; if (g_ < NB * P0W) z[g_] = 0.f; }
    for (int row = blockIdx.x * 8 + wid; row < BT; row += gridDim.x * 8) {
        const int b = row >> 12;
        const float* xp = xin + (size_t)row * D;
        f32x4 v[4]; float ss = 0.f;
#pragma unroll
        for (int j = 0; j < 2; ++j) { v[2 * j] = *(const f32x4*)(xp + j * 512 + lane * 8); v[2 * j + 1] = *(const f32x4*)(xp + j * 512 + lane * 8 + 4); }
#pragma unroll
        for (int j = 0; j < 4; ++j) ss += v[j][0] * v[j][0] + v[j][1] * v[j][1] + v[j][2] * v[j][2] + v[j][3] * v[j][3];
        ss = red64(ss);
        const float rstd = rsqrtf(ss * (1.0f / D) + 1e-6f);
        const float* sh = mod + (size_t)b * 3 * D; const float* sc = sh + D;
#pragma unroll
        for (int j = 0; j < 2; ++j) {
            const int c0 = j * 512 + lane * 8; float o[8];
#pragma unroll
            for (int i = 0; i < 8; ++i) { const float xv = v[2 * j + (i >> 2)][i & 3]; o[i] = xv * rstd * g[c0 + i] * (1.0f + sc[c0 + i]) + sh[c0 + i]; }
            u32x4 w; w.x = pk2(o[0], o[1]); w.y = pk2(o[2], o[3]); w.z = pk2(o[4], o[5]); w.w = pk2(o[6], o[7]);
            *(u32x4*)(h + (size_t)row * D + c0) = w;
            if ((row & (T - 1)) == 0) { float* hf = (float*)(p.ws + OFF_H0F) + (size_t)b * D + c0;
                *(f32x4*)hf = (f32x4){o[0], o[1], o[2], o[3]}; *(f32x4*)(hf + 4) = (f32x4){o[4], o[5], o[6], o[7]}; }
        }
    }
}
__device__ __forceinline__ void gemv0_item(const Params& p, int l, int item, unsigned char* shm) {
    const int tid = tid_(), wid = tid >> 6, lane = tid & 63, cg_ = item >> 3, kc = item & 7;
    float* red = (float*)shm;
    const float* h0 = (const float*)(p.ws + OFF_H0F);
    const int src = cg_ < 8 ? C_RW + RW_R + 64 * cg_ : cg_ < 16 ? C_RW + RW_K + 64 * (cg_ - 8) : cg_ == 16 ? C_RW + RW_AL : cg_ < 25 ? C_Q + 64 * (cg_ - 17) : C_K + 64 * (cg_ - 25);
    const int dst = cg_ < 8 ? 64 * cg_ : cg_ < 16 ? 512 + 64 * (cg_ - 8) : cg_ == 16 ? 1024 : 1152 + 64 * (cg_ - 17);
    const int k0 = kc * 128 + wid * 16;
    const float* wp = p.w_in + (size_t)l * D * DIN + (size_t)k0 * DIN + src + lane;
    float w[16];
#pragma unroll
    for (int i = 0; i < 16; ++i) w[i] = wp[(size_t)i * DIN];
    float a0 = 0.f, a1 = 0.f, a2 = 0.f, a3 = 0.f;
#pragma unroll
    for (int i = 0; i < 16; ++i) { a0 += w[i] * h0[k0 + i]; a1 += w[i] * h0[D + k0 + i]; a2 += w[i] * h0[2 * D + k0 + i]; a3 += w[i] * h0[3 * D + k0 + i]; }
    red[(wid * 4 + 0) * 64 + lane] = a0; red[(wid * 4 + 1) * 64 + lane] = a1; red[(wid * 4 + 2) * 64 + lane] = a2; red[(wid * 4 + 3) * 64 + lane] = a3;
    __syncthreads();
    if (tid < 256) { const int b = tid >> 6; float sm = 0.f;
#pragma unroll
        for (int w_ = 0; w_ < 8; ++w_) sm += red[(w_ * 4 + b) * 64 + lane];
        atomicAdd((float*)(p.ws + OFF_P0F) + (size_t)b * P0W + dst + lane, sm); }
    __syncthreads();
}

__device__ __forceinline__ void phase_final_norm(const Params& p) {
    const int tid = tid_(), wid = tid >> 6, lane = tid & 63;
    for (int row = blockIdx.x * 8 + wid; row < BT; row += gridDim.x * 8) {
        float* xp = p.out + (size_t)row * D;
        f32x4 v[4]; float ss = 0.f;
#pragma unroll
        for (int j = 0; j < 4; ++j) v[j] = *(const f32x4*)(xp + j * 256 + lane * 4);
#pragma unroll
        for (int j = 0; j < 4; ++j) ss += v[j][0] * v[j][0] + v[j][1] * v[j][1] + v[j][2] * v[j][2] + v[j][3] * v[j][3];
        ss = red64(ss);
        const float rstd = rsqrtf(ss * (1.0f / D) + 1e-6f);
#pragma unroll
        for (int j = 0; j < 4; ++j) { const f32x4 gg = *(const f32x4*)(p.final_g + j * 256 + lane * 4); *(f32x4*)(xp + j * 256 + lane * 4) = v[j] * rstd * gg; }
    }
}

__device__ __forceinline__ void pool_item(const Params& p, int l, int item) {
    const int tid = tid_(), cv = tid & 63, tl = tid >> 6, c0 = cv * 8, g = c0 >> 7, win = 2 << g;
    const bf16_t* proj = (const bf16_t*)(p.ws + OFF_PROJ);
    bf16_t* br0 = (bf16_t*)(p.ws + OFF_BR);
    float sc[8]; ldf8(p.pool_scale + l * BW + c0, sc);
    const int tokA = item * 64 + tl * 8, tposA = tokA & (T - 1);
    u32x4 rows[23];
#pragma unroll
    for (int i = 0; i < 23; ++i) {
        const int d = i - 15;
        const bool ok = (tposA + d >= 0) && (d > -win);
        rows[i] = ok ? *(const u32x4*)(proj + (size_t)(tokA + d) * DINP + C_PU + c0) : (u32x4){0u, 0u, 0u, 0u};
    }
    u32x4 gts[8];
#pragma unroll
    for (int tt = 0; tt < 8; ++tt) gts[tt] = *(const u32x4*)(proj + (size_t)(tokA + tt) * DINP + C_PG + c0);
#pragma unroll
    for (int tt = 0; tt < 8; ++tt) {
        const int tpos = tposA + tt, cnt = min(tpos + 1, win);
        float s[8];
#pragma unroll
        for (int i = 0; i < 8; ++i) s[i] = 0.f;
#pragma unroll
        for (int j = 0; j < 16; ++j) {
            if (j < win) { float u[8]; unpack8(rows[15 + tt - j], u);
#pragma unroll
                for (int i = 0; i < 8; ++i) s[i] += u[i]; }
        }
        const float inv = 1.0f / (float)cnt;
        float uu[8], gg[8], o[8]; unpack8(rows[15 + tt], uu); unpack8(gts[tt], gg);
#pragma unroll
        for (int i = 0; i < 8; ++i) o[i] = (s[i] * inv - uu[i]) * sc[i] * siluf_(gg[i]);
        *(u32x4*)(br0 + (size_t)(tokA + tt) * BW + c0) = pack8(o);
    }
}

__device__ __forceinline__ float ret_lg(int h) { return h == 0 ? -0.04580368961312479f : h == 1 ? -0.02272007650008353f : h == 2 ? -0.011315313227834146f : -0.005646563141142063f; }

struct RotCS { f32x4 c0, c1, s0, s1; };
__device__ __forceinline__ void fetch_cs(const Params& p, RotCS (&cs)[2], int tid, int tok0) {
    const float* COS = (const float*)(p.ws + OFF_COS); const float* SIN = (const float*)(p.ws + OFF_SIN);
#pragma unroll
    for (int it = 0; it < 2; ++it) { const int u = tid + it * 512, j = u >> 3, d0 = (u & 7) * 8;
        const float* cp = COS + (size_t)(tok0 + j) * 64 + d0; const float* sn = SIN + (size_t)(tok0 + j) * 64 + d0;
        cs[it].c0 = *(const f32x4*)cp; cs[it].c1 = *(const f32x4*)(cp + 4); cs[it].s0 = *(const f32x4*)sn; cs[it].s1 = *(const f32x4*)(sn + 4); }
}
__device__ __forceinline__ void fetch_qk(const Params& p, u32x4 (&ra)[2], u32x4 (&rb)[2], int tid, int tok0, int col) {
    const bf16_t* proj = (const bf16_t*)(p.ws + OFF_PROJ);
#pragma unroll
    for (int it = 0; it < 2; ++it) { const int u = tid + it * 512, j = u >> 3, d0 = (u & 7) * 8;
        const bf16_t* sp = proj + (size_t)(tok0 + j) * DINP + col + d0; ra[it] = *(const u32x4*)sp; rb[it] = *(const u32x4*)(sp + 64); }
}
template <bool TRANS> __device__ __forceinline__ void store_rot(LAS bf16_t* dst, const u32x4 (&ra)[2], const u32x4 (&rb)[2], const RotCS (&cs)[2], int tid, float scale, float lgt) {
#pragma unroll
    for (int it = 0; it < 2; ++it) {
        const int u = tid + it * 512, j = u >> 3, d0 = (u & 7) * 8;
        float x1[8], x2[8]; unpack8(ra[it], x1); unpack8(rb[it], x2);
        const float cc[8] = {cs[it].c0[0], cs[it].c0[1], cs[it].c0[2], cs[it].c0[3], cs[it].c1[0], cs[it].c1[1], cs[it].c1[2], cs[it].c1[3]};
        const float ss[8] = {cs[it].s0[0], cs[it].s0[1], cs[it].s0[2], cs[it].s0[3], cs[it].s1[0], cs[it].s1[1], cs[it].s1[2], cs[it].s1[3]};
        const float sc = (lgt != 0.f) ? scale * exp2f(lgt * (float)(127 - j)) : scale;
        float o1[8], o2[8];
#pragma unroll
        for (int i = 0; i < 8; ++i) { o1[i] = (x1[i] * cc[i] - x2[i] * ss[i]) * sc; o2[i] = (x1[i] * ss[i] + x2[i] * cc[i]) * sc; }
        if (TRANS) {
#pragma unroll
            for (int i = 0; i < 8; ++i) { dst[(d0 + i) * LDS_LD + j] = f2bf(o1[i]); dst[(d0 + 64 + i) * LDS_LD + j] = f2bf(o2[i]); }
        } else {
            *(LAS u32x4*)(dst + j * LDS_LD + d0) = pack8(o1); *(LAS u32x4*)(dst + j * LDS_LD + d0 + 64) = pack8(o2);
        }
    }
}
__device__ __forceinline__ void fetch_v(const Params& p, u32x4 (&rv)[4], int tid, int tok0, int col) {
    const bf16_t* proj = (const bf16_t*)(p.ws + OFF_PROJ);
#pragma unroll
    for (int it = 0; it < 4; ++it) { const int u = tid + it * 512, j = u >> 4, e0 = (u & 15) * 8; rv[it] = *(const u32x4*)(proj + (size_t)(tok0 + j) * DINP + col + e0); }
}
__device__ __forceinline__ void store_vT(LAS bf16_t* dst, const u32x4 (&rv)[4], int tid) {
#pragma unroll
    for (int it = 0; it < 4; ++it) {
        const int u = tid + it * 512, j = u >> 4, e0 = (u & 15) * 8; const u32x4 a = rv[it];
        dst[(e0 + 0) * LDS_LD + j] = (bf16_t)(a.x & 0xffffu); dst[(e0 + 1) * LDS_LD + j] = (bf16_t)(a.x >> 16);
        dst[(e0 + 2) * LDS_LD + j] = (bf16_t)(a.y & 0xffffu); dst[(e0 + 3) * LDS_LD + j] = (bf16_t)(a.y >> 16);
        dst[(e0 + 4) * LDS_LD + j] = (bf16_t)(a.z & 0xffffu); dst[(e0 + 5) * LDS_LD + j] = (bf16_t)(a.z >> 16);
        dst[(e0 + 6) * LDS_LD + j] = (bf16_t)(a.w & 0xffffu); dst[(e0 + 7) * LDS_LD + j] = (bf16_t)(a.w >> 16);
    }
}

__device__ __forceinline__ void ret_r1_item(const Params& p, int item, LAS bf16_t* lds) {
    const int tid = tid_(), wid = tid >> 6, lane = tid & 63, fr = lane & 15, fq = lane >> 4;
    const int n = item & 31, bh = item >> 5, h = bh & 3, b = bh >> 2, tok0 = b * T + n * 128;
    LAS bf16_t* KT = lds; LAS bf16_t* VT = lds + 128 * LDS_LD;
    { RotCS cs[2]; u32x4 ka[2], kb[2], rv[4];
      fetch_qk(p, ka, kb, tid, tok0, C_K + h * 128); fetch_cs(p, cs, tid, tok0); fetch_v(p, rv, tid, tok0, C_V + h * 128);
      store_rot<true>(KT, ka, kb, cs, tid, 0.08838834764831845f, ret_lg(h));
      store_vT(VT, rv, tid); }
    __syncthreads();
    f32x4 acc[8];
#pragma unroll
    for (int i = 0; i < 8; ++i) acc[i] = (f32x4){0.f, 0.f, 0.f, 0.f};
    strip_mma(VT, wid * 16, KT, acc, fr, fq);
    float* kvT = (float*)(p.ws + OFF_KVT) + ((size_t)item << 14);
#pragma unroll
    for (int nn = 0; nn < 8; ++nn)
#pragma unroll
        for (int jj = 0; jj < 4; ++jj) kvT[(wid * 16 + fq * 4 + jj) * 128 + nn * 16 + fr] = acc[nn][jj];
    __syncthreads();
}

constexpr int PREP_LD = 516;
__device__ __forceinline__ float red8(float v) {
    v += dpp_mov<0xB1>(v); v += dpp_mov<0x4E>(v); v += dpp_mov<0x141>(v);
    return v;
}
__device__ __forceinline__ void rwkv_prep_item(const Params& p, int l, int item, LAS bf16_t* lds) {
    const int tid = tid_(), wid = tid >> 6, lane = tid & 63, fr = lane & 15, fq = lane >> 4;
    const bf16_t* proj = (const bf16_t*)(p.ws + OFF_PROJ);
    const int tok0 = item * 32;
    LAS bf16_t* Aw = lds;
    LAS bf16_t* Aa = lds + 32 * 72;
    LAS float* LW = (LAS float*)(lds + 2 * 32 * 72);
    LAS float* LA = LW + 32 * PREP_LD;
    const float* mu = p.shift_mu + l * RW_W;
#pragma unroll
    for (int hh = 0; hh < 2; ++hh) {
        const int tt = (tid >> 5) + hh * 16, cc = (tid & 31) * 4, tok = tok0 + tt;
        const int ch = cc < 64 ? RW_WL + cc : RW_AL + (cc - 64);
        const u32x2 cu = *(const u32x2*)(proj + (size_t)tok * DINP + C_RW + ch);
        u32x2 pu = (u32x2){0u, 0u};
        if ((tok & (T - 1)) != 0) pu = *(const u32x2*)(proj + (size_t)(tok - 1) * DINP + C_RW + ch);
        const float xc[4] = {bflo(cu.x), bfhi(cu.x), bflo(cu.y), bfhi(cu.y)}, xp[4] = {bflo(pu.x), bfhi(pu.x), bflo(pu.y), bfhi(pu.y)};
        float o[4];
#pragma unroll
        for (int i = 0; i < 4; ++i) { o[i] = xc[i] + (xp[i] - xc[i]) * mu[ch + i]; if (cc < 64) o[i] = tanhf(o[i]); }
        LAS bf16_t* dp = (cc < 64 ? Aw + tt * 72 + cc : Aa + tt * 72 + (cc - 64));
        u32x2 w; w.x = pk2(o[0], o[1]); w.y = pk2(o[2], o[3]); *(LAS u32x2*)dp = w;
    }
    __syncthreads();
    {
        const bf16_t* W2T = (const bf16_t*)(p.ws + p.img_off + OFF_W2T); const bf16_t* A2T = (const bf16_t*)(p.ws + p.img_off + OFF_A2T);
        f32x4 lw[2][4], la[2][4];
#pragma unroll
        for (int mt = 0; mt < 2; ++mt)
#pragma unroll
            for (int n = 0; n < 4; ++n) { lw[mt][n] = (f32x4){0.f, 0.f, 0.f, 0.f}; la[mt][n] = (f32x4){0.f, 0.f, 0.f, 0.f}; }
#pragma unroll
        for (int kk = 0; kk < 2; ++kk) {
            bf16x8 aw[2], aa[2];
#pragma unroll
            for (int mt = 0; mt < 2; ++mt) { aw[mt] = *(const LAS bf16x8*)(Aw + (mt * 16 + fr) * 72 + kk * 32 + fq * 8); aa[mt] = *(const LAS bf16x8*)(Aa + (mt * 16 + fr) * 72 + kk * 32 + fq * 8); }
#pragma unroll
            for (int n = 0; n < 4; ++n) {
                const int chn = wid * 64 + n * 16 + fr;
                const bf16x8 bw = *(const bf16x8*)(W2T + (size_t)chn * 64 + kk * 32 + fq * 8);
                const bf16x8 ba = *(const bf16x8*)(A2T + (size_t)chn * 64 + kk * 32 + fq * 8);
#pragma unroll
                for (int mt = 0; mt < 2; ++mt) {
                    lw[mt][n] = __builtin_amdgcn_mfma_f32_16x16x32_bf16(aw[mt], bw, lw[mt][n], 0, 0, 0);
                    la[mt][n] = __builtin_amdgcn_mfma_f32_16x16x32_bf16(aa[mt], ba, la[mt][n], 0, 0, 0);
                }
            }
        }
#pragma unroll
        for (int mt = 0; mt < 2; ++mt)
#pragma unroll
            for (int n = 0; n < 4; ++n)
#pragma unroll
                for (int jj = 0; jj < 4; ++jj) { const int o = (mt * 16 + fq * 4 + jj) * PREP_LD + wid * 64 + n * 16 + fr; LW[o] = lw[mt][n][jj]; LA[o] = la[mt][n][jj]; }
    }
    __syncthreads();
    {
        const int cv = tid & 63, c0 = cv * 8, head = cv >> 3, cc = c0 & 63;
        float muR[8], muK[8], muV[8], w0v[8], a0v[8], kkw[8], kaw[8], rkw[8];
        ldf8(mu + RW_R + c0, muR); ldf8(mu + RW_K + c0, muK); ldf8(mu + RW_V + c0, muV);
        ldf8(p.w0 + l * BW + c0, w0v); ldf8(p.a0 + l * BW + c0, a0v); ldf8(p.k_k + l * BW + c0, kkw); ldf8(p.k_a + l * BW + c0, kaw); ldf8(p.r_k + l * BW + c0, rkw);
        unsigned char* stream = p.ws + OFF_STREAM; float* bonus = (float*)(p.ws + OFF_BONUS);
#pragma unroll
        for (int it = 0; it < 4; ++it) {
            const int tt = (tid >> 6) + it * 8, tok = tok0 + tt, tpos = tok & (T - 1), b = tok >> 12;
            const bf16_t* pc = proj + (size_t)tok * DINP + C_RW + c0;
            float rc[8], kc[8], vc[8], rp[8], kp[8], vp[8];
            unpack8(*(const u32x4*)(pc + RW_R), rc); unpack8(*(const u32x4*)(pc + RW_K), kc); unpack8(*(const u32x4*)(pc + RW_V), vc);
            if (tpos != 0) { unpack8(*(const u32x4*)(pc - DINP + RW_R), rp); unpack8(*(const u32x4*)(pc - DINP + RW_K), kp); unpack8(*(const u32x4*)(pc - DINP + RW_V), vp); }
            else {
#pragma unroll
                for (int i = 0; i < 8; ++i) { rp[i] = 0.f; kp[i] = 0.f; vp[i] = 0.f; } }
            float lwv[8], lav[8];
            { const f32x4 x0 = *(const LAS f32x4*)(LW + tt * PREP_LD + c0), x1 = *(const LAS f32x4*)(LW + tt * PREP_LD + c0 + 4), y0 = *(const LAS f32x4*)(LA + tt * PREP_LD + c0), y1 = *(const LAS f32x4*)(LA + tt * PREP_LD + c0 + 4);
#pragma unroll
              for (int i = 0; i < 4; ++i) { lwv[i] = x0[i]; lwv[4 + i] = x1[i]; lav[i] = y0[i]; lav[4 + i] = y1[i]; } }
            float rr[8], k2[8], vv[8], dec[8], av[8], kkv[8]; float ssq = 0.f, bsum = 0.f;
#pragma unroll
            for (int i = 0; i < 8; ++i) {
                const float r = rc[i] + (rp[i] - rc[i]) * muR[i], k = kc[i] + (kp[i] - kc[i]) * muK[i], v = vc[i] + (vp[i] - vc[i]) * muV[i];
                dec[i] = __expf(-0.6065306597126334f * sigmoidf_(w0v[i] + lwv[i]));
                const float a = sigmoidf_(a0v[i] + lav[i]);
                const float kq = k * kkw[i];
                ssq += kq * kq; kkv[i] = kq;
                const float kk2 = k * (1.0f + (a - 1.0f) * kaw[i]);
                bsum += r * kk2 * rkw[i];
                rr[i] = r; k2[i] = kk2; vv[i] = v; av[i] = a;
            }
            ssq = red8(ssq); bsum = red8(bsum);
            const float inv = 1.0f / fmaxf(sqrtf(ssq), 1e-12f);
            float na[8], nb[8];
#pragma unroll
            for (int i = 0; i < 8; ++i) { const float kn = kkv[i] * inv; na[i] = -kn; nb[i] = kn * av[i]; }
            unsigned char* rec = stream + ((size_t)(b * 8 + head) * T + tpos) * SREC;
            *(f32x4*)(rec + 4 * cc) = (f32x4){dec[0], dec[1], dec[2], dec[3]}; *(f32x4*)(rec + 4 * cc + 16) = (f32x4){dec[4], dec[5], dec[6], dec[7]};
            *(u32x4*)(rec + 256 + 2 * cc) = pack8(rr);
            *(u32x4*)(rec + 384 + 2 * cc) = pack8(k2);
            *(u32x4*)(rec + 512 + 2 * cc) = pack8(na);
            *(u32x4*)(rec + 640 + 2 * cc) = pack8(nb);
            *(u32x4*)(rec + 768 + 2 * cc) = pack8(vv);
            if ((cv & 7) == 0) bonus[(size_t)tok * 8 + head] = bsum;
        }
    }
    __syncthreads();
}

__device__ __forceinline__ void ret_r2(const Params& p) {
    const float* kvT = (const float*)(p.ws + OFF_KVT); bf16_t* rp = (bf16_t*)(p.ws + OFF_RPREV);
    const int gtid = blockIdx.x * 512 + tid_(), nth = gridDim.x * 512;
    for (int i2 = gtid; i2 < 16 * 8192; i2 += nth) {
        const int bh = i2 >> 13, ed = (i2 & 8191) * 2, h = bh & 3;
        const float cd = exp2f(128.0f * ret_lg(h));
        const size_t o0 = ((size_t)(bh * 32) << 14) + ed;
        f32x2 kv[31];
#pragma unroll
        for (int n = 0; n < 31; ++n) kv[n] = __builtin_nontemporal_load((const f32x2*)(kvT + o0 + ((size_t)n << 14)));
        float r0 = 0.f, r1 = 0.f;
#pragma unroll
        for (int n = 0; n < 32; ++n) {
            *(unsigned*)(rp + o0 + ((size_t)n << 14)) = pk2(r0, r1);
            if (n < 31) { r0 = cd * r0 + kv[n][0]; r1 = cd * r1 + kv[n][1]; }
        }
    }
}

constexpr int SCH = 32;
constexpr int SREC_F = 384;
constexpr int SBUF_F = SCH * SREC_F;
__device__ __forceinline__ void rwkv_scan_item(const Params& p, int item, LAS float* lds, LAS unsigned* roletab) {
    const int tid = tid_(), wid = tid >> 6, lane = tid & 63;
    const int bh = (item & 7) + 8 * ((item >> 3) & 3), rg = item >> 5, b = bh >> 3, h = bh & 7;
    const unsigned char* sbase = p.ws + OFF_STREAM + (size_t)bh * T * SREC;
    constexpr int NCH = T / SCH;
    if (lane == 0) roletab[wid] = (unsigned)__builtin_amdgcn_s_getreg((1 << 11) | (4 << 6) | 4) & 3u;
    __syncthreads();
    int srole = -1, lrole = -1;
    {
        int sd[8];
#pragma unroll
        for (int i = 0; i < 8; ++i) sd[i] = (int)roletab[i];
        const int sA = 0; int sB = -1;
#pragma unroll
        for (int i = 1; i < 8; ++i) if (sB < 0 && sd[i] != sd[0]) sB = i;
        if (sB < 0) sB = 1;
        int nl = 0;
#pragma unroll
        for (int i = 0; i < 8; ++i) { const bool free_ = (i != sA) && (i != sB) && sd[i] != sd[sA] && sd[i] != sd[sB]; if (free_ && nl < 4) { if (i == wid) lrole = nl; ++nl; } }
#pragma unroll
        for (int i = 0; i < 8; ++i) { const bool other = (i != sA) && (i != sB) && !(sd[i] != sd[sA] && sd[i] != sd[sB]); if (other && nl < 4) { if (i == wid) lrole = nl; ++nl; } }
        if (wid == sA) srole = 0; else if (wid == sB) srole = 1;
    }
    const bool scanner = srole >= 0, loader = lrole >= 0;
    const int lt = lrole * 64 + lane;
    LAS float* ybuf = lds + 2 * SBUF_F;
    bf16_t* proj = (bf16_t*)(p.ws + OFF_PROJ);
    float* ybase = (float*)(proj + (size_t)(b * T) * DINP + C_RW) + h * 64 + rg * 8;
    u32x4 reg[7];
    auto ld = [&](int c) {
        const u32x4* src = (const u32x4*)(sbase + (size_t)c * SCH * SREC);
#pragma unroll
        for (int i = 0; i < 7; ++i) reg[i] = src[lt + i * 256];
    };
    auto st = [&](int buf) {
        LAS float* dst = lds + buf * SBUF_F;
#pragma unroll
        for (int i = 0; i < 7; ++i) { const int v = lt + i * 256;
            const int s = v / 56, wi = v % 56; const u32x4 r = reg[i];
            if (wi < 16) { *(LAS u32x4*)(dst + s * SREC_F + wi * 4) = r; }
            else { const int a = (wi - 16) >> 3, pos = ((wi - 16) & 7) * 8; LAS float* d = dst + s * SREC_F + 64 + a * 64 + pos;
                *(LAS f32x4*)d = (f32x4){bflo(r.x), bfhi(r.x), bflo(r.y), bfhi(r.y)}; *(LAS f32x4*)(d + 4) = (f32x4){bflo(r.z), bfhi(r.z), bflo(r.w), bfhi(r.w)}; }
        }
    };
    auto yred = [&](int c) {
        const LAS float* yp = ybuf + (c & 1) * (SCH * 128) + lt * 16;
        const f32x4 a0 = *(const LAS f32x4*)yp, a1 = *(const LAS f32x4*)(yp + 4), a2 = *(const LAS f32x4*)(yp + 8), a3 = *(const LAS f32x4*)(yp + 12);
        const f32x4 sm = (a0 + a1) + (a2 + a3);
        ybase[(size_t)(c * SCH + (lt >> 3)) * (DINP / 2) + (lt & 7)] = (sm[0] + sm[1]) + (sm[2] + sm[3]);
    };
    if (loader) { ld(0); st(0); ld(1); }
    if (scanner) __builtin_amdgcn_s_setprio(3);
    __syncthreads();
    const int rr = lane >> 4, q = lane & 15, rl = (srole & 1) * 4 + rr, row = rg * 8 + rl;
    f32x2 S0 = (f32x2){0.f, 0.f}, S1 = (f32x2){0.f, 0.f};
    for (int c = 0; c < NCH; ++c) {
        if (loader) {
            if (c + 1 < NCH) st((c + 1) & 1);
            if (c + 2 < NCH) ld(c + 2);
            if (c > 0) yred(c - 1);
        } else if (scanner) {
            const LAS float* cb = lds + (c & 1) * SBUF_F + q * 4;
            const LAS float* vb = lds + (c & 1) * SBUF_F + 320 + row;
            LAS float* yb = ybuf + (c & 1) * (SCH * 128) + rl * 16 + q;
            f32x4 w4 = *(const LAS f32x4*)(cb), r4 = *(const LAS f32x4*)(cb + 64), k4 = *(const LAS f32x4*)(cb + 128), a4 = *(const LAS f32x4*)(cb + 192), b4 = *(const LAS f32x4*)(cb + 256);
            float vv = vb[0];
            f32x4 w5 = *(const LAS f32x4*)(cb + SREC_F), r5 = *(const LAS f32x4*)(cb + SREC_F + 64), k5 = *(const LAS f32x4*)(cb + SREC_F + 128), a5 = *(const LAS f32x4*)(cb + SREC_F + 192), b5 = *(const LAS f32x4*)(cb + SREC_F + 256);
            float v5 = vb[SREC_F];
#pragma unroll
            for (int s = 0; s < SCH; ++s) {
                f32x4 nw = w5, nr = r5, nk = k5, na = a5, nb = b5; float nv = v5;
                if (s + 2 < SCH) {
                    const LAS float* nbp = cb + (s + 2) * SREC_F;
                    nw = *(const LAS f32x4*)(nbp); nr = *(const LAS f32x4*)(nbp + 64); nk = *(const LAS f32x4*)(nbp + 128); na = *(const LAS f32x4*)(nbp + 192); nb = *(const LAS f32x4*)(nbp + 256);
                    nv = vb[(s + 2) * SREC_F];
                }
                f32x2 t = S0 * (f32x2){a4[0], a4[1]};
                t = __builtin_elementwise_fma(S1, (f32x2){a4[2], a4[3]}, t);
                float pa = t[0] + t[1];
                pa = red16(pa);
                const f32x2 vk0 = (f32x2){vv, vv} * (f32x2){k4[0], k4[1]}, vk1 = (f32x2){vv, vv} * (f32x2){k4[2], k4[3]};
                const f32x2 t0 = __builtin_elementwise_fma(S0, (f32x2){w4[0], w4[1]}, vk0), t1 = __builtin_elementwise_fma(S1, (f32x2){w4[2], w4[3]}, vk1);
                S0 = __builtin_elementwise_fma((f32x2){pa, pa}, (f32x2){b4[0], b4[1]}, t0);
                S1 = __builtin_elementwise_fma((f32x2){pa, pa}, (f32x2){b4[2], b4[3]}, t1);
                f32x2 u = S0 * (f32x2){r4[0], r4[1]};
                u = __builtin_elementwise_fma(S1, (f32x2){r4[2], r4[3]}, u);
                yb[s * 128] = u[0] + u[1];
                w4 = w5; r4 = r5; k4 = k5; a4 = a5; b4 = b5; vv = v5;
                w5 = nw; r5 = nr; k5 = nk; a5 = na; b5 = nb; v5 = nv;
            }
        }
        __syncthreads();
    }
    if (loader) yred(NCH - 1);
    if (scanner) __builtin_amdgcn_s_setprio(0);
    __syncthreads();
}

__device__ __forceinline__ void ret_r3_item(const Params& p, int l, int item, LAS bf16_t* lds) {
    const int tid = tid_(), wid = tid >> 6, lane = tid & 63, fr = lane & 15, fq = lane >> 4;
    const int n = item & 31, bh = item >> 5, h = bh & 3, b = bh >> 2, tok0 = b * T + n * 128;
    const float lg = ret_lg(h);
    LAS bf16_t* Q = lds; LAS bf16_t* Kk = lds + 128 * LDS_LD; LAS bf16_t* VT = lds + 2 * 128 * LDS_LD; LAS bf16_t* RP = lds + 3 * 128 * LDS_LD;
    {
        const bf16_t* rp = (const bf16_t*)(p.ws + OFF_RPREV) + ((size_t)item << 14);
        RotCS cs[2]; u32x4 qa[2], qb[2], ka[2], kb[2], rv[4], rpv[4];
        fetch_qk(p, qa, qb, tid, tok0, C_Q + h * 128); fetch_qk(p, ka, kb, tid, tok0, C_K + h * 128); fetch_cs(p, cs, tid, tok0);
        fetch_v(p, rv, tid, tok0, C_V + h * 128);
#pragma unroll
        for (int it = 0; it < 4; ++it) rpv[it] = *(const u32x4*)(rp + (size_t)(tid + it * 512) * 8);
        store_rot<false>(Q, qa, qb, cs, tid, 1.0f, 0.f);
        store_rot<false>(Kk, ka, kb, cs, tid, 0.08838834764831845f, 0.f);
        store_vT(VT, rv, tid);
#pragma unroll
        for (int it = 0; it < 4; ++it) { const int u = tid + it * 512, e = u >> 4, d0 = (u & 15) * 8; *(LAS u32x4*)(RP + e * LDS_LD + d0) = rpv[it]; }
    }
    __syncthreads();
    const int i0 = wid * 16;
    f32x4 acc[8], sc_[8];
#pragma unroll
    for (int i = 0; i < 8; ++i) { acc[i] = (f32x4){0.f, 0.f, 0.f, 0.f}; sc_[i] = (f32x4){0.f, 0.f, 0.f, 0.f}; }
    strip_mma(Q, i0, RP, acc, fr, fq);
    strip_mma(Q, i0, Kk, sc_, fr, fq);
#pragma unroll
    for (int jj = 0; jj < 4; ++jj) { const float sc = exp2f(lg * (float)(i0 + fq * 4 + jj + 1));
#pragma unroll
        for (int nn = 0; nn < 8; ++nn) acc[nn][jj] *= sc; }
    asm volatile("s_waitcnt lgkmcnt(0)" ::: "memory");
    LAS bf16_t* P = Q;
    {
        float rf[4], cf[8];
#pragma unroll
        for (int jj = 0; jj < 4; ++jj) rf[jj] = exp2f(lg * (float)(i0 + fq * 4 + jj));
#pragma unroll
        for (int nn = 0; nn < 8; ++nn) cf[nn] = exp2f(-lg * (float)(nn * 16 + fr));
#pragma unroll
        for (int nn = 0; nn < 8; ++nn)
#pragma unroll
            for (int jj = 0; jj < 4; ++jj) {
                const int i = i0 + fq * 4 + jj, j = nn * 16 + fr;
                const float m = (i >= j) ? rf[jj] * cf[nn] : 0.f;
                P[i * LDS_LD + j] = f2bf(sc_[nn][jj] * m);
            }
    }
    asm volatile("s_waitcnt lgkmcnt(0)" ::: "memory");
    strip_mma(P, i0, VT, acc, fr, fq);
    if (n == 0 && wid == 0 && fq == 0) {
        const float s0 = ((const float*)(p.ws + OFF_SACC))[b * 4 + h];
#pragma unroll
        for (int nn = 0; nn < 8; ++nn) acc[nn][0] = s0 * bf2f(VT[(nn * 16 + fr) * LDS_LD]);
    }
    asm volatile("s_waitcnt lgkmcnt(0)" ::: "memory");
    const bf16_t* proj = (const bf16_t*)(p.ws + OFF_PROJ);
    bf16_t* br1 = (bf16_t*)(p.ws + OFF_BR) + (size_t)BT * BW;
    const float* gn = p.ret_norm_g + l * BW + h * 128;
    float gv[8];
#pragma unroll
    for (int nn = 0; nn < 8; ++nn) gv[nn] = gn[nn * 16 + fr];
#pragma unroll
    for (int jj = 0; jj < 4; ++jj) {
        float s = 0.f;
#pragma unroll
        for (int nn = 0; nn < 8; ++nn) s += acc[nn][jj];
        s = red16(s); const float mean = s * (1.0f / 128.0f);
        float vs = 0.f;
#pragma unroll
        for (int nn = 0; nn < 8; ++nn) { const float d = acc[nn][jj] - mean; vs += d * d; }
        vs = red16(vs); const float rstd = rsqrtf(vs * (1.0f / 128.0f) + 1e-5f);
#pragma unroll
        for (int nn = 0; nn < 8; ++nn) Q[(i0 + fq * 4 + jj) * LDS_LD + nn * 16 + fr] = f2bf((acc[nn][jj] - mean) * rstd * gv[nn]);
    }
    asm volatile("s_waitcnt lgkmcnt(0)" ::: "memory");
#pragma unroll
    for (int it = 0; it < 4; ++it) {
        const int i = i0 + it * 4 + fq, e0 = fr * 8;
        const size_t tok = (size_t)(tok0 + i);
        float ov[8], gt[8], o[8];
        unpack8(*(const LAS u32x4*)(Q + i * LDS_LD + e0), ov);
        unpack8(*(const u32x4*)(proj + tok * DINP + C_RG + h * 128 + e0), gt);
#pragma unroll
        for (int k = 0; k < 8; ++k) o[k] = ov[k] * siluf_(gt[k]);
        *(u32x4*)(br1 + tok * BW + h * 128 + e0) = pack8(o);
    }
    __syncthreads();
}

__device__ __forceinline__ void c0_item(const Params& p, int l, unsigned char* shm) {
    const int tid = tid_(), b = tid >> 7, h = (tid >> 4) & 7, q = tid & 15, ch = h * 64 + q * 4;
    float* P0 = (float*)shm;
    {
        const float* pp = (const float*)(p.ws + OFF_P0F);
        float v18[18];
#pragma unroll
        for (int j = 0; j < 18; ++j) v18[j] = pp[tid + j * 512];
#pragma unroll
        for (int j = 0; j < 18; ++j) P0[tid + j * 512] = v18[j];
    }
    __syncthreads();
    {
        const int b2 = tid >> 7, h2 = (tid >> 5) & 3, l32 = tid & 31;
        const f32x4 qv = *(const f32x4*)(P0 + b2 * P0W + 1152 + h2 * 128 + l32 * 4), kv = *(const f32x4*)(P0 + b2 * P0W + 1664 + h2 * 128 + l32 * 4);
        float sp = (qv[0] * kv[0] + qv[1] * kv[1]) + (qv[2] * kv[2] + qv[3] * kv[3]);
        sp = red16(sp); sp += __shfl_xor(sp, 16);
        if (l32 == 0) ((float*)(p.ws + OFF_SACC))[b2 * 4 + h2] = sp * 0.08838834764831845f;
    }
    const float* p0 = P0 + b * P0W;
    const float* mu = p.shift_mu + l * RW_W;
    float* AL = P0 + NB * P0W;
    if (tid < 256) AL[tid] = P0[(tid >> 6) * P0W + 1024 + (tid & 63)] * (1.0f - mu[RW_AL + (tid & 63)]);
    __syncthreads();
    f32x4 aacc = *(const f32x4*)(p.a0 + l * BW + ch);
#pragma unroll
    for (int i0 = 0; i0 < 64; i0 += 32) {
        f32x4 rows[32];
#pragma unroll
        for (int j = 0; j < 32; ++j) rows[j] = *(const f32x4*)(p.a2 + ((size_t)l * 64 + i0 + j) * BW + ch);
#pragma unroll
        for (int j = 0; j < 32; ++j) aacc += AL[b * 64 + i0 + j] * rows[j];
    }
    const f32x4 r0 = *(const f32x4*)(p0 + ch), k0v = *(const f32x4*)(p0 + 512 + ch);
    const f32x4 ka = *(const f32x4*)(p.k_a + l * BW + ch);
    float cpart = 0.f;
#pragma unroll
    for (int i = 0; i < 4; ++i) { const float av = 1.0f / (1.0f + expf(-aacc[i]));
        const float rr_ = r0[i] * (1.0f - mu[RW_R + ch + i]), kk_ = k0v[i] * (1.0f - mu[RW_K + ch + i]);
        cpart += rr_ * (kk_ * (1.0f + (av - 1.0f) * ka[i])); }
    const float c0 = red16(cpart);
    if (q == 0) ((float*)(p.ws + OFF_CACC))[b * 8 + h] = c0;
    __syncthreads();
}
__device__ __forceinline__ void rwkv_post(const Params& p, int l) {
    const bf16_t* proj = (const bf16_t*)(p.ws + OFF_PROJ);
    bf16_t* br2 = (bf16_t*)(p.ws + OFF_BR) + (size_t)2 * BT * BW;
    const float* bonus = (const float*)(p.ws + OFF_BONUS);
    const unsigned char* stream = p.ws + OFF_STREAM;
    const float* ln_w = p.ln_w + l * BW; const float* ln_b = p.ln_b + l * BW;
    const int gtid = blockIdx.x * 512 + tid_(), nth = gridDim.x * 512;
    for (int idx = gtid; idx < BT * 64; idx += nth) {
        const int tok = idx >> 6, h = (idx >> 3) & 7, q = idx & 7, ch = h * 64 + q * 8, b = tok >> 12, tpos = tok & (T - 1);
        float y[8]; ldf8((const float*)(proj + (size_t)tok * DINP + C_RW) + ch, y);
        float v8[8]; unpack8(*(const u32x4*)(stream + ((size_t)(b * 8 + h) * T + tpos) * SREC + 768 + q * 16), v8);
        if (tpos == 0) {
            const float c0 = ((const float*)(p.ws + OFF_CACC))[b * 8 + h];
#pragma unroll
            for (int i = 0; i < 8; ++i) y[i] = v8[i] * c0;
        }
        float s = 0.f;
#pragma unroll
        for (int i = 0; i < 8; ++i) s += y[i];
        s = red8(s); const float mean = s * (1.0f / 64.0f);
        float vs = 0.f;
#pragma unroll
        for (int i = 0; i < 8; ++i) { y[i] -= mean; vs += y[i] * y[i]; }
        vs = red8(vs);
        const float rstd = rsqrtf(vs * (1.0f / 64.0f) + 64e-5f);
        float g8[8]; unpack8(*(const u32x4*)(proj + (size_t)tok * DINP + C_RWG + ch), g8);
        float lw8[8], lb8[8]; ldf8(ln_w + ch, lw8); ldf8(ln_b + ch, lb8);
        const float bs = bonus[(size_t)tok * 8 + h];
        float o[8];
#pragma unroll
        for (int i = 0; i < 8; ++i) o[i] = (y[i] * rstd * lw8[i] + lb8[i] + bs * v8[i]) * siluf_(g8[i]);
        *(u32x4*)(br2 + (size_t)tok * BW + ch) = pack8(o);
    }
}
__device__ __forceinline__ void gemm_inproj(const Params& p, LAS unsigned char* lds) {
    pg8::Gemm g{(const bf16_t*)(p.ws + OFF_H), (const bf16_t*)(p.ws + p.img_off + OFF_WIN), BT, DINP, D}; pg8::StaticOrder S; S.init(BT, DINP, (int)gridDim.x, (int)blockIdx.x); EpiProj E{(bf16_t*)(p.ws + OFF_PROJ)};
    pg8::gemm_phase<EpiProj, pg8::StaticOrder, false>(lds, g, S, E, nullptr);
}
template <int NBR> __device__ __forceinline__ void gemm_merge1(const Params& p, LAS unsigned char* lds) {
    const bf16_t* br = (const bf16_t*)(p.ws + OFF_BR); const bf16_t* Wt_br = (const bf16_t*)(p.ws + OFF_WBR);
    pg8::StaticOrder S; S.init(BT, D, (int)gridDim.x, (int)blockIdx.x);
    pg8::Gemm g{br + (size_t)NBR * BT * BW, Wt_br + (size_t)NBR * D * BW, BT, D, BW};
    EpiMerge<NBR> E{(const bf16_t*)(p.ws + OFF_PROJ), (float*)(p.ws + OFF_MERGED), (bf16_t*)(p.ws + OFF_MERGEDB)};
    pg8::gemm_phase<EpiMerge<NBR>, pg8::StaticOrder, false>(lds, g, S, E, nullptr);
}
__device__ __forceinline__ void gemm_merge(const Params& p, LAS unsigned char* lds) { gemm_merge1<0>(p, lds); gemm_merge1<1>(p, lds); gemm_merge1<2>(p, lds); }
__device__ __forceinline__ void gemm_merge_all(const Params& p, LAS unsigned char* lds) {
    pg8::Gemm g{(const bf16_t*)(p.ws + OFF_BR), (const bf16_t*)(p.ws + OFF_WBR), 3 * BT, 3 * D, BW};
    MergeOrder S; S.base.init(BT, D, (int)gridDim.x, (int)blockIdx.x);
    EpiMergeAll E{(const bf16_t*)(p.ws + OFF_PROJ), (float*)(p.ws + OFF_MERGED), (bf16_t*)(p.ws + OFF_MERGEDB)};
    pg8::gemm_phase<EpiMergeAll, MergeOrder, false>(lds, g, S, E, nullptr);
}
__device__ __forceinline__ void gemm_out(const Params& p, int l, const float* xin, LAS unsigned char* lds) {
    pg8::Gemm g{(const bf16_t*)(p.ws + OFF_MERGEDB), (const bf16_t*)(p.ws + p.img_off + OFF_WOUT), BT, D, D}; pg8::StaticOrder S; S.init(BT, D, (int)gridDim.x, (int)blockIdx.x);
    EpiOut E{xin, p.out, (const float*)(p.ws + OFF_MOD) + (size_t)l * NB * 3 * D + 2 * D};
    pg8::gemm_phase<EpiOut, pg8::StaticOrder, false>(lds, g, S, E, nullptr);
}
constexpr int MG_BK = 64, MG_A_BYTES = 256 * MG_BK * 2, MG_B_BYTES = 128 * MG_BK * 2, MG_STAGE = MG_A_BYTES + MG_B_BYTES;
template <int DRY> __device__ __forceinline__ void gemm_merge_fused(const Params& p, LAS unsigned char* lds) {
    const int tid = tid_(), wid = tid >> 6, lane = tid & 63, fr = lane & 15, fq = lane >> 4, wr = wid >> 1, wc = wid & 1;
    const bf16_t* br = (const bf16_t*)(p.ws + OFF_BR); const bf16_t* Wt = (const bf16_t*)(p.ws + p.img_off + OFF_WBR);
    const bf16_t* proj = (const bf16_t*)(p.ws + OFF_PROJ); bf16_t* mergedb = (bf16_t*)(p.ws + OFF_MERGEDB);
    int a_off[4], b_off[2];
#pragma unroll
    for (int i = 0; i < 4; ++i) { const int c = tid + i * 512, row = c >> 3; a_off[i] = row * BW + (((c & 7) ^ (row & 7)) * 8); }
#pragma unroll
    for (int i = 0; i < 2; ++i) { const int c = tid + i * 512, row = c >> 3, rho = row & 31, srow = (row & ~31) + 8 * ((rho & 15) >> 2) + 4 * (rho >> 4) + (rho & 3);
        b_off[i] = srow * BW + (((c & 7) ^ (row & 7)) * 8); }
    f32x4 tot[4][4], acc[4][4];
    int nmine = 0; for (int u = (int)blockIdx.x; u < 512; u += (int)gridDim.x) ++nmine;
    const int nsteps = nmine * 24;
    auto unit_of = [&](int ui, int& pm, int& pn) { const int u = (int)blockIdx.x + ui * (int)gridDim.x; pm = (u & 7) + 8 * (u >> 6); pn = (u >> 3) & 7; };
    auto dma = [&](int g) {
        const int ui = g / 24, r = g - ui * 24, n = r >> 3, t = r & 7; int pm, pn; unit_of(ui, pm, pn);
        const bf16_t* A = br + (size_t)n * BT * BW + (size_t)(pm * 256) * BW + t * MG_BK;
        const bf16_t* Bw = Wt + (size_t)n * D * BW + (size_t)(pn * 128) * BW + t * MG_BK;
        LAS unsigned char* base = lds + (g % 3) * MG_STAGE + wid * 1024;
#pragma unroll
        for (int i = 0; i < 4; ++i) __builtin_amdgcn_global_load_lds((const unsigned*)(A + a_off[i]), (LAS unsigned*)(base + i * 8192), 16, 0, 0);
#pragma unroll
        for (int i = 0; i < 2; ++i) __builtin_amdgcn_global_load_lds((const unsigned*)(Bw + b_off[i]), (LAS unsigned*)(base + MG_A_BYTES + i * 8192), 16, 0, 0);
    };
#pragma unroll
    for (int m = 0; m < 4; ++m)
#pragma unroll
        for (int n = 0; n < 4; ++n) { tot[m][n] = (f32x4){0.f, 0.f, 0.f, 0.f}; acc[m][n] = (f32x4){0.f, 0.f, 0.f, 0.f}; }
    if (nsteps > 0) { dma(0); if (nsteps > 1) { dma(1); asm volatile("s_waitcnt vmcnt(6)" ::: "memory"); } else asm volatile("s_waitcnt vmcnt(0)" ::: "memory"); }
    __builtin_amdgcn_s_barrier(); asm volatile("" ::: "memory");
    for (int g = 0; g < nsteps; ++g) {
        {
            const LAS unsigned char* Ab = lds + (g % 3) * MG_STAGE; const LAS unsigned char* Bb = Ab + MG_A_BYTES;
#pragma unroll
            for (int kk = 0; kk < 2; ++kk) {
                if (kk == 1 && g + 2 < nsteps) dma(g + 2);
                bf16x8 af[4], bfv[4];
#pragma unroll
                for (int m = 0; m < 4; ++m) { const int row = wr * 64 + m * 16 + fr; af[m] = *(const LAS bf16x8*)(Ab + row * 128 + (((kk * 4 + fq) ^ (row & 7)) * 16)); }
#pragma unroll
                for (int n = 0; n < 4; ++n) { const int row = wc * 64 + n * 16 + fr; bfv[n] = *(const LAS bf16x8*)(Bb + row * 128 + (((kk * 4 + fq) ^ (row & 7)) * 16)); }
                __builtin_amdgcn_s_setprio(1);
#pragma unroll
                for (int m = 0; m < 4; ++m)
#pragma unroll
                    for (int n = 0; n < 4; ++n) { if (DRY != 1) acc[m][n] = __builtin_amdgcn_mfma_f32_16x16x32_bf16(bfv[n], af[m], acc[m][n], 0, 0, 0); else { asm volatile("" :: "v"(bfv[n]), "v"(af[m])); } }
                __builtin_amdgcn_s_setprio(0);
            }
        }
        const int ui = g / 24, r = g - ui * 24, nb = r >> 3, t = r & 7;
        if (t == 7 && DRY == 0) {
            int pm, pn; unit_of(ui, pm, pn);
            const int row0 = pm * 256 + wr * 64 + fr, col0 = pn * 128 + wc * 64 + fq * 8;
#pragma unroll
            for (int m = 0; m < 4; ++m)
#pragma unroll
                for (int pp_ = 0; pp_ < 2; ++pp_) {
                    const u32x4 lg = *(const u32x4*)(proj + (size_t)(row0 + m * 16) * DINP + C_GATE + nb * D + col0 + pp_ * 32);
                    f32x4& t0 = tot[m][2 * pp_]; f32x4& t1 = tot[m][2 * pp_ + 1]; f32x4& c0 = acc[m][2 * pp_]; f32x4& c1 = acc[m][2 * pp_ + 1];
                    t0[0] += sigmoidf_(bflo(lg.x)) * c0[0]; t0[1] += sigmoidf_(bfhi(lg.x)) * c0[1]; t0[2] += sigmoidf_(bflo(lg.y)) * c0[2]; t0[3] += sigmoidf_(bfhi(lg.y)) * c0[3];
                    t1[0] += sigmoidf_(bflo(lg.z)) * c1[0]; t1[1] += sigmoidf_(bfhi(lg.z)) * c1[1]; t1[2] += sigmoidf_(bflo(lg.w)) * c1[2]; t1[3] += sigmoidf_(bfhi(lg.w)) * c1[3];
                    c0 = (f32x4){0.f, 0.f, 0.f, 0.f}; c1 = (f32x4){0.f, 0.f, 0.f, 0.f};
                }
            if (nb == 2) {
#pragma unroll
                for (int m = 0; m < 4; ++m)
#pragma unroll
                    for (int pp_ = 0; pp_ < 2; ++pp_) {
                        f32x4& t0 = tot[m][2 * pp_]; f32x4& t1 = tot[m][2 * pp_ + 1];
                        u32x4 w; w.x = pk2(t0[0], t0[1]); w.y = pk2(t0[2], t0[3]); w.z = pk2(t1[0], t1[1]); w.w = pk2(t1[2], t1[3]);
                        *(u32x4*)(mergedb + (size_t)(row0 + m * 16) * D + col0 + pp_ * 32) = w;
                        t0 = (f32x4){0.f, 0.f, 0.f, 0.f}; t1 = (f32x4){0.f, 0.f, 0.f, 0.f};
                    }
            }
        }
        if (g + 2 < nsteps) asm volatile("s_waitcnt vmcnt(6)" ::: "memory"); else asm volatile("s_waitcnt vmcnt(0)" ::: "memory");
        asm volatile("s_waitcnt lgkmcnt(0)" ::: "memory");
        __builtin_amdgcn_s_barrier(); asm volatile("" ::: "memory");
    }
    __syncthreads();
}

#ifndef DUP_P1
#define DUP_P1 0
#endif
#ifndef DUP_P2
#define DUP_P2 0
#endif
#ifndef DUP_P3A
#define DUP_P3A 0
#endif
#ifndef DUP_P3B
#define DUP_P3B 0
#endif
#ifndef DUP_P3C
#define DUP_P3C 0
#endif
#ifndef DUP_P4
#define DUP_P4 0
#endif
#ifndef DUP_P5A
#define DUP_P5A 0
#endif
#ifndef DUP_P5B
#define DUP_P5B 0
#endif
#ifndef DUP_P6
#define DUP_P6 0
#endif
#ifndef DUP_P7
#define DUP_P7 0
#endif
#ifndef DUP_P0
#define DUP_P0 0
#endif
#ifndef DUP_R2
#define DUP_R2 0
#endif
#ifndef DUP_P6DRY
#define DUP_P6DRY 0
#endif
#ifndef DUP_P6NOEPI
#define DUP_P6NOEPI 0
#endif
#ifndef DUP_SYNC
#define DUP_SYNC 0
#endif
#if defined(__HIP_DEVICE_COMPILE__)
#define FRESH_PARAMS(q) Params q; { const __attribute__((address_space(4))) Params* pp_ = (const __attribute__((address_space(4))) Params*)__builtin_amdgcn_kernarg_segment_ptr(); asm volatile("" : "+s"(pp_)); q = *pp_; }
#else
#define FRESH_PARAMS(q) Params q = p_unused;
#endif
__global__ void __launch_bounds__(512, 2) fwd_megakernel(Params p_unused) {
    extern __shared__ __attribute__((aligned(16))) unsigned char shm[];
    cg::grid_group grid = cg::this_grid();
    LAS unsigned char* lds = (LAS unsigned char*)shm;
    const int G = (int)gridDim.x, bid = (int)blockIdx.x;
    volatile LAS unsigned* xb_st = (volatile LAS unsigned*)(lds + LDS_MAIN);
    if (tid_() == 0) { xb_st[0] = 0u; xb_st[1] = 0u; xb_st[2] = 0u; xb_st[3] = 0u; }
    __syncthreads();
    { FRESH_PARAMS(p); (void)xcd_barrier_post((unsigned*)(p.ws + OFF_BAR), xb_st); }
#define GSYNC() do { FRESH_PARAMS(pb_); XcdBarrier b_; b_.bar = (unsigned*)(pb_.ws + OFF_BAR); b_.x = xb_xcc_id(); b_.st = xb_st; xcd_barrier(b_); } while (0)

    for (int rep = 0; rep <= DUP_P0; ++rep) { FRESH_PARAMS(p); phase0(p, shm); }
    __syncthreads();
    { FRESH_PARAMS(p); p.img_off = 0; phase_weights(p, 0, shm, bid, G); }
    grid.sync();

#pragma nounroll
    for (int l = 0; l < NL; ++l) {
        for (int rep = 0; rep <= DUP_P1; ++rep) {
        { FRESH_PARAMS(p); phase_norm(p, l, (l == 0) ? p.x : p.out); }
        }
        GSYNC();
        for (int rep = 0; rep <= DUP_P2; ++rep) { FRESH_PARAMS(p); p.img_off = (size_t)(l & 1) * IMG_STRIDE; gemm_inproj(p, lds); }
        if (l + 1 < NL) { FRESH_PARAMS(p); p.img_off = (size_t)((l + 1) & 1) * IMG_STRIDE;
            if (G == 256) { if (bid >= 64) phase_weights(p, l + 1, shm, bid - 64, 192); }
            else phase_weights(p, l + 1, shm, bid, G); }
        { FRESH_PARAMS(p); const int first = (G == 256) ? 64 : 0; for (int it = bid - first; it >= 0 && it < 264; it += G - first) gemv0_item(p, l, it, shm); }
        GSYNC();
        for (int rep = 0; rep <= DUP_P3A; ++rep) { FRESH_PARAMS(p); for (int it = bid; it < BT / 64; it += G) pool_item(p, l, it); }
        for (int rep = 0; rep <= DUP_P3B; ++rep) { FRESH_PARAMS(p); for (int it = bid; it < 512; it += G) ret_r1_item(p, it, (LAS bf16_t*)lds); }
        for (int rep = 0; rep <= DUP_P3C; ++rep) { FRESH_PARAMS(p); p.img_off = (size_t)(l & 1) * IMG_STRIDE; for (int it = bid; it < BT / 32; it += G) rwkv_prep_item(p, l, it, (LAS bf16_t*)lds); }
        if (bid == G - 1) { FRESH_PARAMS(p); c0_item(p, l, shm); }
        GSYNC();
        for (int rep = 0; rep <= DUP_R2; ++rep) { FRESH_PARAMS(p); ret_r2(p); }
        for (int rep = 0; rep <= DUP_P4; ++rep) { FRESH_PARAMS(p); for (int it = bid; it < 256; it += G) rwkv_scan_item(p, it, (LAS float*)lds, (LAS unsigned*)(lds + LDS_MAIN + 16)); }
        GSYNC();
        for (int rep = 0; rep <= DUP_P5A; ++rep) { FRESH_PARAMS(p); for (int it = bid; it < 512; it += G) ret_r3_item(p, l, it, (LAS bf16_t*)lds); }
        for (int rep = 0; rep <= DUP_P5B; ++rep) { FRESH_PARAMS(p); rwkv_post(p, l); }
        GSYNC();
        for (int rep = 0; rep <= DUP_P6; ++rep) {
        { FRESH_PARAMS(p); p.img_off = (size_t)(l & 1) * IMG_STRIDE; gemm_merge_fused<0>(p, lds); }
        }
        GSYNC();
        for (int rep = 0; rep < DUP_P7; ++rep) { FRESH_PARAMS(p); p.img_off = (size_t)(l & 1) * IMG_STRIDE; Params q = p; q.out = (float*)(p.ws + OFF_MERGED); gemm_out(q, l, (l == 0) ? p.x : p.out, lds); }
        { FRESH_PARAMS(p); p.img_off = (size_t)(l & 1) * IMG_STRIDE; gemm_out(p, l, (l == 0) ? p.x : p.out, lds); }
        GSYNC();
        for (int rep = 0; rep < DUP_SYNC; ++rep) GSYNC();
    }
    { FRESH_PARAMS(p); phase_final_norm(p); }
}

extern "C" void kernel_launch(void* const* d_in, const int* in_sizes, int n_in, void* d_out, int out_size, void* d_ws, size_t ws_size, hipStream_t stream) {
    (void)in_sizes; (void)n_in; (void)out_size;
    if (ws_size < WS_NEED) { fprintf(stderr, "workspace too small: %zu < %zu\n", ws_size, (size_t)WS_NEED); return; }
    static int grid_blocks = 0;
    if (!grid_blocks) {
        int dev = 0, cus = 0, per_cu = 0;
        hipGetDevice(&dev);
        hipDeviceGetAttribute(&cus, hipDeviceAttributeMultiprocessorCount, dev);
        hipFuncSetAttribute((const void*)fwd_megakernel, hipFuncAttributeMaxDynamicSharedMemorySize, LDS_BYTES);
        hipOccupancyMaxActiveBlocksPerMultiprocessor(&per_cu, fwd_megakernel, 512, LDS_BYTES);
        if (per_cu < 1) per_cu = 1;
        grid_blocks = cus * per_cu;
        if (grid_blocks > 256) grid_blocks = 256;
    }
    Params p{};
    p.x = (const float*)d_in[0]; p.c = (const float*)d_in[1]; p.pos = (const int*)d_in[2];
    p.norm_g = (const float*)d_in[3]; p.w_ada = (const float*)d_in[4]; p.b_ada = (const float*)d_in[5]; p.w_in = (const float*)d_in[6];
    p.pool_w = (const float*)d_in[7]; p.pool_scale = (const float*)d_in[8]; p.ret_norm_g = (const float*)d_in[9]; p.shift_mu = (const float*)d_in[10];
    p.w0 = (const float*)d_in[11]; p.w2 = (const float*)d_in[12]; p.a0 = (const float*)d_in[13]; p.a2 = (const float*)d_in[14];
    p.k_k = (const float*)d_in[15]; p.k_a = (const float*)d_in[16]; p.r_k = (const float*)d_in[17]; p.ln_w = (const float*)d_in[18]; p.ln_b = (const float*)d_in[19];
    p.w_branch = (const float*)d_in[20]; p.w_out = (const float*)d_in[21]; p.final_g = (const float*)d_in[22];
    p.out = (float*)d_out; p.ws = (unsigned char*)d_ws;
    (void)hipMemsetAsync((unsigned char*)d_ws + OFF_BAR, 0, SZ_BAR, stream);
    void* args[] = {&p};
    hipError_t e = hipLaunchCooperativeKernel((const void*)fwd_megakernel, dim3(grid_blocks), dim3(512), args, LDS_BYTES, stream);
    if (e != hipSuccess) fprintf(stderr, "cooperative launch failed: %s (grid %d)\n", hipGetErrorString(e), grid_blocks);
}
```

```cpp
#include <hip/hip_runtime.h>
#include <hip/hip_cooperative_groups.h>
#include <cstdio>
namespace cg = cooperative_groups;

__device__ __forceinline__ int tid_() { int t = (int)__builtin_amdgcn_workitem_id_x(); asm volatile("" : "+v"(t)); return t; }
#define LAS __attribute__((address_space(3)))

#define XB_TMO      128
#define XB_XCNT(j)  (256  + 64 * (j))
#define XB_XSUB(j)  (1280 + 64 * (j))
#define XB_XGEN(j)  (2304 + 64 * (j))
#define XB_TOP      3328
#define XB_TOPGEN   3392
#define XCD_BAR_WORDS 3456
#define XB_SPIN_CAP (1u << 18)

__device__ __forceinline__ unsigned xb_ld(unsigned* p)              { return __hip_atomic_load(p, __ATOMIC_RELAXED, __HIP_MEMORY_SCOPE_AGENT); }
__device__ __forceinline__ unsigned xb_add(unsigned* p, unsigned v) { return __hip_atomic_fetch_add(p, v, __ATOMIC_RELAXED, __HIP_MEMORY_SCOPE_AGENT); }
__device__ __forceinline__ unsigned xb_xcc_id() { return (unsigned)__builtin_amdgcn_s_getreg((3 << 11) | 20) & 0xFu; }
#define XB_SPIN(cond, bar) do { unsigned _sp = 0; while (cond) { __builtin_amdgcn_s_sleep(1); \
    if ((++_sp & 255u) == 0u) { if (xb_ld(&(bar)[XB_TMO])) break; if (_sp > XB_SPIN_CAP) { atomicAdd(&(bar)[XB_TMO], 1u); break; } } } } while (0)

struct XcdBarrier {
    unsigned* bar; unsigned x;
    volatile LAS unsigned* st;
};

__device__ __forceinline__ XcdBarrier xcd_barrier_post(unsigned* bar, volatile LAS unsigned* st) {
    XcdBarrier b; b.bar = bar; b.x = xb_xcc_id(); b.st = st;
    if (tid_() == 0) (void)xb_add(&bar[XB_XCNT(b.x)], 1u);
    return b;
}
__device__ __forceinline__ void xcd_barrier_complete(unsigned* bar, unsigned x, unsigned& nloc, unsigned& nx) {
    const unsigned G = gridDim.x * gridDim.y * gridDim.z;
    unsigned sum, cnt, mine, sp = 0u;
    for (;;) {
        sum = 0u; cnt = 0u; mine = 0u;
#pragma unroll
        for (unsigned j = 0; j < 16; ++j) { const unsigned c = xb_ld(&bar[XB_XCNT(j)]); sum += c; cnt += (c > 0u) ? 1u : 0u; mine = (j == x) ? c : mine; }
        if (sum == G) break;
        __builtin_amdgcn_s_sleep(1);
        if ((++sp & 255u) == 0u) { if (xb_ld(&bar[XB_TMO])) break; if (sp > XB_SPIN_CAP) { atomicAdd(&bar[XB_TMO], 1u); break; } }
    }
    nloc = mine > 0u ? mine : 1u; nx = cnt > 0u ? cnt : 1u;
}

__device__ __forceinline__ void xcd_barrier(const XcdBarrier& b) {
    asm volatile("s_waitcnt vmcnt(0)" ::: "memory");
    __syncthreads();
    if (tid_() == 0) {
        unsigned* bar = b.bar;
        __builtin_amdgcn_s_waitcnt(0);
        unsigned nloc = b.st[0], nx = b.st[1];
        if (nloc == 0u) { xcd_barrier_complete(bar, b.x, nloc, nx); b.st[0] = nloc; b.st[1] = nx; }
        const unsigned old = xb_add(&bar[XB_XSUB(b.x)], 1u);
        const unsigned gen = old / nloc;
        if (old + 1u == (gen + 1u) * nloc) {
            __builtin_amdgcn_fence(__ATOMIC_RELEASE, "agent");
            asm volatile("s_waitcnt vmcnt(0)" ::: "memory");
            const unsigned og = xb_add(&bar[XB_TOP], 1u);
            const unsigned tg = og / nx;
            if (og + 1u == (tg + 1u) * nx) xb_add(&bar[XB_TOPGEN], 1u);
            else XB_SPIN(xb_ld(&bar[XB_TOPGEN]) == tg, bar);
            __builtin_amdgcn_fence(__ATOMIC_ACQUIRE, "agent");
            xb_add(&bar[XB_XGEN(b.x)], 1u);
            asm volatile("s_waitcnt vmcnt(0)" ::: "memory");
        } else {
            XB_SPIN(xb_ld(&bar[XB_XGEN(b.x)]) == gen, bar);
            __builtin_amdgcn_fence(__ATOMIC_ACQUIRE, "agent");
            asm volatile("s_waitcnt vmcnt(0)" ::: "memory");
        }
    }
    __syncthreads();
}
namespace pg8 {
#define PG8_LAS __attribute__((address_space(3)))
typedef unsigned short bf16_t;
typedef short bf16x8 __attribute__((ext_vector_type(8)));
typedef float f32x4 __attribute__((ext_vector_type(4)));
typedef unsigned u32x4 __attribute__((ext_vector_type(4)));
constexpr int BM = 256, BK = 64, HALF = 128, HTB = HALF * BK * 2  , STAGE_BYTES = 8 * HTB, NXCD = 8, WGM = 8;

__host__ __device__ __forceinline__ int lds_byte(int r, int c) { const int st = (r >> 4) * 2 + (c >> 5), rr = r & 15, cc = c & 31, ob = rr * 64 + cc * 2; return st * 1024 + (ob ^ (((ob >> 9) & 1) << 5)); }
__host__ __device__ __forceinline__ void stage_rc(int b, int& R, int& C) { const int st = b / 1024, sb = b % 1024, swz = sb ^ (((sb >> 9) & 1) << 5); R = (st >> 1) * 16 + swz / 64; C = (st & 1) * 32 + (swz % 64) / 2; }
__host__ __device__ __forceinline__ int perm32(int rho) { const int n = rho >> 4, i = rho & 15; return 8 * (i >> 2) + 4 * n + (i & 3); }

struct Unit { int pm, pn; };
struct Gemm { const bf16_t* A; const bf16_t* Bt; int M, N, K; };

struct StaticOrder {
    int nM, nN, nwg, G, c;
    __host__ __device__ void init(int M, int N, int G_, int c_) { nM = M / BM; nN = N / BM; nwg = nM * nN; G = G_; c = c_; }
    __host__ __device__ bool next(int i, Unit& u) const {
        const long L = (long)i * G + c; if (L >= nwg) return false;
        int wgid = (int)L; { const int q = nwg / NXCD, r = nwg % NXCD, xcd = wgid % NXCD, off = wgid / NXCD; wgid = (xcd < r ? xcd * (q + 1) : r * (q + 1) + (xcd - r) * q) + off; }
        const int nig = WGM * nN, gid = wgid / nig, fm = gid * WGM, gsz = (nM - fm) < WGM ? (nM - fm) : WGM;
        u.pm = fm + ((wgid % nig) % gsz); u.pn = (wgid % nig) / gsz; return true;
    }
    __device__ __forceinline__ void a_ready(const Unit&) const {}
    __device__ __forceinline__ void done(const Unit&) const {}
};
__device__ __forceinline__ unsigned cvt_pk_bf16(float lo, float hi) { unsigned r; asm volatile("v_cvt_pk_bf16_f32 %0, %1, %2" : "=v"(r) : "v"(lo), "v"(hi)); return r; }
typedef float f32x2 __attribute__((ext_vector_type(2)));

template <class Epi, class Sched, bool STAMP = false>
__device__ __forceinline__ void gemm_phase(PG8_LAS unsigned char* lds, const Gemm g, const Sched& S, const Epi& E, unsigned long long* stamps) {
    const int tid = tid_(), wid = __builtin_amdgcn_readfirstlane(tid >> 6), lane = tid & 63, wr = wid >> 2, wc = wid & 3, fr = lane & 15, fq = lane >> 4;
    const int K = g.K, nt = K / BK;
    int ts_lo = 0, ts_hi = 0, nts = 0; const unsigned long long rt_entry = STAMP ? (unsigned long long)wall_clock64() : 0ull;
#define PG8_STAMP() do { if (STAMP && wid == 0 && nts < 64) { const unsigned long long _c = (unsigned long long)clock64(); \
        ts_lo = (lane == nts) ? (int)(unsigned)_c : ts_lo; ts_hi = (lane == nts) ? (int)(unsigned)(_c >> 32) : ts_hi; ++nts; } } while (0)
    PG8_STAMP();
    unsigned voffA[2], voffB[2];
#pragma unroll
    for (int i = 0; i < 2; ++i) { int R, C; stage_rc(tid * 16 + i * 8192, R, C); const int Rb = Epi::PERM ? ((R & ~31) + perm32(R & 31)) : R;
        voffA[i] = (unsigned)(R * K + C) * 2u; voffB[i] = (unsigned)(Rb * K + C) * 2u; }
    const size_t kstep = (size_t)(BK * 2);
    const size_t hstep = (size_t)HALF * K * 2;
    const size_t tstep = 2 * hstep;
    const unsigned ldsw = (unsigned)wid * 1024u;
    const int aoff = lds_byte(wr * 64 + fr, fq * 8), boff = lds_byte(wc * 32 + fr, fq * 8);
#define PG8_SA(b, h) (((b) * 2 + (h)) * HTB)
#define PG8_SB(b, h) ((4 + (b) * 2 + (h)) * HTB)
#define PG8_STAGE(bufoff, gbase, voff) do { _Pragma("unroll") for (int _i = 0; _i < 2; ++_i) \
        __builtin_amdgcn_global_load_lds((const unsigned*)((const char*)(gbase) + (voff)[_i]), (PG8_LAS unsigned*)(lds + (bufoff) + ldsw + _i * 8192), 16, 0, 0); } while (0)
#define PG8_LDA(dst, b, h) do { _Pragma("unroll") for (int m = 0; m < 4; ++m) _Pragma("unroll") for (int k = 0; k < 2; ++k) dst[m][k] = *(const PG8_LAS bf16x8*)(lds + PG8_SA(b, h) + aoff + m * 2048 + k * 1024); } while (0)
#define PG8_LDB(dst, b, h) do { _Pragma("unroll") for (int n = 0; n < 2; ++n) _Pragma("unroll") for (int k = 0; k < 2; ++k) dst[n][k] = *(const PG8_LAS bf16x8*)(lds + PG8_SB(b, h) + boff + n * 2048 + k * 1024); } while (0)
#define PG8_MMA(ai, bj, At, Bt) do { __builtin_amdgcn_s_setprio(1); _Pragma("unroll") for (int m = 0; m < 4; ++m) _Pragma("unroll") for (int n = 0; n < 2; ++n) _Pragma("unroll") for (int k = 0; k < 2; ++k) \
        acc[ai][bj][m][n] = __builtin_amdgcn_mfma_f32_16x16x32_bf16(Bt[n][k], At[m][k], acc[ai][bj][m][n], 0, 0, 0); __builtin_amdgcn_s_setprio(0); } while (0)
#define PG8_WAIT_V(n) asm volatile("s_waitcnt vmcnt(" #n ")" ::: "memory")
#define PG8_WAIT_L(n) asm volatile("s_waitcnt lgkmcnt(" #n ")" ::: "memory")
#define PG8_BAR __builtin_amdgcn_s_barrier()
#define PG8_SCHED __builtin_amdgcn_sched_barrier(0)
    Unit cur, nxt; int ui = 0;
    if (!S.next(0, cur)) return;
    f32x4 acc[2][2][4][2];
#pragma unroll
    for (int a = 0; a < 2; ++a)
#pragma unroll
        for (int b = 0; b < 2; ++b)
#pragma unroll
            for (int m = 0; m < 4; ++m)
#pragma unroll
                for (int n = 0; n < 2; ++n) acc[a][b][m][n] = (f32x4){0.f, 0.f, 0.f, 0.f};
    bf16x8 At[4][2], B0[2][2], B1[2][2];
    const char* cA = (const char*)g.A + (size_t)cur.pm * tstep; const char* cB = (const char*)g.Bt + (size_t)cur.pn * tstep;
    S.a_ready(cur);
    PG8_STAGE(PG8_SB(0, 0), cB, voffB); PG8_STAGE(PG8_SA(0, 0), cA, voffA); PG8_STAGE(PG8_SB(0, 1), cB + hstep, voffB); PG8_STAGE(PG8_SA(0, 1), cA + hstep, voffA);
    if (wr == 1) PG8_BAR;
    PG8_WAIT_V(4); PG8_BAR;
    PG8_STAGE(PG8_SB(1, 0), cB + kstep, voffB); PG8_STAGE(PG8_SA(1, 0), cA + kstep, voffA); PG8_STAGE(PG8_SB(1, 1), cB + hstep + kstep, voffB);
    PG8_WAIT_V(6); PG8_BAR;
    PG8_STAMP();
    for (;;) {
        const bool has_next = S.next(ui + 1, nxt);
        const char* nA = has_next ? (const char*)g.A + (size_t)nxt.pm * tstep : cA; const char* nB = has_next ? (const char*)g.Bt + (size_t)nxt.pn * tstep : cB;
        for (int t = 0; t < nt; t += 2) {
            const bool last = (t == nt - 2);
            const char* a1 = cA + (size_t)(t + 1) * kstep;
            const char* a2 = last ? nA : cA + (size_t)(t + 2) * kstep; const char* b2 = last ? nB : cB + (size_t)(t + 2) * kstep;
            const char* a3 = a2 + kstep; const char* b3 = b2 + kstep;
            if (last && has_next) S.a_ready(nxt);
            PG8_LDB(B0, 0, 0); PG8_SCHED; PG8_LDA(At, 0, 0); PG8_STAGE(PG8_SA(1, 1), a1 + hstep, voffA);
            PG8_WAIT_L(8); PG8_BAR; PG8_WAIT_L(0); PG8_MMA(0, 0, At, B0); PG8_BAR; PG8_SCHED;
            PG8_LDB(B1, 0, 1); PG8_STAGE(PG8_SB(0, 0), b2, voffB);
            PG8_BAR; PG8_WAIT_L(0); PG8_MMA(0, 1, At, B1); PG8_BAR;
            PG8_LDA(At, 0, 1); PG8_STAGE(PG8_SA(0, 0), a2, voffA);
            PG8_BAR; PG8_WAIT_L(0); PG8_MMA(1, 0, At, B0); PG8_BAR; PG8_SCHED;
            PG8_STAGE(PG8_SB(0, 1), b2 + hstep, voffB);
            PG8_WAIT_V(6); PG8_BAR; PG8_MMA(1, 1, At, B1); PG8_BAR;
            PG8_LDB(B0, 1, 0); PG8_SCHED; PG8_LDA(At, 1, 0); PG8_STAGE(PG8_SA(0, 1), a2 + hstep, voffA);
            PG8_WAIT_L(8); PG8_BAR; PG8_WAIT_L(0); PG8_MMA(0, 0, At, B0); PG8_BAR; PG8_SCHED;
            PG8_LDB(B1, 1, 1); PG8_STAGE(PG8_SB(1, 0), b3, voffB);
            PG8_BAR; PG8_WAIT_L(0); PG8_MMA(0, 1, At, B1); PG8_BAR;
            PG8_LDA(At, 1, 1); PG8_STAGE(PG8_SA(1, 0), a3, voffA);
            PG8_BAR; PG8_WAIT_L(0); PG8_MMA(1, 0, At, B0); PG8_BAR; PG8_SCHED;
            PG8_STAGE(PG8_SB(1, 1), b3 + hstep, voffB);
            PG8_WAIT_V(6); PG8_BAR; PG8_MMA(1, 1, At, B1); PG8_BAR;
        }
        PG8_STAMP();
        if constexpr (!Epi::AFTER_DRAIN) { E(acc, cur, wr, wc, fr, fq); S.done(cur); }
        PG8_STAMP();
        if (!has_next) break;
#pragma unroll
        for (int a = 0; a < 2; ++a)
#pragma unroll
            for (int b = 0; b < 2; ++b)
#pragma unroll
                for (int m = 0; m < 4; ++m)
#pragma unroll
                    for (int n = 0; n < 2; ++n) acc[a][b][m][n] = (f32x4){0.f, 0.f, 0.f, 0.f};
        cur = nxt; cA = nA; cB = nB; ++ui;
    }
    PG8_WAIT_V(0);
    if (wr == 0) PG8_BAR;
    PG8_BAR;
    if constexpr (Epi::AFTER_DRAIN) { E.fused(acc, cur, wr, wc, fr, fq, lds, wid, lane); S.done(cur); }
    PG8_STAMP();
    if (STAMP && wid == 0) { stamps[lane] = lane < nts ? (((unsigned long long)(unsigned)ts_hi << 32) | (unsigned)ts_lo) : 0ull;
        if (lane == 62) stamps[62] = rt_entry; if (lane == 63) stamps[63] = (unsigned long long)wall_clock64(); }
#undef PG8_STAMP
#undef PG8_SA
#undef PG8_SB
#undef PG8_STAGE
#undef PG8_LDA
#undef PG8_LDB
#undef PG8_MMA
#undef PG8_WAIT_V
#undef PG8_WAIT_L
#undef PG8_BAR
#undef PG8_SCHED
}
}

typedef unsigned short bf16_t;
typedef short bf16x8 __attribute__((ext_vector_type(8)));
typedef float f32x4 __attribute__((ext_vector_type(4)));
typedef float f32x2 __attribute__((ext_vector_type(2)));
typedef unsigned u32x4 __attribute__((ext_vector_type(4)));
typedef unsigned u32x2 __attribute__((ext_vector_type(2)));

constexpr int D = 1024, NB = 4, T = 4096, NL = 4, BT = NB * T, BW = 512;
constexpr int DIN = 8320, DINP = 8448;
constexpr int C_PU = 0, C_PG = 512, C_Q = 1024, C_K = 1536, C_V = 2048, C_RG = 2560, C_RW = 3072, C_RWG = 4736, C_GATE = 5248;
constexpr int RW_R = 0, RW_WL = 512, RW_K = 576, RW_V = 1088, RW_AL = 1600, RW_W = 1664;
constexpr int SREC = 896;
constexpr int LDS_MAIN = 147456, LDS_BYTES = LDS_MAIN + 64;

constexpr size_t SZ_WIN = (size_t)DINP * D * 2, SZ_WBR = (size_t)3 * D * BW * 2, SZ_WOUT = (size_t)D * D * 2, SZ_LORA = (size_t)BW * 64 * 2;
constexpr size_t OFF_WIN = 0, OFF_WBR = OFF_WIN + SZ_WIN, OFF_WOUT = OFF_WBR + SZ_WBR, OFF_W2T = OFF_WOUT + SZ_WOUT, OFF_A2T = OFF_W2T + SZ_LORA;
constexpr size_t IMG_STRIDE = OFF_A2T + SZ_LORA;
constexpr size_t OFF_MOD = 2 * IMG_STRIDE, SZ_MOD = (size_t)NL * NB * 3 * D * 4;
constexpr size_t OFF_COS = OFF_MOD + SZ_MOD, SZ_TAB = (size_t)BT * 64 * 4, OFF_SIN = OFF_COS + SZ_TAB;
constexpr size_t OFF_BONUS = OFF_SIN + SZ_TAB, SZ_BONUS = (size_t)BT * 8 * 4;
constexpr size_t OFF_PROJ = OFF_BONUS + SZ_BONUS, SZ_PROJ = (size_t)BT * DINP * 2;
constexpr size_t OFF_BR = OFF_PROJ + SZ_PROJ, SZ_BR = (size_t)3 * BT * BW * 2;
constexpr size_t OFF_X = OFF_BR + SZ_BR;
constexpr size_t OFF_H = OFF_X;
constexpr size_t OFF_STREAM = OFF_X, SZ_STREAM = (size_t)BT * 8 * SREC;
constexpr size_t OFF_KVT = OFF_BR + SZ_BR / 3, SZ_KVT = (size_t)16 * 32 * 128 * 128 * 4;
constexpr size_t OFF_RPREV = OFF_STREAM + SZ_STREAM, SZ_RPREV = SZ_KVT / 2;
constexpr size_t OFF_MERGED = OFF_X, SZ_MERGED = (size_t)BT * D * 4;
constexpr size_t OFF_MERGEDB = OFF_MERGED + SZ_MERGED;
constexpr size_t OFF_H0F = OFF_RPREV + SZ_RPREV, SZ_H0F = (size_t)NB * D * 4;
constexpr int P0W = 2304;
constexpr size_t OFF_P0F = OFF_H0F + SZ_H0F, SZ_P0F = (size_t)NB * P0W * 4;
constexpr size_t OFF_CACC = OFF_P0F + SZ_P0F, SZ_CACC = 256;
constexpr size_t OFF_SACC = OFF_CACC + 128;
constexpr size_t OFF_BAR = OFF_CACC + SZ_CACC, SZ_BAR = (size_t)XCD_BAR_WORDS * 4;
constexpr size_t WS_NEED = OFF_BAR + SZ_BAR;

struct Params {
    const float* x; const float* c; const int* pos;
    const float *norm_g, *w_ada, *b_ada, *w_in, *pool_w, *pool_scale, *ret_norm_g, *shift_mu, *w0, *w2, *a0, *a2, *k_k, *k_a, *r_k, *ln_w, *ln_b, *w_branch, *w_out, *final_g;
    float* out; unsigned char* ws; size_t img_off;
};

__device__ __forceinline__ float bf2f(unsigned v) { return __uint_as_float(v << 16); }
__device__ __forceinline__ float bflo(unsigned v) { return __uint_as_float(v << 16); }
__device__ __forceinline__ float bfhi(unsigned v) { return __uint_as_float(v & 0xffff0000u); }
__device__ __forceinline__ unsigned pk2(float lo, float hi) { return pg8::cvt_pk_bf16(lo, hi); }
__device__ __forceinline__ bf16_t f2bf(float f) { return (bf16_t)(pk2(f, 0.f) & 0xffffu); }
__device__ __forceinline__ float sigmoidf_(float x) { return __builtin_amdgcn_rcpf(1.0f + __expf(-x)); }
__device__ __forceinline__ float siluf_(float x) { return x / (1.0f + __expf(-x)); }

__device__ __forceinline__ void unpack8(const u32x4 a, float (&o)[8]) { o[0] = bflo(a.x); o[1] = bfhi(a.x); o[2] = bflo(a.y); o[3] = bfhi(a.y); o[4] = bflo(a.z); o[5] = bfhi(a.z); o[6] = bflo(a.w); o[7] = bfhi(a.w); }
__device__ __forceinline__ u32x4 pack8(const float (&o)[8]) { u32x4 w; w.x = pk2(o[0], o[1]); w.y = pk2(o[2], o[3]); w.z = pk2(o[4], o[5]); w.w = pk2(o[6], o[7]); return w; }
__device__ __forceinline__ void ldf8(const float* p, float (&o)[8]) { const f32x4 a = *(const f32x4*)p, b = *(const f32x4*)(p + 4); o[0] = a[0]; o[1] = a[1]; o[2] = a[2]; o[3] = a[3]; o[4] = b[0]; o[5] = b[1]; o[6] = b[2]; o[7] = b[3]; }
template <int CTRL> __device__ __forceinline__ float dpp_mov(float v) { return __int_as_float(__builtin_amdgcn_update_dpp(0, __float_as_int(v), CTRL, 0xF, 0xF, false)); }
__device__ __forceinline__ float red16(float v) {
    v += dpp_mov<0xB1>(v);
    v += dpp_mov<0x4E>(v);
    v += dpp_mov<0x141>(v);
    v += dpp_mov<0x140>(v);
    return v;
}
__device__ __forceinline__ float red64(float v) {
    v = red16(v);
    v += __shfl_xor(v, 16); v += __shfl_xor(v, 32);
    return v;
}

constexpr int LDS_LD = 136;
__device__ __forceinline__ void strip_mma(const LAS bf16_t* A, int row0, const LAS bf16_t* Bm, f32x4 (&acc)[8], int fr, int fq) {
#pragma unroll
    for (int kk = 0; kk < 4; ++kk) {
        const bf16x8 a = *(const LAS bf16x8*)(A + (row0 + fr) * LDS_LD + kk * 32 + fq * 8);
#pragma unroll
        for (int n = 0; n < 8; ++n) {
            const bf16x8 b = *(const LAS bf16x8*)(Bm + (n * 16 + fr) * LDS_LD + kk * 32 + fq * 8);
            acc[n] = __builtin_amdgcn_mfma_f32_16x16x32_bf16(a, b, acc[n], 0, 0, 0);
        }
    }
}

struct EpiProj {
    static constexpr bool PERM = true, AFTER_DRAIN = false;
    bf16_t* O;
    __device__ __forceinline__ void operator()(const f32x4 (&acc)[2][2][4][2], const pg8::Unit& u, int wr, int wc, int fr, int fq) const {
        const int row0 = u.pm * 256 + wr * 64 + fr, col0 = u.pn * 256 + wc * 32 + 8 * fq;
#pragma unroll
        for (int ai = 0; ai < 2; ++ai)
#pragma unroll
            for (int m = 0; m < 4; ++m) { bf16_t* rowp = O + (size_t)(row0 + ai * 128 + m * 16) * DINP + col0;
#pragma unroll
                for (int bj = 0; bj < 2; ++bj) { const f32x4 v0 = acc[ai][bj][m][0], v1 = acc[ai][bj][m][1];
                    u32x4 w; w.x = pk2(v0[0], v0[1]); w.y = pk2(v0[2], v0[3]); w.z = pk2(v1[0], v1[1]); w.w = pk2(v1[2], v1[3]);
                    *(u32x4*)(rowp + bj * 128) = w; } }
    }
};
template <int NBR> struct EpiMerge {
    static constexpr bool PERM = true, AFTER_DRAIN = false;
    const bf16_t* proj; float* merged; bf16_t* mergedb;
    __device__ __forceinline__ void operator()(const f32x4 (&acc)[2][2][4][2], const pg8::Unit& u, int wr, int wc, int fr, int fq) const {
        const int row0 = u.pm * 256 + wr * 64 + fr, col0 = u.pn * 256 + wc * 32 + 8 * fq;
#pragma unroll
        for (int ai = 0; ai < 2; ++ai)
#pragma unroll
            for (int m = 0; m < 4; ++m) {
                const size_t row = (size_t)(row0 + ai * 128 + m * 16);
#pragma unroll
                for (int bj = 0; bj < 2; ++bj) {
                    const int col = col0 + bj * 128;
                    const u32x4 lg = *(const u32x4*)(proj + row * DINP + C_GATE + NBR * D + col);
                    const f32x4 v0 = acc[ai][bj][m][0], v1 = acc[ai][bj][m][1];
                    f32x4 o0, o1;
                    o0[0] = sigmoidf_(bflo(lg.x)) * v0[0]; o0[1] = sigmoidf_(bfhi(lg.x)) * v0[1]; o0[2] = sigmoidf_(bflo(lg.y)) * v0[2]; o0[3] = sigmoidf_(bfhi(lg.y)) * v0[3];
                    o1[0] = sigmoidf_(bflo(lg.z)) * v1[0]; o1[1] = sigmoidf_(bfhi(lg.z)) * v1[1]; o1[2] = sigmoidf_(bflo(lg.w)) * v1[2]; o1[3] = sigmoidf_(bfhi(lg.w)) * v1[3];
                    float* mp = merged + row * D + col;
                    if (NBR > 0) { o0 += *(const f32x4*)mp; o1 += *(const f32x4*)(mp + 4); }
                    if (NBR < 2) { *(f32x4*)mp = o0; *(f32x4*)(mp + 4) = o1; }
                    else { u32x4 w; w.x = pk2(o0[0], o0[1]); w.y = pk2(o0[2], o0[3]); w.z = pk2(o1[0], o1[1]); w.w = pk2(o1[2], o1[3]); *(u32x4*)(mergedb + row * D + col) = w; }
                }
            }
    }
};

struct MergeOrder {
    pg8::StaticOrder base;
    __device__ __forceinline__ bool next(int i, pg8::Unit& u) const { const int r = i / 3, n = i - 3 * r; pg8::Unit t; if (!base.next(r, t)) return false; u.pm = n * 64 + t.pm; u.pn = n * 4 + t.pn; return true; }
    __device__ __forceinline__ void a_ready(const pg8::Unit&) const {}
    __device__ __forceinline__ void done(const pg8::Unit&) const {}
};
struct EpiMergeAll {
    static constexpr bool PERM = true, AFTER_DRAIN = false;
    const bf16_t* proj; float* merged; bf16_t* mergedb;
    __device__ __forceinline__ void operator()(const f32x4 (&acc)[2][2][4][2], const pg8::Unit& u, int wr, int wc, int fr, int fq) const {
        const int n = u.pm >> 6; pg8::Unit t; t.pm = u.pm & 63; t.pn = u.pn & 3;
        if (n == 0) { EpiMerge<0> e{proj, merged, mergedb}; e(acc, t, wr, wc, fr, fq); }
        else if (n == 1) { EpiMerge<1> e{proj, merged, mergedb}; e(acc, t, wr, wc, fr, fq); }
        else { EpiMerge<2> e{proj, merged, mergedb}; e(acc, t, wr, wc, fr, fq); }
    }
};
struct EpiOut {
    static constexpr bool PERM = false, AFTER_DRAIN = false;
    const float* xin; float* xout; const float* gate;
    __device__ __forceinline__ void operator()(const f32x4 (&acc)[2][2][4][2], const pg8::Unit& u, int wr, int wc, int fr, int fq) const {
        const int row0 = u.pm * 256 + wr * 64 + fr, col0 = u.pn * 256 + wc * 32 + 4 * fq;
        const float* gp = gate + (size_t)(u.pm >> 4) * 3 * D + col0;
        f32x4 gv[2][2];
#pragma unroll
        for (int bj = 0; bj < 2; ++bj)
#pragma unroll
            for (int n = 0; n < 2; ++n) gv[bj][n] = *(const f32x4*)(gp + bj * 128 + n * 16);
#pragma unroll
        for (int ai = 0; ai < 2; ++ai)
#pragma unroll
            for (int m = 0; m < 4; ++m) {
                const size_t ro = (size_t)(row0 + ai * 128 + m * 16) * D + col0;
#pragma unroll
                for (int bj = 0; bj < 2; ++bj)
#pragma unroll
                    for (int n = 0; n < 2; ++n) {
                        const f32x4 xi = *(const f32x4*)(xin + ro + bj * 128 + n * 16);
                        *(f32x4*)(xout + ro + bj * 128 + n * 16) = xi + gv[bj][n] * acc[ai][bj][m][n];
                    }
            }
    }
};

__device__ __forceinline__ void phase0(const Params& p, unsigned char* shm) {
    const int tid = tid_(), wid = tid >> 6, lane = tid & 63;
    const int gtid = blockIdx.x * 512 + tid, nth = gridDim.x * 512;
    { const int nz = (DINP - DIN) * D * 2 / 16;
      for (int st_ = 0; st_ < 2; ++st_) { u32x4* z = (u32x4*)(p.ws + st_ * IMG_STRIDE + OFF_WIN + (size_t)DIN * D * 2);
        for (int i = gtid; i < nz; i += nth) z[i] = (u32x4){0u, 0u, 0u, 0u}; } }
    { float* COS = (float*)(p.ws + OFF_COS); float* SIN = (float*)(p.ws + OFF_SIN);
      for (int idx = gtid; idx < BT * 64; idx += nth) {
          const int i = idx & 63, tok = idx >> 6;
          double f = 1.0; for (int j = 0; j < i; ++j) f *= 0.8659643233600653;
          const float freq = (float)f;
          const float ang = (float)p.pos[tok] * freq;
          const double ad = (double)ang;
          const double nq = rint(ad * 0.6366197723675814);
          double r = fma(-nq, 1.5707963267948966, ad); r = fma(-nq, 6.123233995736766e-17, r);
          const float rf = (float)r; const float sr = sinf(rf), cr = cosf(rf);
          const int q = ((int)nq) & 3;
          float s, c;
          if (q == 0) { s = sr; c = cr; } else if (q == 1) { s = cr; c = -sr; } else if (q == 2) { s = -sr; c = -cr; } else { s = -cr; c = sr; }
          COS[idx] = c; SIN[idx] = s;
      } }
    float* cs = (float*)shm;
    float* red = cs + 4096;
    for (int i = tid; i < 4096; i += 512) { const int b = i >> 10, k = i & 1023; cs[k * 4 + b] = siluf_(p.c[b * 1024 + k]); }
    __syncthreads();
    float* mod = (float*)(p.ws + OFF_MOD);
    for (int item = blockIdx.x; item < NL * 48; item += gridDim.x) {
        const int l = item / 48, cgp = item % 48, col = cgp * 64 + lane;
        const float* wp = p.w_ada + (size_t)l * D * 3 * D + col;
        const int k0 = wid * 128;
        float a0 = 0.f, a1 = 0.f, a2 = 0.f, a3 = 0.f;
#pragma unroll 32
        for (int k = k0; k < k0 + 128; ++k) { const float w = wp[(size_t)k * 3 * D]; const f32x4 c4 = *(const f32x4*)(cs + k * 4); a0 += w * c4[0]; a1 += w * c4[1]; a2 += w * c4[2]; a3 += w * c4[3]; }
        red[(wid * 4 + 0) * 64 + lane] = a0; red[(wid * 4 + 1) * 64 + lane] = a1; red[(wid * 4 + 2) * 64 + lane] = a2; red[(wid * 4 + 3) * 64 + lane] = a3;
        __syncthreads();
        if (tid < 256) { const int b = tid >> 6; float s = 0.f;
#pragma unroll
            for (int w = 0; w < 8; ++w) s += red[(w * 4 + b) * 64 + lane];
            mod[(size_t)(l * NB + b) * 3 * D + col] = s + p.b_ada[l * 3 * D + col]; }
        __syncthreads();
    }
}

__device__ __forceinline__ void tconv64(const float* src, int ld_src, bf16_t* dst, int ld_dst, int r0, int c0, float* tile) {
    const int tid = tid_();
    { const int r = tid >> 3, cc = (tid & 7) * 8; const float* sp = src + (size_t)(r0 + r) * ld_src + c0 + cc;
      const f32x4 v0 = *(const f32x4*)sp, v1 = *(const f32x4*)(sp + 4); float* tp = tile + r * 65 + cc;
      tp[0] = v0[0]; tp[1] = v0[1]; tp[2] = v0[2]; tp[3] = v0[3]; tp[4] = v1[0]; tp[5] = v1[1]; tp[6] = v1[2]; tp[7] = v1[3]; }
    __syncthreads();
    { const int c = tid >> 3, rc = (tid & 7) * 8; const float* tp = tile + rc * 65 + c;
      u32x4 w; w.x = pk2(tp[0], tp[65]); w.y = pk2(tp[130], tp[195]); w.z = pk2(tp[260], tp[325]); w.w = pk2(tp[390], tp[455]);
      *(u32x4*)(dst + (size_t)(c0 + c) * ld_dst + r0 + rc) = w; }
    __syncthreads();
}
__device__ __forceinline__ void poolfold64(const float* w_in_l, const float* pool_w_l, bf16_t* dst, int k0, int n0, float* lds) {
    const int tid = tid_(), g = n0 >> 7, nb = n0 & 127;
    float* Ain = lds;
    float* Pw = lds + 64 * 129;
    for (int i = tid; i < 64 * 32; i += 512) { const int r = i >> 5, c4 = (i & 31) * 4; const f32x4 v = *(const f32x4*)(w_in_l + (size_t)(k0 + r) * DIN + g * 128 + c4);
        float* tp = Ain + r * 129 + c4; tp[0] = v[0]; tp[1] = v[1]; tp[2] = v[2]; tp[3] = v[3]; }
    for (int i = tid; i < 128 * 16; i += 512) { const int c = i >> 4, n4 = (i & 15) * 4; const f32x4 v = *(const f32x4*)(pool_w_l + (size_t)(g * 128 + c) * 128 + nb + n4);
        float* tp = Pw + c * 65 + n4; tp[0] = v[0]; tp[1] = v[1]; tp[2] = v[2]; tp[3] = v[3]; }
    __syncthreads();
    { const int nn = tid >> 3, rc = (tid & 7) * 8; float acc[8];
#pragma unroll
      for (int i = 0; i < 8; ++i) acc[i] = 0.f;
      for (int c = 0; c < 128; ++c) { const float pw = Pw[c * 65 + nn];
#pragma unroll
          for (int i = 0; i < 8; ++i) acc[i] += Ain[(rc + i) * 129 + c] * pw; }
      u32x4 w; w.x = pk2(acc[0], acc[1]); w.y = pk2(acc[2], acc[3]); w.z = pk2(acc[4], acc[5]); w.w = pk2(acc[6], acc[7]);
      *(u32x4*)(dst + (size_t)(n0 + nn) * D + k0 + rc) = w; }
    __syncthreads();
}
__device__ __forceinline__ void phase_weights(const Params& p, int l, unsigned char* shm, int job0, int jstride) {
    float* tile = (float*)shm;
    unsigned char* img = p.ws + p.img_off;
    bf16_t* Wt_in = (bf16_t*)(img + OFF_WIN); bf16_t* Wt_br = (bf16_t*)(img + OFF_WBR); bf16_t* Wt_out = (bf16_t*)(img + OFF_WOUT);
    bf16_t* W2T = (bf16_t*)(img + OFF_W2T); bf16_t* A2T = (bf16_t*)(img + OFF_A2T);
    const float* w_in_l = p.w_in + (size_t)l * D * DIN;
    constexpr int J_IN = 16 * 130, J_BR = 3 * 8 * 16, J_OUT = 16 * 16, J_LORA = 16;
    constexpr int NJ = J_IN + J_BR + J_OUT + J_LORA;
    for (int job = job0; job < NJ; job += jstride) {
        int j = job;
        if (j < J_IN) { const int kt = j & 15, nt = j >> 4;
            if (nt < 8) poolfold64(w_in_l, p.pool_w + (size_t)l * 4 * 128 * 128, Wt_in, kt * 64, nt * 64, tile);
            else tconv64(w_in_l, DIN, Wt_in, D, kt * 64, nt * 64, tile);
            continue; }
        j -= J_IN;
        if (j < J_BR) { const int nb = j / 128, r = j % 128, wt = r & 7, dt = r >> 3;
            tconv64(p.w_branch + ((size_t)l * 3 + nb) * BW * D, D, Wt_br + (size_t)nb * D * BW, BW, wt * 64, dt * 64, tile); continue; }
        j -= J_BR;
        if (j < J_OUT) { const int kt = j & 15, dt = j >> 4; tconv64(p.w_out + (size_t)l * D * D, D, Wt_out, D, kt * 64, dt * 64, tile); continue; }
        j -= J_OUT;
        if (j < 8) tconv64(p.w2 + (size_t)l * 64 * BW, BW, W2T, 64, 0, j * 64, tile);
        else tconv64(p.a2 + (size_t)l * 64 * BW, BW, A2T, 64, 0, (j - 8) * 64, tile);
    }
}
__device__ __forceinline__ void phase_norm(const Params& p, int l, const float* xin) {
    const int tid = tid_(), wid = tid >> 6, lane = tid & 63;
    bf16_t* h = (bf16_t*)(p.ws + OFF_H);
    const float* mod = (const float*)(p.ws + OFF_MOD) + (size_t)l * NB * 3 * D;
    const float* g = p.norm_g + l * D;
    { float* z = (float*)(p.ws + OFF_P0F); const int g_ = blockIdx.x * 512 + tid; if (g_ < NB * P0W) z[g_] = 0.f; }
    for (int row = blockIdx.x * 8 + wid; row < BT; row += gridDim.x * 8) {
        const int b = row >> 12;
        const float* xp = xin + (size_t)row * D;
        f32x4 v[4]; float ss = 0.f;
#pragma unroll
        for (int j = 0; j < 2; ++j) { v[2 * j] = *(const f32x4*)(xp + j * 512 + lane * 8); v[2 * j + 1] = *(const f32x4*)(xp + j * 512 + lane * 8 + 4); }
#pragma unroll
        for (int j = 0; j < 4; ++j) ss += v[j][0] * v[j][0] + v[j][1] * v[j][1] + v[j][2] * v[j][2] + v[j][3] * v[j][3];
        ss = red64(ss);
        const float rstd = rsqrtf(ss * (1.0f / D) + 1e-6f);
        const float* sh = mod + (size_t)b * 3 * D; const float* sc = sh + D;
#pragma unroll
        for (int j = 0; j < 2; ++j) {
            const int c0 = j * 512 + lane * 8; float o[8];
#pragma unroll
            for (int i = 0; i < 8; ++i) { const float xv = v[2 * j + (i >> 2)][i & 3]; o[i] = xv * rstd * g[c0 + i] * (1.0f + sc[c0 + i]) + sh[c0 + i]; }
            u32x4 w; w.x = pk2(o[0], o[1]); w.y = pk2(o[2], o[3]); w.z = pk2(o[4], o[5]); w.w = pk2(o[6], o[7]);
            *(u32x4*)(h + (size_t)row * D + c0) = w;
            if ((row & (T - 1)) == 0) { float* hf = (float*)(p.ws + OFF_H0F) + (size_t)b * D + c0;
                *(f32x4*)hf = (f32x4){o[0], o[1], o[2], o[3]}; *(f32x4*)(hf + 4) = (f32x4){o[4], o[5], o[6], o[7]}; }
        }
    }
}
__device__ __forceinline__ void gemv0_item(const Params& p, int l, int item, unsigned char* shm) {
    const int tid = tid_(), wid = tid >> 6, lane = tid & 63, cg_ = item >> 2, kc = item & 3;
    float* red = (float*)shm;
    const float* h0 = (const float*)(p.ws + OFF_H0F);
    const int src = cg_ < 8 ? C_RW + RW_R + 64 * cg_ : cg_ < 16 ? C_RW + RW_K + 64 * (cg_ - 8) : cg_ == 16 ? C_RW + RW_AL : cg_ < 25 ? C_Q + 64 * (cg_ - 17) : C_K + 64 * (cg_ - 25);
    const int dst = cg_ < 8 ? 64 * cg_ : cg_ < 16 ? 512 + 64 * (cg_ - 8) : cg_ == 16 ? 1024 : 1152 + 64 * (cg_ - 17);
    const int k0 = kc * 256 + wid * 32;
    const float* wp = p.w_in + (size_t)l * D * DIN + (size_t)k0 * DIN + src + lane;
    float w[32];
#pragma unroll
    for (int i = 0; i < 32; ++i) w[i] = wp[(size_t)i * DIN];
    float a0 = 0.f, a1 = 0.f, a2 = 0.f, a3 = 0.f;
#pragma unroll
    for (int i = 0; i < 32; ++i) { a0 += w[i] * h0[k0 + i]; a1 += w[i] * h0[D + k0 + i]; a2 += w[i] * h0[2 * D + k0 + i]; a3 += w[i] * h0[3 * D + k0 + i]; }
    red[(wid * 4 + 0) * 64 + lane] = a0; red[(wid * 4 + 1) * 64 + lane] = a1; red[(wid * 4 + 2) * 64 + lane] = a2; red[(wid * 4 + 3) * 64 + lane] = a3;
    __syncthreads();
    if (tid < 256) { const int b = tid >> 6; float sm = 0.f;
#pragma unroll
        for (int w_ = 0; w_ < 8; ++w_) sm += red[(w_ * 4 + b) * 64 + lane];
        atomicAdd((float*)(p.ws + OFF_P0F) + (size_t)b * P0W + dst + lane, sm); }
    __syncthreads();
}

__device__ __forceinline__ void phase_final_norm(const Params& p) {
    const int tid = tid_(), wid = tid >> 6, lane = tid & 63;
    for (int row = blockIdx.x * 8 + wid; row < BT; row += gridDim.x * 8) {
        float* xp = p.out + (size_t)row * D;
        f32x4 v[4]; float ss = 0.f;
#pragma unroll
        for (int j = 0; j < 4; ++j) v[j] = *(const f32x4*)(xp + j * 256 + lane * 4);
#pragma unroll
        for (int j = 0; j < 4; ++j) ss += v[j][0] * v[j][0] + v[j][1] * v[j][1] + v[j][2] * v[j][2] + v[j][3] * v[j][3];
        ss = red64(ss);
        const float rstd = rsqrtf(ss * (1.0f / D) + 1e-6f);
#pragma unroll
        for (int j = 0; j < 4; ++j) { const f32x4 gg = *(const f32x4*)(p.final_g + j * 256 + lane * 4); *(f32x4*)(xp + j * 256 + lane * 4) = v[j] * rstd * gg; }
    }
}

__device__ __forceinline__ void pool_item(const Params& p, int l, int item) {
    const int tid = tid_(), cv = tid & 63, tl = tid >> 6, c0 = cv * 8, g = c0 >> 7, win = 2 << g;
    const bf16_t* proj = (const bf16_t*)(p.ws + OFF_PROJ);
    bf16_t* br0 = (bf16_t*)(p.ws + OFF_BR);
    float sc[8]; ldf8(p.pool_scale + l * BW + c0, sc);
    const int tokA = item * 64 + tl * 8, tposA = tokA & (T - 1);
    u32x4 rows[23];
#pragma unroll
    for (int i = 0; i < 23; ++i) {
        const int d = i - 15;
        const bool ok = (tposA + d >= 0) && (d > -win);
        rows[i] = ok ? *(const u32x4*)(proj + (size_t)(tokA + d) * DINP + C_PU + c0) : (u32x4){0u, 0u, 0u, 0u};
    }
    u32x4 gts[8];
#pragma unroll
    for (int tt = 0; tt < 8; ++tt) gts[tt] = *(const u32x4*)(proj + (size_t)(tokA + tt) * DINP + C_PG + c0);
#pragma unroll
    for (int tt = 0; tt < 8; ++tt) {
        const int tpos = tposA + tt, cnt = min(tpos + 1, win);
        float s[8];
#pragma unroll
        for (int i = 0; i < 8; ++i) s[i] = 0.f;
#pragma unroll
        for (int j = 0; j < 16; ++j) {
            if (j < win) { float u[8]; unpack8(rows[15 + tt - j], u);
#pragma unroll
                for (int i = 0; i < 8; ++i) s[i] += u[i]; }
        }
        const float inv = 1.0f / (float)cnt;
        float uu[8], gg[8], o[8]; unpack8(rows[15 + tt], uu); unpack8(gts[tt], gg);
#pragma unroll
        for (int i = 0; i < 8; ++i) o[i] = (s[i] * inv - uu[i]) * sc[i] * siluf_(gg[i]);
        *(u32x4*)(br0 + (size_t)(tokA + tt) * BW + c0) = pack8(o);
    }
}

__device__ __forceinline__ float ret_lg(int h) { return h == 0 ? -0.04580368961312479f : h == 1 ? -0.02272007650008353f : h == 2 ? -0.011315313227834146f : -0.005646563141142063f; }

struct RotCS { f32x4 c0, c1, s0, s1; };
__device__ __forceinline__ void fetch_cs(const Params& p, RotCS (&cs)[2], int tid, int tok0) {
    const float* COS = (const float*)(p.ws + OFF_COS); const float* SIN = (const float*)(p.ws + OFF_SIN);
#pragma unroll
    for (int it = 0; it < 2; ++it) { const int u = tid + it * 512, j = u >> 3, d0 = (u & 7) * 8;
        const float* cp = COS + (size_t)(tok0 + j) * 64 + d0; const float* sn = SIN + (size_t)(tok0 + j) * 64 + d0;
        cs[it].c0 = *(const f32x4*)cp; cs[it].c1 = *(const f32x4*)(cp + 4); cs[it].s0 = *(const f32x4*)sn; cs[it].s1 = *(const f32x4*)(sn + 4); }
}
__device__ __forceinline__ void fetch_qk(const Params& p, u32x4 (&ra)[2], u32x4 (&rb)[2], int tid, int tok0, int col) {
    const bf16_t* proj = (const bf16_t*)(p.ws + OFF_PROJ);
#pragma unroll
    for (int it = 0; it < 2; ++it) { const int u = tid + it * 512, j = u >> 3, d0 = (u & 7) * 8;
        const bf16_t* sp = proj + (size_t)(tok0 + j) * DINP + col + d0; ra[it] = *(const u32x4*)sp; rb[it] = *(const u32x4*)(sp + 64); }
}
template <bool TRANS> __device__ __forceinline__ void store_rot(LAS bf16_t* dst, const u32x4 (&ra)[2], const u32x4 (&rb)[2], const RotCS (&cs)[2], int tid, float scale, float lgt) {
#pragma unroll
    for (int it = 0; it < 2; ++it) {
        const int u = tid + it * 512, j = u >> 3, d0 = (u & 7) * 8;
        float x1[8], x2[8]; unpack8(ra[it], x1); unpack8(rb[it], x2);
        const float cc[8] = {cs[it].c0[0], cs[it].c0[1], cs[it].c0[2], cs[it].c0[3], cs[it].c1[0], cs[it].c1[1], cs[it].c1[2], cs[it].c1[3]};
        const float ss[8] = {cs[it].s0[0], cs[it].s0[1], cs[it].s0[2], cs[it].s0[3], cs[it].s1[0], cs[it].s1[1], cs[it].s1[2], cs[it].s1[3]};
        const float sc = (lgt != 0.f) ? scale * exp2f(lgt * (float)(127 - j)) : scale;
        float o1[8], o2[8];
#pragma unroll
        for (int i = 0; i < 8; ++i) { o1[i] = (x1[i] * cc[i] - x2[i] * ss[i]) * sc; o2[i] = (x1[i] * ss[i] + x2[i] * cc[i]) * sc; }
        if (TRANS) {
#pragma unroll
            for (int i = 0; i < 8; ++i) { dst[(d0 + i) * LDS_LD + j] = f2bf(o1[i]); dst[(d0 + 64 + i) * LDS_LD + j] = f2bf(o2[i]); }
        } else {
            *(LAS u32x4*)(dst + j * LDS_LD + d0) = pack8(o1); *(LAS u32x4*)(dst + j * LDS_LD + d0 + 64) = pack8(o2);
        }
    }
}
__device__ __forceinline__ void fetch_v(const Params& p, u32x4 (&rv)[4], int tid, int tok0, int col) {
    const bf16_t* proj = (const bf16_t*)(p.ws + OFF_PROJ);
#pragma unroll
    for (int it = 0; it < 4; ++it) { const int u = tid + it * 512, j = u >> 4, e0 = (u & 15) * 8; rv[it] = *(const u32x4*)(proj + (size_t)(tok0 + j) * DINP + col + e0); }
}
__device__ __forceinline__ void store_vT(LAS bf16_t* dst, const u32x4 (&rv)[4], int tid) {
#pragma unroll
    for (int it = 0; it < 4; ++it) {
        const int u = tid + it * 512, j = u >> 4, e0 = (u & 15) * 8; const u32x4 a = rv[it];
        dst[(e0 + 0) * LDS_LD + j] = (bf16_t)(a.x & 0xffffu); dst[(e0 + 1) * LDS_LD + j] = (bf16_t)(a.x >> 16);
        dst[(e0 + 2) * LDS_LD + j] = (bf16_t)(a.y & 0xffffu); dst[(e0 + 3) * LDS_LD + j] = (bf16_t)(a.y >> 16);
        dst[(e0 + 4) * LDS_LD + j] = (bf16_t)(a.z & 0xffffu); dst[(e0 + 5) * LDS_LD + j] = (bf16_t)(a.z >> 16);
        dst[(e0 + 6) * LDS_LD + j] = (bf16_t)(a.w & 0xffffu); dst[(e0 + 7) * LDS_LD + j] = (bf16_t)(a.w >> 16);
    }
}

__device__ __forceinline__ void ret_r1_item(const Params& p, int item, LAS bf16_t* lds) {
    const int tid = tid_(), wid = tid >> 6, lane = tid & 63, fr = lane & 15, fq = lane >> 4;
    const int n = item & 31, bh = item >> 5, h = bh & 3, b = bh >> 2, tok0 = b * T + n * 128;
    LAS bf16_t* KT = lds; LAS bf16_t* VT = lds + 128 * LDS_LD;
    { RotCS cs[2]; u32x4 ka[2], kb[2], rv[4];
      fetch_qk(p, ka, kb, tid, tok0, C_K + h * 128); fetch_cs(p, cs, tid, tok0); fetch_v(p, rv, tid, tok0, C_V + h * 128);
      store_rot<true>(KT, ka, kb, cs, tid, 0.08838834764831845f, ret_lg(h));
      store_vT(VT, rv, tid); }
    __syncthreads();
    f32x4 acc[8];
#pragma unroll
    for (int i = 0; i < 8; ++i) acc[i] = (f32x4){0.f, 0.f, 0.f, 0.f};
    strip_mma(VT, wid * 16, KT, acc, fr, fq);
    float* kvT = (float*)(p.ws + OFF_KVT) + ((size_t)item << 14);
#pragma unroll
    for (int nn = 0; nn < 8; ++nn)
#pragma unroll
        for (int jj = 0; jj < 4; ++jj) kvT[(wid * 16 + fq * 4 + jj) * 128 + nn * 16 + fr] = acc[nn][jj];
    __syncthreads();
}

constexpr int PREP_LD = 516;
__device__ __forceinline__ float red8(float v) {
    v += dpp_mov<0xB1>(v); v += dpp_mov<0x4E>(v); v += dpp_mov<0x141>(v);
    return v;
}
__device__ __forceinline__ void rwkv_prep_item(const Params& p, int l, int item, LAS bf16_t* lds) {
    const int tid = tid_(), wid = tid >> 6, lane = tid & 63, fr = lane & 15, fq = lane >> 4;
    const bf16_t* proj = (const bf16_t*)(p.ws + OFF_PROJ);
    const int tok0 = item * 32;
    LAS bf16_t* Aw = lds;
    LAS bf16_t* Aa = lds + 32 * 72;
    LAS float* LW = (LAS float*)(lds + 2 * 32 * 72);
    LAS float* LA = LW + 32 * PREP_LD;
    const float* mu = p.shift_mu + l * RW_W;
#pragma unroll
    for (int hh = 0; hh < 2; ++hh) {
        const int tt = (tid >> 5) + hh * 16, cc = (tid & 31) * 4, tok = tok0 + tt;
        const int ch = cc < 64 ? RW_WL + cc : RW_AL + (cc - 64);
        const u32x2 cu = *(const u32x2*)(proj + (size_t)tok * DINP + C_RW + ch);
        u32x2 pu = (u32x2){0u, 0u};
        if ((tok & (T - 1)) != 0) pu = *(const u32x2*)(proj + (size_t)(tok - 1) * DINP + C_RW + ch);
        const float xc[4] = {bflo(cu.x), bfhi(cu.x), bflo(cu.y), bfhi(cu.y)}, xp[4] = {bflo(pu.x), bfhi(pu.x), bflo(pu.y), bfhi(pu.y)};
        float o[4];
#pragma unroll
        for (int i = 0; i < 4; ++i) { o[i] = xc[i] + (xp[i] - xc[i]) * mu[ch + i]; if (cc < 64) o[i] = tanhf(o[i]); }
        LAS bf16_t* dp = (cc < 64 ? Aw + tt * 72 + cc : Aa + tt * 72 + (cc - 64));
        u32x2 w; w.x = pk2(o[0], o[1]); w.y = pk2(o[2], o[3]); *(LAS u32x2*)dp = w;
    }
    __syncthreads();
    {
        const bf16_t* W2T = (const bf16_t*)(p.ws + p.img_off + OFF_W2T); const bf16_t* A2T = (const bf16_t*)(p.ws + p.img_off + OFF_A2T);
        f32x4 lw[2][4], la[2][4];
#pragma unroll
        for (int mt = 0; mt < 2; ++mt)
#pragma unroll
            for (int n = 0; n < 4; ++n) { lw[mt][n] = (f32x4){0.f, 0.f, 0.f, 0.f}; la[mt][n] = (f32x4){0.f, 0.f, 0.f, 0.f}; }
#pragma unroll
        for (int kk = 0; kk < 2; ++kk) {
            bf16x8 aw[2], aa[2];
#pragma unroll
            for (int mt = 0; mt < 2; ++mt) { aw[mt] = *(const LAS bf16x8*)(Aw + (mt * 16 + fr) * 72 + kk * 32 + fq * 8); aa[mt] = *(const LAS bf16x8*)(Aa + (mt * 16 + fr) * 72 + kk * 32 + fq * 8); }
#pragma unroll
            for (int n = 0; n < 4; ++n) {
                const int chn = wid * 64 + n * 16 + fr;
                const bf16x8 bw = *(const bf16x8*)(W2T + (size_t)chn * 64 + kk * 32 + fq * 8);
                const bf16x8 ba = *(const bf16x8*)(A2T + (size_t)chn * 64 + kk * 32 + fq * 8);
#pragma unroll
                for (int mt = 0; mt < 2; ++mt) {
                    lw[mt][n] = __builtin_amdgcn_mfma_f32_16x16x32_bf16(aw[mt], bw, lw[mt][n], 0, 0, 0);
                    la[mt][n] = __builtin_amdgcn_mfma_f32_16x16x32_bf16(aa[mt], ba, la[mt][n], 0, 0, 0);
                }
            }
        }
#pragma unroll
        for (int mt = 0; mt < 2; ++mt)
#pragma unroll
            for (int n = 0; n < 4; ++n)
#pragma unroll
                for (int jj = 0; jj < 4; ++jj) { const int o = (mt * 16 + fq * 4 + jj) * PREP_LD + wid * 64 + n * 16 + fr; LW[o] = lw[mt][n][jj]; LA[o] = la[mt][n][jj]; }
    }
    __syncthreads();
    {
        const int cv = tid & 63, c0 = cv * 8, head = cv >> 3, cc = c0 & 63;
        float muR[8], muK[8], muV[8], w0v[8], a0v[8], kkw[8], kaw[8], rkw[8];
        ldf8(mu + RW_R + c0, muR); ldf8(mu + RW_K + c0, muK); ldf8(mu + RW_V + c0, muV);
        ldf8(p.w0 + l * BW + c0, w0v); ldf8(p.a0 + l * BW + c0, a0v); ldf8(p.k_k + l * BW + c0, kkw); ldf8(p.k_a + l * BW + c0, kaw); ldf8(p.r_k + l * BW + c0, rkw);
        unsigned char* stream = p.ws + OFF_STREAM; float* bonus = (float*)(p.ws + OFF_BONUS);
#pragma unroll
        for (int it = 0; it < 4; ++it) {
            const int tt = (tid >> 6) + it * 8, tok = tok0 + tt, tpos = tok & (T - 1), b = tok >> 12;
            const bf16_t* pc = proj + (size_t)tok * DINP + C_RW + c0;
            float rc[8], kc[8], vc[8], rp[8], kp[8], vp[8];
            unpack8(*(const u32x4*)(pc + RW_R), rc); unpack8(*(const u32x4*)(pc + RW_K), kc); unpack8(*(const u32x4*)(pc + RW_V), vc);
            if (tpos != 0) { unpack8(*(const u32x4*)(pc - DINP + RW_R), rp); unpack8(*(const u32x4*)(pc - DINP + RW_K), kp); unpack8(*(const u32x4*)(pc - DINP + RW_V), vp); }
            else {
#pragma unroll
                for (int i = 0; i < 8; ++i) { rp[i] = 0.f; kp[i] = 0.f; vp[i] = 0.f; } }
            float lwv[8], lav[8];
            { const f32x4 x0 = *(const LAS f32x4*)(LW + tt * PREP_LD + c0), x1 = *(const LAS f32x4*)(LW + tt * PREP_LD + c0 + 4), y0 = *(const LAS f32x4*)(LA + tt * PREP_LD + c0), y1 = *(const LAS f32x4*)(LA + tt * PREP_LD + c0 + 4);
#pragma unroll
              for (int i = 0; i < 4; ++i) { lwv[i] = x0[i]; lwv[4 + i] = x1[i]; lav[i] = y0[i]; lav[4 + i] = y1[i]; } }
            float rr[8], k2[8], vv[8], dec[8], av[8], kkv[8]; float ssq = 0.f, bsum = 0.f;
#pragma unroll
            for (int i = 0; i < 8; ++i) {
                const float r = rc[i] + (rp[i] - rc[i]) * muR[i], k = kc[i] + (kp[i] - kc[i]) * muK[i], v = vc[i] + (vp[i] - vc[i]) * muV[i];
                dec[i] = __expf(-0.6065306597126334f * sigmoidf_(w0v[i] + lwv[i]));
                const float a = sigmoidf_(a0v[i] + lav[i]);
                const float kq = k * kkw[i];
                ssq += kq * kq; kkv[i] = kq;
                const float kk2 = k * (1.0f + (a - 1.0f) * kaw[i]);
                bsum += r * kk2 * rkw[i];
                rr[i] = r; k2[i] = kk2; vv[i] = v; av[i] = a;
            }
            ssq = red8(ssq); bsum = red8(bsum);
            const float inv = 1.0f / fmaxf(sqrtf(ssq), 1e-12f);
            float na[8], nb[8];
#pragma unroll
            for (int i = 0; i < 8; ++i) { const float kn = kkv[i] * inv; na[i] = -kn; nb[i] = kn * av[i]; }
            unsigned char* rec = stream + ((size_t)(b * 8 + head) * T + tpos) * SREC;
            *(f32x4*)(rec + 4 * cc) = (f32x4){dec[0], dec[1], dec[2], dec[3]}; *(f32x4*)(rec + 4 * cc + 16) = (f32x4){dec[4], dec[5], dec[6], dec[7]};
            *(u32x4*)(rec + 256 + 2 * cc) = pack8(rr);
            *(u32x4*)(rec + 384 + 2 * cc) = pack8(k2);
            *(u32x4*)(rec + 512 + 2 * cc) = pack8(na);
            *(u32x4*)(rec + 640 + 2 * cc) = pack8(nb);
            *(u32x4*)(rec + 768 + 2 * cc) = pack8(vv);
            if ((cv & 7) == 0) bonus[(size_t)tok * 8 + head] = bsum;
        }
    }
    __syncthreads();
}

__device__ __forceinline__ void ret_r2(const Params& p) {
    const float* kvT = (const float*)(p.ws + OFF_KVT); bf16_t* rp = (bf16_t*)(p.ws + OFF_RPREV);
    const int gtid = blockIdx.x * 512 + tid_(), nth = gridDim.x * 512;
    for (int i2 = gtid; i2 < 16 * 8192; i2 += nth) {
        const int bh = i2 >> 13, ed = (i2 & 8191) * 2, h = bh & 3;
        const float cd = exp2f(128.0f * ret_lg(h));
        const size_t o0 = ((size_t)(bh * 32) << 14) + ed;
        f32x2 kv[31];
#pragma unroll
        for (int n = 0; n < 31; ++n) kv[n] = __builtin_nontemporal_load((const f32x2*)(kvT + o0 + ((size_t)n << 14)));
        float r0 = 0.f, r1 = 0.f;
#pragma unroll
        for (int n = 0; n < 32; ++n) {
            *(unsigned*)(rp + o0 + ((size_t)n << 14)) = pk2(r0, r1);
            if (n < 31) { r0 = cd * r0 + kv[n][0]; r1 = cd * r1 + kv[n][1]; }
        }
    }
}

constexpr int SCH = 32;
constexpr int SREC_F = 384;
constexpr int SBUF_F = SCH * SREC_F;
__device__ __forceinline__ void rwkv_scan_item(const Params& p, int item, LAS float* lds, LAS unsigned* roletab) {
    const int tid = tid_(), wid = tid >> 6, lane = tid & 63;
    const int bh = (item & 7) + 8 * ((item >> 3) & 3), rg = item >> 5, b = bh >> 3, h = bh & 7;
    const unsigned char* sbase = p.ws + OFF_STREAM + (size_t)bh * T * SREC;
    constexpr int NCH = T / SCH;
    if (lane == 0) roletab[wid] = (unsigned)__builtin_amdgcn_s_getreg((1 << 11) | (4 << 6) | 4) & 3u;
    __syncthreads();
    int srole = -1, lrole = -1;
    {
        int sd[8];
#pragma unroll
        for (int i = 0; i < 8; ++i) sd[i] = (int)roletab[i];
        const int sA = 0; int sB = -1;
#pragma unroll
        for (int i = 1; i < 8; ++i) if (sB < 0 && sd[i] != sd[0]) sB = i;
        if (sB < 0) sB = 1;
        int nl = 0;
#pragma unroll
        for (int i = 0; i < 8; ++i) { const bool free_ = (i != sA) && (i != sB) && sd[i] != sd[sA] && sd[i] != sd[sB]; if (free_ && nl < 4) { if (i == wid) lrole = nl; ++nl; } }
#pragma unroll
        for (int i = 0; i < 8; ++i) { const bool other = (i != sA) && (i != sB) && !(sd[i] != sd[sA] && sd[i] != sd[sB]); if (other && nl < 4) { if (i == wid) lrole = nl; ++nl; } }
        if (wid == sA) srole = 0; else if (wid == sB) srole = 1;
    }
    const bool scanner = srole >= 0, loader = lrole >= 0;
    const int lt = lrole * 64 + lane;
    LAS float* ybuf = lds + 2 * SBUF_F;
    bf16_t* proj = (bf16_t*)(p.ws + OFF_PROJ);
    float* ybase = (float*)(proj + (size_t)(b * T) * DINP + C_RW) + h * 64 + rg * 8;
    u32x4 reg[7];
    auto ld = [&](int c) {
        const u32x4* src = (const u32x4*)(sbase + (size_t)c * SCH * SREC);
#pragma unroll
        for (int i = 0; i < 7; ++i) reg[i] = src[lt + i * 256];
    };
    auto st = [&](int buf) {
        LAS float* dst = lds + buf * SBUF_F;
#pragma unroll
        for (int i = 0; i < 7; ++i) { const int v = lt + i * 256;
            const int s = v / 56, wi = v % 56; const u32x4 r = reg[i];
            if (wi < 16) { *(LAS u32x4*)(dst + s * SREC_F + wi * 4) = r; }
            else { const int a = (wi - 16) >> 3, pos = ((wi - 16) & 7) * 8; LAS float* d = dst + s * SREC_F + 64 + a * 64 + pos;
                *(LAS f32x4*)d = (f32x4){bflo(r.x), bfhi(r.x), bflo(r.y), bfhi(r.y)}; *(LAS f32x4*)(d + 4) = (f32x4){bflo(r.z), bfhi(r.z), bflo(r.w), bfhi(r.w)}; }
        }
    };
    auto yred = [&](int c) {
        const LAS float* yp = ybuf + (c & 1) * (SCH * 128) + lt * 16;
        const f32x4 a0 = *(const LAS f32x4*)yp, a1 = *(const LAS f32x4*)(yp + 4), a2 = *(const LAS f32x4*)(yp + 8), a3 = *(const LAS f32x4*)(yp + 12);
        const f32x4 sm = (a0 + a1) + (a2 + a3);
        ybase[(size_t)(c * SCH + (lt >> 3)) * (DINP / 2) + (lt & 7)] = (sm[0] + sm[1]) + (sm[2] + sm[3]);
    };
    if (loader) { ld(0); st(0); ld(1); }
    if (scanner) __builtin_amdgcn_s_setprio(3);
    __syncthreads();
    const int rr = lane >> 4, q = lane & 15, rl = (srole & 1) * 4 + rr, row = rg * 8 + rl;
    f32x2 S0 = (f32x2){0.f, 0.f}, S1 = (f32x2){0.f, 0.f};
    for (int c = 0; c < NCH; ++c) {
        if (loader) {
            if (c + 1 < NCH) st((c + 1) & 1);
            if (c + 2 < NCH) ld(c + 2);
            if (c > 0) yred(c - 1);
        } else if (scanner) {
            const LAS float* cb = lds + (c & 1) * SBUF_F + q * 4;
            const LAS float* vb = lds + (c & 1) * SBUF_F + 320 + row;
            LAS float* yb = ybuf + (c & 1) * (SCH * 128) + rl * 16 + q;
            f32x4 w4 = *(const LAS f32x4*)(cb), r4 = *(const LAS f32x4*)(cb + 64), k4 = *(const LAS f32x4*)(cb + 128), a4 = *(const LAS f32x4*)(cb + 192), b4 = *(const LAS f32x4*)(cb + 256);
            float vv = vb[0];
            f32x4 w5 = *(const LAS f32x4*)(cb + SREC_F), r5 = *(const LAS f32x4*)(cb + SREC_F + 64), k5 = *(const LAS f32x4*)(cb + SREC_F + 128), a5 = *(const LAS f32x4*)(cb + SREC_F + 192), b5 = *(const LAS f32x4*)(cb + SREC_F + 256);
            float v5 = vb[SREC_F];
#pragma unroll
            for (int s = 0; s < SCH; ++s) {
                f32x4 nw = w5, nr = r5, nk = k5, na = a5, nb = b5; float nv = v5;
                if (s + 2 < SCH) {
                    const LAS float* nbp = cb + (s + 2) * SREC_F;
                    nw = *(const LAS f32x4*)(nbp); nr = *(const LAS f32x4*)(nbp + 64); nk = *(const LAS f32x4*)(nbp + 128); na = *(const LAS f32x4*)(nbp + 192); nb = *(const LAS f32x4*)(nbp + 256);
                    nv = vb[(s + 2) * SREC_F];
                }
                f32x2 t = S0 * (f32x2){a4[0], a4[1]};
                t = __builtin_elementwise_fma(S1, (f32x2){a4[2], a4[3]}, t);
                float pa = t[0] + t[1];
                pa = red16(pa);
                const f32x2 vk0 = (f32x2){vv, vv} * (f32x2){k4[0], k4[1]}, vk1 = (f32x2){vv, vv} * (f32x2){k4[2], k4[3]};
                const f32x2 t0 = __builtin_elementwise_fma(S0, (f32x2){w4[0], w4[1]}, vk0), t1 = __builtin_elementwise_fma(S1, (f32x2){w4[2], w4[3]}, vk1);
                S0 = __builtin_elementwise_fma((f32x2){pa, pa}, (f32x2){b4[0], b4[1]}, t0);
                S1 = __builtin_elementwise_fma((f32x2){pa, pa}, (f32x2){b4[2], b4[3]}, t1);
                f32x2 u = S0 * (f32x2){r4[0], r4[1]};
                u = __builtin_elementwise_fma(S1, (f32x2){r4[2], r4[3]}, u);
                yb[s * 128] = u[0] + u[1];
                w4 = w5; r4 = r5; k4 = k5; a4 = a5; b4 = b5; vv = v5;
                w5 = nw; r5 = nr; k5 = nk; a5 = na; b5 = nb; v5 = nv;
            }
        }
        __syncthreads();
    }
    if (loader) yred(NCH - 1);
    if (scanner) __builtin_amdgcn_s_setprio(0);
    __syncthreads();
}

__device__ __forceinline__ void ret_r3_item(const Params& p, int l, int item, LAS bf16_t* lds) {
    const int tid = tid_(), wid = tid >> 6, lane = tid & 63, fr = lane & 15, fq = lane >> 4;
    const int n = item & 31, bh = item >> 5, h = bh & 3, b = bh >> 2, tok0 = b * T + n * 128;
    const float lg = ret_lg(h);
    LAS bf16_t* Q = lds; LAS bf16_t* Kk = lds + 128 * LDS_LD; LAS bf16_t* VT = lds + 2 * 128 * LDS_LD; LAS bf16_t* RP = lds + 3 * 128 * LDS_LD;
    {
        const bf16_t* rp = (const bf16_t*)(p.ws + OFF_RPREV) + ((size_t)item << 14);
        RotCS cs[2]; u32x4 qa[2], qb[2], ka[2], kb[2], rv[4], rpv[4];
        fetch_qk(p, qa, qb, tid, tok0, C_Q + h * 128); fetch_qk(p, ka, kb, tid, tok0, C_K + h * 128); fetch_cs(p, cs, tid, tok0);
        fetch_v(p, rv, tid, tok0, C_V + h * 128);
#pragma unroll
        for (int it = 0; it < 4; ++it) rpv[it] = *(const u32x4*)(rp + (size_t)(tid + it * 512) * 8);
        store_rot<false>(Q, qa, qb, cs, tid, 1.0f, 0.f);
        store_rot<false>(Kk, ka, kb, cs, tid, 0.08838834764831845f, 0.f);
        store_vT(VT, rv, tid);
#pragma unroll
        for (int it = 0; it < 4; ++it) { const int u = tid + it * 512, e = u >> 4, d0 = (u & 15) * 8; *(LAS u32x4*)(RP + e * LDS_LD + d0) = rpv[it]; }
    }
    __syncthreads();
    const int i0 = wid * 16;
    f32x4 acc[8], sc_[8];
#pragma unroll
    for (int i = 0; i < 8; ++i) { acc[i] = (f32x4){0.f, 0.f, 0.f, 0.f}; sc_[i] = (f32x4){0.f, 0.f, 0.f, 0.f}; }
    strip_mma(Q, i0, RP, acc, fr, fq);
    strip_mma(Q, i0, Kk, sc_, fr, fq);
#pragma unroll
    for (int jj = 0; jj < 4; ++jj) { const float sc = exp2f(lg * (float)(i0 + fq * 4 + jj + 1));
#pragma unroll
        for (int nn = 0; nn < 8; ++nn) acc[nn][jj] *= sc; }
    asm volatile("s_waitcnt lgkmcnt(0)" ::: "memory");
    LAS bf16_t* P = Q;
    {
        float rf[4], cf[8];
#pragma unroll
        for (int jj = 0; jj < 4; ++jj) rf[jj] = exp2f(lg * (float)(i0 + fq * 4 + jj));
#pragma unroll
        for (int nn = 0; nn < 8; ++nn) cf[nn] = exp2f(-lg * (float)(nn * 16 + fr));
#pragma unroll
        for (int nn = 0; nn < 8; ++nn)
#pragma unroll
            for (int jj = 0; jj < 4; ++jj) {
                const int i = i0 + fq * 4 + jj, j = nn * 16 + fr;
                const float m = (i >= j) ? rf[jj] * cf[nn] : 0.f;
                P[i * LDS_LD + j] = f2bf(sc_[nn][jj] * m);
            }
    }
    asm volatile("s_waitcnt lgkmcnt(0)" ::: "memory");
    strip_mma(P, i0, VT, acc, fr, fq);
    if (n == 0 && wid == 0 && fq == 0) {
        const float s0 = ((const float*)(p.ws + OFF_SACC))[b * 4 + h];
#pragma unroll
        for (int nn = 0; nn < 8; ++nn) acc[nn][0] = s0 * bf2f(VT[(nn * 16 + fr) * LDS_LD]);
    }
    asm volatile("s_waitcnt lgkmcnt(0)" ::: "memory");
    const bf16_t* proj = (const bf16_t*)(p.ws + OFF_PROJ);
    bf16_t* br1 = (bf16_t*)(p.ws + OFF_BR) + (size_t)BT * BW;
    const float* gn = p.ret_norm_g + l * BW + h * 128;
    float gv[8];
#pragma unroll
    for (int nn = 0; nn < 8; ++nn) gv[nn] = gn[nn * 16 + fr];
#pragma unroll
    for (int jj = 0; jj < 4; ++jj) {
        float s = 0.f;
#pragma unroll
        for (int nn = 0; nn < 8; ++nn) s += acc[nn][jj];
        s = red16(s); const float mean = s * (1.0f / 128.0f);
        float vs = 0.f;
#pragma unroll
        for (int nn = 0; nn < 8; ++nn) { const float d = acc[nn][jj] - mean; vs += d * d; }
        vs = red16(vs); const float rstd = rsqrtf(vs * (1.0f / 128.0f) + 1e-5f);
#pragma unroll
        for (int nn = 0; nn < 8; ++nn) Q[(i0 + fq * 4 + jj) * LDS_LD + nn * 16 + fr] = f2bf((acc[nn][jj] - mean) * rstd * gv[nn]);
    }
    asm volatile("s_waitcnt lgkmcnt(0)" ::: "memory");
#pragma unroll
    for (int it = 0; it < 4; ++it) {
        const int i = i0 + it * 4 + fq, e0 = fr * 8;
        const size_t tok = (size_t)(tok0 + i);
        float ov[8], gt[8], o[8];
        unpack8(*(const LAS u32x4*)(Q + i * LDS_LD + e0), ov);
        unpack8(*(const u32x4*)(proj + tok * DINP + C_RG + h * 128 + e0), gt);
#pragma unroll
        for (int k = 0; k < 8; ++k) o[k] = ov[k] * siluf_(gt[k]);
        *(u32x4*)(br1 + tok * BW + h * 128 + e0) = pack8(o);
    }
    __syncthreads();
}

__device__ __forceinline__ void c0_item(const Params& p, int l, unsigned char* shm) {
    const int tid = tid_(), b = tid >> 7, h = (tid >> 4) & 7, q = tid & 15, ch = h * 64 + q * 4;
    float* P0 = (float*)shm;
    {
        const float* pp = (const float*)(p.ws + OFF_P0F);
        float v18[18];
#pragma unroll
        for (int j = 0; j < 18; ++j) v18[j] = pp[tid + j * 512];
#pragma unroll
        for (int j = 0; j < 18; ++j) P0[tid + j * 512] = v18[j];
    }
    __syncthreads();
    {
        const int b2 = tid >> 7, h2 = (tid >> 5) & 3, l32 = tid & 31;
        const f32x4 qv = *(const f32x4*)(P0 + b2 * P0W + 1152 + h2 * 128 + l32 * 4), kv = *(const f32x4*)(P0 + b2 * P0W + 1664 + h2 * 128 + l32 * 4);
        float sp = (qv[0] * kv[0] + qv[1] * kv[1]) + (qv[2] * kv[2] + qv[3] * kv[3]);
        sp = red16(sp); sp += __shfl_xor(sp, 16);
        if (l32 == 0) ((float*)(p.ws + OFF_SACC))[b2 * 4 + h2] = sp * 0.08838834764831845f;
    }
    const float* p0 = P0 + b * P0W;
    const float* mu = p.shift_mu + l * RW_W;
    float* AL = P0 + NB * P0W;
    if (tid < 256) AL[tid] = P0[(tid >> 6) * P0W + 1024 + (tid & 63)] * (1.0f - mu[RW_AL + (tid & 63)]);
    __syncthreads();
    f32x4 aacc = *(const f32x4*)(p.a0 + l * BW + ch);
#pragma unroll
    for (int i0 = 0; i0 < 64; i0 += 32) {
        f32x4 rows[32];
#pragma unroll
        for (int j = 0; j < 32; ++j) rows[j] = *(const f32x4*)(p.a2 + ((size_t)l * 64 + i0 + j) * BW + ch);
#pragma unroll
        for (int j = 0; j < 32; ++j) aacc += AL[b * 64 + i0 + j] * rows[j];
    }
    const f32x4 r0 = *(const f32x4*)(p0 + ch), k0v = *(const f32x4*)(p0 + 512 + ch);
    const f32x4 ka = *(const f32x4*)(p.k_a + l * BW + ch);
    float cpart = 0.f;
#pragma unroll
    for (int i = 0; i < 4; ++i) { const float av = 1.0f / (1.0f + expf(-aacc[i]));
        const float rr_ = r0[i] * (1.0f - mu[RW_R + ch + i]), kk_ = k0v[i] * (1.0f - mu[RW_K + ch + i]);
        cpart += rr_ * (kk_ * (1.0f + (av - 1.0f) * ka[i])); }
    const float c0 = red16(cpart);
    if (q == 0) ((float*)(p.ws + OFF_CACC))[b * 8 + h] = c0;
    __syncthreads();
}
__device__ __forceinline__ void rwkv_post(const Params& p, int l) {
    const bf16_t* proj = (const bf16_t*)(p.ws + OFF_PROJ);
    bf16_t* br2 = (bf16_t*)(p.ws + OFF_BR) + (size_t)2 * BT * BW;
    const float* bonus = (const float*)(p.ws + OFF_BONUS);
    const unsigned char* stream = p.ws + OFF_STREAM;
    const float* ln_w = p.ln_w + l * BW; const float* ln_b = p.ln_b + l * BW;
    const int gtid = blockIdx.x * 512 + tid_(), nth = gridDim.x * 512;
    for (int idx = gtid; idx < BT * 64; idx += nth) {
        const int tok = idx >> 6, h = (idx >> 3) & 7, q = idx & 7, ch = h * 64 + q * 8, b = tok >> 12, tpos = tok & (T - 1);
        float y[8]; ldf8((const float*)(proj + (size_t)tok * DINP + C_RW) + ch, y);
        float v8[8]; unpack8(*(const u32x4*)(stream + ((size_t)(b * 8 + h) * T + tpos) * SREC + 768 + q * 16), v8);
        if (tpos == 0) {
            const float c0 = ((const float*)(p.ws + OFF_CACC))[b * 8 + h];
#pragma unroll
            for (int i = 0; i < 8; ++i) y[i] = v8[i] * c0;
        }
        float s = 0.f;
#pragma unroll
        for (int i = 0; i < 8; ++i) s += y[i];
        s = red8(s); const float mean = s * (1.0f / 64.0f);
        float vs = 0.f;
#pragma unroll
        for (int i = 0; i < 8; ++i) { y[i] -= mean; vs += y[i] * y[i]; }
        vs = red8(vs);
        const float rstd = rsqrtf(vs * (1.0f / 64.0f) + 64e-5f);
        float g8[8]; unpack8(*(const u32x4*)(proj + (size_t)tok * DINP + C_RWG + ch), g8);
        float lw8[8], lb8[8]; ldf8(ln_w + ch, lw8); ldf8(ln_b + ch, lb8);
        const float bs = bonus[(size_t)tok * 8 + h];
        float o[8];
#pragma unroll
        for (int i = 0; i < 8; ++i) o[i] = (y[i] * rstd * lw8[i] + lb8[i] + bs * v8[i]) * siluf_(g8[i]);
        *(u32x4*)(br2 + (size_t)tok * BW + ch) = pack8(o);
    }
}
__device__ __forceinline__ void gemm_inproj(const Params& p, LAS unsigned char* lds) {
    pg8::Gemm g{(const bf16_t*)(p.ws + OFF_H), (const bf16_t*)(p.ws + p.img_off + OFF_WIN), BT, DINP, D}; pg8::StaticOrder S; S.init(BT, DINP, (int)gridDim.x, (int)blockIdx.x); EpiProj E{(bf16_t*)(p.ws + OFF_PROJ)};
    pg8::gemm_phase<EpiProj, pg8::StaticOrder, false>(lds, g, S, E, nullptr);
}
template <int NBR> __device__ __forceinline__ void gemm_merge1(const Params& p, LAS unsigned char* lds) {
    const bf16_t* br = (const bf16_t*)(p.ws + OFF_BR); const bf16_t* Wt_br = (const bf16_t*)(p.ws + OFF_WBR);
    pg8::StaticOrder S; S.init(BT, D, (int)gridDim.x, (int)blockIdx.x);
    pg8::Gemm g{br + (size_t)NBR * BT * BW, Wt_br + (size_t)NBR * D * BW, BT, D, BW};
    EpiMerge<NBR> E{(const bf16_t*)(p.ws + OFF_PROJ), (float*)(p.ws + OFF_MERGED), (bf16_t*)(p.ws + OFF_MERGEDB)};
    pg8::gemm_phase<EpiMerge<NBR>, pg8::StaticOrder, false>(lds, g, S, E, nullptr);
}
__device__ __forceinline__ void gemm_merge(const Params& p, LAS unsigned char* lds) { gemm_merge1<0>(p, lds); gemm_merge1<1>(p, lds); gemm_merge1<2>(p, lds); }
__device__ __forceinline__ void gemm_merge_all(const Params& p, LAS unsigned char* lds) {
    pg8::Gemm g{(const bf16_t*)(p.ws + OFF_BR), (const bf16_t*)(p.ws + OFF_WBR), 3 * BT, 3 * D, BW};
    MergeOrder S; S.base.init(BT, D, (int)gridDim.x, (int)blockIdx.x);
    EpiMergeAll E{(const bf16_t*)(p.ws + OFF_PROJ), (float*)(p.ws + OFF_MERGED), (bf16_t*)(p.ws + OFF_MERGEDB)};
    pg8::gemm_phase<EpiMergeAll, MergeOrder, false>(lds, g, S, E, nullptr);
}
__device__ __forceinline__ void gemm_out(const Params& p, int l, const float* xin, LAS unsigned char* lds) {
    pg8::Gemm g{(const bf16_t*)(p.ws + OFF_MERGEDB), (const bf16_t*)(p.ws + p.img_off + OFF_WOUT), BT, D, D}; pg8::StaticOrder S; S.init(BT, D, (int)gridDim.x, (int)blockIdx.x);
    EpiOut E{xin, p.out, (const float*)(p.ws + OFF_MOD) + (size_t)l * NB * 3 * D + 2 * D};
    pg8::gemm_phase<EpiOut, pg8::StaticOrder, false>(lds, g, S, E, nullptr);
}
constexpr int MG_BK = 64, MG_A_BYTES = 256 * MG_BK * 2, MG_B_BYTES = 128 * MG_BK * 2, MG_STAGE = MG_A_BYTES + MG_B_BYTES;
template <int DRY> __device__ __forceinline__ void gemm_merge_fused(const Params& p, LAS unsigned char* lds) {
    const int tid = tid_(), wid = tid >> 6, lane = tid & 63, fr = lane & 15, fq = lane >> 4, wr = wid >> 1, wc = wid & 1;
    const bf16_t* br = (const bf16_t*)(p.ws + OFF_BR); const bf16_t* Wt = (const bf16_t*)(p.ws + p.img_off + OFF_WBR);
    const bf16_t* proj = (const bf16_t*)(p.ws + OFF_PROJ); bf16_t* mergedb = (bf16_t*)(p.ws + OFF_MERGEDB);
    int a_off[4], b_off[2];
#pragma unroll
    for (int i = 0; i < 4; ++i) { const int c = tid + i * 512, row = c >> 3; a_off[i] = row * BW + (((c & 7) ^ (row & 7)) * 8); }
#pragma unroll
    for (int i = 0; i < 2; ++i) { const int c = tid + i * 512, row = c >> 3, rho = row & 31, srow = (row & ~31) + 8 * ((rho & 15) >> 2) + 4 * (rho >> 4) + (rho & 3);
        b_off[i] = srow * BW + (((c & 7) ^ (row & 7)) * 8); }
    f32x4 tot[4][4], acc[4][4];
    int nmine = 0; for (int u = (int)blockIdx.x; u < 512; u += (int)gridDim.x) ++nmine;
    const int nsteps = nmine * 24;
    auto unit_of = [&](int ui, int& pm, int& pn) { const int u = (int)blockIdx.x + ui * (int)gridDim.x; pm = (u & 7) + 8 * (u >> 6); pn = (u >> 3) & 7; };
    auto dma = [&](int g) {
        const int ui = g / 24, r = g - ui * 24, n = r >> 3, t = r & 7; int pm, pn; unit_of(ui, pm, pn);
        const bf16_t* A = br + (size_t)n * BT * BW + (size_t)(pm * 256) * BW + t * MG_BK;
        const bf16_t* Bw = Wt + (size_t)n * D * BW + (size_t)(pn * 128) * BW + t * MG_BK;
        LAS unsigned char* base = lds + (g % 3) * MG_STAGE + wid * 1024;
#pragma unroll
        for (int i = 0; i < 4; ++i) __builtin_amdgcn_global_load_lds((const unsigned*)(A + a_off[i]), (LAS unsigned*)(base + i * 8192), 16, 0, 0);
#pragma unroll
        for (int i = 0; i < 2; ++i) __builtin_amdgcn_global_load_lds((const unsigned*)(Bw + b_off[i]), (LAS unsigned*)(base + MG_A_BYTES + i * 8192), 16, 0, 0);
    };
#pragma unroll
    for (int m = 0; m < 4; ++m)
#pragma unroll
        for (int n = 0; n < 4; ++n) { tot[m][n] = (f32x4){0.f, 0.f, 0.f, 0.f}; acc[m][n] = (f32x4){0.f, 0.f, 0.f, 0.f}; }
    if (nsteps > 0) { dma(0); if (nsteps > 1) { dma(1); asm volatile("s_waitcnt vmcnt(6)" ::: "memory"); } else asm volatile("s_waitcnt vmcnt(0)" ::: "memory"); }
    __builtin_amdgcn_s_barrier(); asm volatile("" ::: "memory");
    for (int g = 0; g < nsteps; ++g) {
        {
            const LAS unsigned char* Ab = lds + (g % 3) * MG_STAGE; const LAS unsigned char* Bb = Ab + MG_A_BYTES;
#pragma unroll
            for (int kk = 0; kk < 2; ++kk) {
                if (kk == 1 && g + 2 < nsteps) dma(g + 2);
                bf16x8 af[4], bfv[4];
#pragma unroll
                for (int m = 0; m < 4; ++m) { const int row = wr * 64 + m * 16 + fr; af[m] = *(const LAS bf16x8*)(Ab + row * 128 + (((kk * 4 + fq) ^ (row & 7)) * 16)); }
#pragma unroll
                for (int n = 0; n < 4; ++n) { const int row = wc * 64 + n * 16 + fr; bfv[n] = *(const LAS bf16x8*)(Bb + row * 128 + (((kk * 4 + fq) ^ (row & 7)) * 16)); }
                __builtin_amdgcn_s_setprio(1);
#pragma unroll
                for (int m = 0; m < 4; ++m)
#pragma unroll
                    for (int n = 0; n < 4; ++n) { if (DRY != 1) acc[m][n] = __builtin_amdgcn_mfma_f32_16x16x32_bf16(bfv[n], af[m], acc[m][n], 0, 0, 0); else { asm volatile("" :: "v"(bfv[n]), "v"(af[m])); } }
                __builtin_amdgcn_s_setprio(0);
            }
        }
        const int ui = g / 24, r = g - ui * 24, nb = r >> 3, t = r & 7;
        if (t == 7 && DRY == 0) {
            int pm, pn; unit_of(ui, pm, pn);
            const int row0 = pm * 256 + wr * 64 + fr, col0 = pn * 128 + wc * 64 + fq * 8;
#pragma unroll
            for (int m = 0; m < 4; ++m)
#pragma unroll
                for (int pp_ = 0; pp_ < 2; ++pp_) {
                    const u32x4 lg = *(const u32x4*)(proj + (size_t)(row0 + m * 16) * DINP + C_GATE + nb * D + col0 + pp_ * 32);
                    f32x4& t0 = tot[m][2 * pp_]; f32x4& t1 = tot[m][2 * pp_ + 1]; f32x4& c0 = acc[m][2 * pp_]; f32x4& c1 = acc[m][2 * pp_ + 1];
                    t0[0] += sigmoidf_(bflo(lg.x)) * c0[0]; t0[1] += sigmoidf_(bfhi(lg.x)) * c0[1]; t0[2] += sigmoidf_(bflo(lg.y)) * c0[2]; t0[3] += sigmoidf_(bfhi(lg.y)) * c0[3];
                    t1[0] += sigmoidf_(bflo(lg.z)) * c1[0]; t1[1] += sigmoidf_(bfhi(lg.z)) * c1[1]; t1[2] += sigmoidf_(bflo(lg.w)) * c1[2]; t1[3] += sigmoidf_(bfhi(lg.w)) * c1[3];
                    c0 = (f32x4){0.f, 0.f, 0.f, 0.f}; c1 = (f32x4){0.f, 0.f, 0.f, 0.f};
                }
            if (nb == 2) {
#pragma unroll
                for (int m = 0; m < 4; ++m)
#pragma unroll
                    for (int pp_ = 0; pp_ < 2; ++pp_) {
                        f32x4& t0 = tot[m][2 * pp_]; f32x4& t1 = tot[m][2 * pp_ + 1];
                        u32x4 w; w.x = pk2(t0[0], t0[1]); w.y = pk2(t0[2], t0[3]); w.z = pk2(t1[0], t1[1]); w.w = pk2(t1[2], t1[3]);
                        *(u32x4*)(mergedb + (size_t)(row0 + m * 16) * D + col0 + pp_ * 32) = w;
                        t0 = (f32x4){0.f, 0.f, 0.f, 0.f}; t1 = (f32x4){0.f, 0.f, 0.f, 0.f};
                    }
            }
        }
        if (g + 2 < nsteps) asm volatile("s_waitcnt vmcnt(6)" ::: "memory"); else asm volatile("s_waitcnt vmcnt(0)" ::: "memory");
        asm volatile("s_waitcnt lgkmcnt(0)" ::: "memory");
        __builtin_amdgcn_s_barrier(); asm volatile("" ::: "memory");
    }
    __syncthreads();
}

#ifndef DUP_P1
#define DUP_P1 0
#endif
#ifndef DUP_P2
#define DUP_P2 0
#endif
#ifndef DUP_P3A
#define DUP_P3A 0
#endif
#ifndef DUP_P3B
#define DUP_P3B 0
#endif
#ifndef DUP_P3C
#define DUP_P3C 0
#endif
#ifndef DUP_P4
#define DUP_P4 0
#endif
#ifndef DUP_P5A
#define DUP_P5A 0
#endif
#ifndef DUP_P5B
#define DUP_P5B 0
#endif
#ifndef DUP_P6
#define DUP_P6 0
#endif
#ifndef DUP_P7
#define DUP_P7 0
#endif
#ifndef DUP_P0
#define DUP_P0 0
#endif
#ifndef DUP_R2
#define DUP_R2 0
#endif
#ifndef DUP_P6DRY
#define DUP_P6DRY 0
#endif
#ifndef DUP_P6NOEPI
#define DUP_P6NOEPI 0
#endif
#ifndef DUP_SYNC
#define DUP_SYNC 0
#endif
#if defined(__HIP_DEVICE_COMPILE__)
#define FRESH_PARAMS(q) Params q; { const __attribute__((address_space(4))) Params* pp_ = (const __attribute__((address_space(4))) Params*)__builtin_amdgcn_kernarg_segment_ptr(); asm volatile("" : "+s"(pp_)); q = *pp_; }
#else
#define FRESH_PARAMS(q) Params q = p_unused;
#endif
__global__ void __launch_bounds__(512, 2) fwd_megakernel(Params p_unused) {
    extern __shared__ __attribute__((aligned(16))) unsigned char shm[];
    cg::grid_group grid = cg::this_grid();
    LAS unsigned char* lds = (LAS unsigned char*)shm;
    const int G = (int)gridDim.x, bid = (int)blockIdx.x;
    volatile LAS unsigned* xb_st = (volatile LAS unsigned*)(lds + LDS_MAIN);
    if (tid_() == 0) { xb_st[0] = 0u; xb_st[1] = 0u; xb_st[2] = 0u; xb_st[3] = 0u; }
    __syncthreads();
    { FRESH_PARAMS(p); (void)xcd_barrier_post((unsigned*)(p.ws + OFF_BAR), xb_st); }
#define GSYNC() do { FRESH_PARAMS(pb_); XcdBarrier b_; b_.bar = (unsigned*)(pb_.ws + OFF_BAR); b_.x = xb_xcc_id(); b_.st = xb_st; xcd_barrier(b_); } while (0)

    for (int rep = 0; rep <= DUP_P0; ++rep) { FRESH_PARAMS(p); phase0(p, shm); }
    __syncthreads();
    { FRESH_PARAMS(p); p.img_off = 0; phase_weights(p, 0, shm, bid, G); }
    grid.sync();

#pragma nounroll
    for (int l = 0; l < NL; ++l) {
        for (int rep = 0; rep <= DUP_P1; ++rep) {
        { FRESH_PARAMS(p); phase_norm(p, l, (l == 0) ? p.x : p.out); }
        }
        GSYNC();
        for (int rep = 0; rep <= DUP_P2; ++rep) { FRESH_PARAMS(p); p.img_off = (size_t)(l & 1) * IMG_STRIDE; gemm_inproj(p, lds); }
        if (l + 1 < NL) { FRESH_PARAMS(p); p.img_off = (size_t)((l + 1) & 1) * IMG_STRIDE;
            if (G == 256) { if (bid >= 64) phase_weights(p, l + 1, shm, bid - 64, 192); }
            else phase_weights(p, l + 1, shm, bid, G); }
        { FRESH_PARAMS(p); const int first = (G == 256) ? 64 : 0; for (int it = bid - first; it >= 0 && it < 132; it += G - first) gemv0_item(p, l, it, shm); }
        GSYNC();
        for (int rep = 0; rep <= DUP_P3A; ++rep) { FRESH_PARAMS(p); for (int it = bid; it < BT / 64; it += G) pool_item(p, l, it); }
        for (int rep = 0; rep <= DUP_P3B; ++rep) { FRESH_PARAMS(p); for (int it = bid; it < 512; it += G) ret_r1_item(p, it, (LAS bf16_t*)lds); }
        for (int rep = 0; rep <= DUP_P3C; ++rep) { FRESH_PARAMS(p); p.img_off = (size_t)(l & 1) * IMG_STRIDE; for (int it = bid; it < BT / 32; it += G) rwkv_prep_item(p, l, it, (LAS bf16_t*)lds); }
        if (bid == G - 1) { FRESH_PARAMS(p); c0_item(p, l, shm); }
        GSYNC();
        for (int rep = 0; rep <= DUP_R2; ++rep) { FRESH_PARAMS(p); ret_r2(p); }
        for (int rep = 0; rep <= DUP_P4; ++rep) { FRESH_PARAMS(p); for (int it = bid; it < 256; it += G) rwkv_scan_item(p, it, (LAS float*)lds, (LAS unsigned*)(lds + LDS_MAIN + 16)); }
        GSYNC();
        for (int rep = 0; rep <= DUP_P5A; ++rep) { FRESH_PARAMS(p); for (int it = bid; it < 512; it += G) ret_r3_item(p, l, it, (LAS bf16_t*)lds); }
        for (int rep = 0; rep <= DUP_P5B; ++rep) { FRESH_PARAMS(p); rwkv_post(p, l); }
        GSYNC();
        for (int rep = 0; rep <= DUP_P6; ++rep) {
        { FRESH_PARAMS(p); p.img_off = (size_t)(l & 1) * IMG_STRIDE; gemm_merge_fused<0>(p, lds); }
        }
        GSYNC();
        for (int rep = 0; rep < DUP_P7; ++rep) { FRESH_PARAMS(p); p.img_off = (size_t)(l & 1) * IMG_STRIDE; Params q = p; q.out = (float*)(p.ws + OFF_MERGED); gemm_out(q, l, (l == 0) ? p.x : p.out, lds); }
        { FRESH_PARAMS(p); p.img_off = (size_t)(l & 1) * IMG_STRIDE; gemm_out(p, l, (l == 0) ? p.x : p.out, lds); }
        GSYNC();
        for (int rep = 0; rep < DUP_SYNC; ++rep) GSYNC();
    }
    { FRESH_PARAMS(p); phase_final_norm(p); }
}

extern "C" void kernel_launch(void* const* d_in, const int* in_sizes, int n_in, void* d_out, int out_size, void* d_ws, size_t ws_size, hipStream_t stream) {
    (void)in_sizes; (void)n_in; (void)out_size;
    if (ws_size < WS_NEED) { fprintf(stderr, "workspace too small: %zu < %zu\n", ws_size, (size_t)WS_NEED); return; }
    static int grid_blocks = 0;
    if (!grid_blocks) {
        int dev = 0, cus = 0, per_cu = 0;
        hipGetDevice(&dev);
        hipDeviceGetAttribute(&cus, hipDeviceAttributeMultiprocessorCount, dev);
        hipFuncSetAttribute((const void*)fwd_megakernel, hipFuncAttributeMaxDynamicSharedMemorySize, LDS_BYTES);
        hipOccupancyMaxActiveBlocksPerMultiprocessor(&per_cu, fwd_megakernel, 512, LDS_BYTES);
        if (per_cu < 1) per_cu = 1;
        grid_blocks = cus * per_cu;
        if (grid_blocks > 256) grid_blocks = 256;
    }
    Params p{};
    p.x = (const float*)d_in[0]; p.c = (const float*)d_in[1]; p.pos = (const int*)d_in[2];
    p.norm_g = (const float*)d_in[3]; p.w_ada = (const float*)d_in[4]; p.b_ada = (const float*)d_in[5]; p.w_in = (const float*)d_in[6];
    p.pool_w = (const float*)d_in[7]; p.pool_scale = (const float*)d_in[8]; p.ret_norm_g = (const float*)d_in[9]; p.shift_mu = (const float*)d_in[10];
    p.w0 = (const float*)d_in[11]; p.w2 = (const float*)d_in[12]; p.a0 = (const float*)d_in[13]; p.a2 = (const float*)d_in[14];
    p.k_k = (const float*)d_in[15]; p.k_a = (const float*)d_in[16]; p.r_k = (const float*)d_in[17]; p.ln_w = (const float*)d_in[18]; p.ln_b = (const float*)d_in[19];
    p.w_branch = (const float*)d_in[20]; p.w_out = (const float*)d_in[21]; p.final_g = (const float*)d_in[22];
    p.out = (float*)d_out; p.ws = (unsigned char*)d_ws;
    (void)hipMemsetAsync((unsigned char*)d_ws + OFF_BAR, 0, SZ_BAR, stream);
    void* args[] = {&p};
    hipError_t e = hipLaunchCooperativeKernel((const void*)fwd_megakernel, dim3(grid_blocks), dim3(512), args, LDS_BYTES, stream);
    if (e != hipSuccess) fprintf(stderr, "cooperative launch failed: %s (grid %d)\n", hipGetErrorString(e), grid_blocks);
}
```
